# Optimizing an MI355X kernel written in HIP

```python
import math
import jax, jax.numpy as jnp
from jax import lax
import numpy as np

D_MODEL = 1024
BATCH = 16
SEQ = 4096
DEPTH = 2

GRID_W = 64
ATTN_WIDTH = D_MODEL // 2
POOL_WIDTH = D_MODEL - ATTN_WIDTH
HEAD_DIM = 64
N_HEADS = ATTN_WIDTH // HEAD_DIM
WIN_H_MAX = 8
WIN_W = 16
POOL_WINDOWS = (2, 4, 8, 16)
N_POOL_GROUPS = len(POOL_WINDOWS)
POOL_GROUP = POOL_WIDTH // N_POOL_GROUPS
PROJ_WIDTH = 3 * ATTN_WIDTH + POOL_WIDTH
D_FF = 4 * D_MODEL
N_MOD = 6
DN_ALPHA = (2.0 * DEPTH) ** 0.25
DN_BETA = (8.0 * DEPTH) ** -0.25
LN_EPS = 1e-5

kernel_name = "hybrid_natten_pool_deepnorm_encoder"


def layer_norm(x, g, b):
    xf = x.astype(jnp.float32)
    mu = jnp.mean(xf, axis=-1, keepdims=True)
    var = jnp.mean(jnp.square(xf - mu), axis=-1, keepdims=True)
    y = (xf - mu) * lax.rsqrt(var + LN_EPS)
    return (y * g.astype(jnp.float32) + b.astype(jnp.float32)).astype(x.dtype)


def neighborhood_attention(q, k, v, rpb):
    b, s, h, dh = q.shape
    rows = s // GRID_W
    kh = min(WIN_H_MAX, rows)
    qg = q.reshape(b, rows, GRID_W, h, dh).transpose(1, 0, 3, 2, 4)
    kg = k.reshape(b, rows, GRID_W, h, dh).transpose(0, 3, 1, 2, 4)
    vg = v.reshape(b, rows, GRID_W, h, dh).transpose(0, 3, 1, 2, 4)
    col = np.arange(GRID_W)
    col_start = np.clip(col - WIN_W // 2, 0, GRID_W - WIN_W)
    col_idx = col_start[:, None] + np.arange(WIN_W)[None, :]
    col_rel = col_idx - col[:, None] + (WIN_W - 1)
    rpb_c = rpb[:, :, col_rel]
    scale = HEAD_DIM ** -0.5

    def row_block(args):
        r, q_r = args
        start = jnp.clip(r - kh // 2, 0, rows - kh)
        key_rows = start + jnp.arange(kh)
        k_win = jnp.take(jnp.take(kg, key_rows, axis=2), col_idx, axis=3)
        v_win = jnp.take(jnp.take(vg, key_rows, axis=2), col_idx, axis=3)
        bias = jnp.take(rpb_c, key_rows - r + (WIN_H_MAX - 1), axis=1)
        bias = bias.transpose(0, 2, 1, 3).astype(jnp.float32)
        sc = jnp.einsum('bhqd,bhrqcd->bhqrc', q_r * scale, k_win).astype(jnp.float32) + bias[None]
        p = jax.nn.softmax(sc.reshape(b, h, GRID_W, kh * WIN_W), axis=-1)
        p = p.reshape(b, h, GRID_W, kh, WIN_W).astype(v_win.dtype)
        return jnp.einsum('bhqrc,bhrqcd->bhqd', p, v_win)

    out = lax.map(row_block, (jnp.arange(rows), qg))
    return out.transpose(1, 0, 3, 2, 4).reshape(b, s, h * dh)


def multiscale_pool(u, w_pool, pool_scale):
    b, s, _ = u.shape
    uf = u.reshape(b, s, N_POOL_GROUPS, POOL_GROUP).astype(jnp.float32)
    csum = jnp.concatenate([jnp.zeros((b, 1, N_POOL_GROUPS, POOL_GROUP), jnp.float32),
                            jnp.cumsum(uf, axis=1)], axis=1)
    t = np.arange(s)[:, None]
    w = np.array(POOL_WINDOWS)[None, :]
    lo = np.clip(t - w // 2, 0, s)
    hi = np.clip(t - w // 2 + w, 0, s)
    g = np.arange(N_POOL_GROUPS)[None, :]
    window_sum = csum[:, hi, g] - csum[:, lo, g]
    count = (hi - lo).astype(np.float32)[None, :, :, None]
    mixed = (window_sum / count - uf).astype(u.dtype)
    y = jnp.einsum('bsgc,gcd->bsgd', mixed, w_pool).reshape(b, s, POOL_WIDTH)
    return y * pool_scale


def setup_inputs(seed: int = 0) -> dict:
    key = jax.random.key(seed)
    ks = jax.random.split(key, 20)
    f32 = jnp.float32
    x = jax.random.normal(ks[0], (BATCH, SEQ, D_MODEL), f32)
    c = jax.random.normal(ks[1], (BATCH, D_MODEL), f32)
    ln_in_g = 1.0 + 0.02 * jax.random.normal(ks[2], (D_MODEL,), f32)
    ln_in_b = 0.02 * jax.random.normal(ks[3], (D_MODEL,), f32)
    w_ada = 0.1 * D_MODEL ** -0.5 * jax.random.normal(ks[4], (DEPTH, D_MODEL, N_MOD * D_MODEL), f32)
    b_ada = 0.01 * jax.random.normal(ks[5], (DEPTH, N_MOD * D_MODEL), f32)
    col_scale = np.concatenate([np.ones(2 * ATTN_WIDTH, np.float32),
                                np.full(ATTN_WIDTH, DN_BETA, np.float32),
                                np.ones(POOL_WIDTH, np.float32)])
    w_in = D_MODEL ** -0.5 * jax.random.normal(ks[6], (DEPTH, D_MODEL, PROJ_WIDTH), f32) * col_scale
    rpb = 0.1 * jax.random.normal(ks[7], (DEPTH, N_HEADS, 2 * WIN_H_MAX - 1, 2 * WIN_W - 1), f32)
    w_pool = POOL_GROUP ** -0.5 * jax.random.normal(ks[8], (DEPTH, N_POOL_GROUPS, POOL_GROUP, POOL_GROUP), f32)
    pool_scale = 1.0 + 0.1 * jax.random.normal(ks[9], (DEPTH, POOL_WIDTH), f32)
    w_out = DN_BETA * D_MODEL ** -0.5 * jax.random.normal(ks[10], (DEPTH, ATTN_WIDTH + POOL_WIDTH, D_MODEL), f32)
    ln1_g = 1.0 + 0.02 * jax.random.normal(ks[11], (DEPTH, D_MODEL), f32)
    ln1_b = 0.02 * jax.random.normal(ks[12], (DEPTH, D_MODEL), f32)
    w_mlp1 = D_MODEL ** -0.5 * jax.random.normal(ks[13], (DEPTH, D_MODEL, D_FF), f32)
    w_mlp2 = DN_BETA * D_FF ** -0.5 * jax.random.normal(ks[14], (DEPTH, D_FF, D_MODEL), f32)
    ln2_g = 1.0 + 0.02 * jax.random.normal(ks[15], (DEPTH, D_MODEL), f32)
    ln2_b = 0.02 * jax.random.normal(ks[16], (DEPTH, D_MODEL), f32)
    return {"x": x, "c": c, "ln_in_g": ln_in_g, "ln_in_b": ln_in_b, "w_ada": w_ada, "b_ada": b_ada,
            "w_in": w_in, "rpb": rpb, "w_pool": w_pool, "pool_scale": pool_scale, "w_out": w_out,
            "ln1_g": ln1_g, "ln1_b": ln1_b, "w_mlp1": w_mlp1, "w_mlp2": w_mlp2,
            "ln2_g": ln2_g, "ln2_b": ln2_b}


def reference(x, c, ln_in_g, ln_in_b, w_ada, b_ada, w_in, rpb, w_pool, pool_scale, w_out,
              ln1_g, ln1_b, w_mlp1, w_mlp2, ln2_g, ln2_b):
    b, s, _ = x.shape
    x = layer_norm(x, ln_in_g, ln_in_b)
    c_act = jax.nn.silu(c)
    for l in range(DEPTH):
        mod = (c_act @ w_ada[l] + b_ada[l])[:, None, :]
        sh_a, sc_a, g_a, sh_m, sc_m, g_m = jnp.split(mod, N_MOD, axis=-1)

        h = x * (1.0 + sc_a) + sh_a
        proj = h @ w_in[l]
        q, k, v, u = jnp.split(proj, [ATTN_WIDTH, 2 * ATTN_WIDTH, 3 * ATTN_WIDTH], axis=-1)
        q = q.reshape(b, s, N_HEADS, HEAD_DIM)
        k = k.reshape(b, s, N_HEADS, HEAD_DIM)
        v = v.reshape(b, s, N_HEADS, HEAD_DIM)
        y_attn = neighborhood_attention(q, k, v, rpb[l])
        y_pool = multiscale_pool(u, w_pool[l], pool_scale[l])
        y = jnp.concatenate([y_attn, y_pool], axis=-1) @ w_out[l]
        x = layer_norm(DN_ALPHA * x + (1.0 + g_a) * y, ln1_g[l], ln1_b[l])

        h = x * (1.0 + sc_m) + sh_m
        f = jnp.square(jax.nn.relu(h @ w_mlp1[l])) @ w_mlp2[l]
        x = layer_norm(DN_ALPHA * x + (1.0 + g_m) * f, ln2_g[l], ln2_b[l])
    return x
```

```cpp
#include <hip/hip_runtime.h>
#include <hip/hip_cooperative_groups.h>
#include <cstdio>
#include <cstdint>
namespace cg = cooperative_groups;

#define LAS __attribute__((address_space(3)))
typedef unsigned short bf16_t;
typedef short bf16x8 __attribute__((ext_vector_type(8)));
typedef float f32x4 __attribute__((ext_vector_type(4)));
typedef float f32x2 __attribute__((ext_vector_type(2)));
typedef unsigned u32x4 __attribute__((ext_vector_type(4)));
typedef unsigned u32x2 __attribute__((ext_vector_type(2)));

#ifndef MK_MULTI
#define MK_MULTI 0
#endif

constexpr int BATCH = 16, SEQ = 4096, D = 1024, DEPTH = 2, M = BATCH * SEQ;
constexpr int PROJ = 2048, FF = 4096, NMOD = 6 * D, AW = 512;
constexpr int NHEAD = 8;
constexpr float LN_EPS = 1e-5f;
constexpr float DN_ALPHA = 1.41421356237309515f;
constexpr float LOG2E = 1.44269504088896341f;
constexpr float QSCALE = 0.125f * LOG2E;
constexpr int RPB_H = 15, RPB_W = 31, RPB_N = RPB_H * RPB_W;

constexpr size_t MiB = (size_t)1 << 20;
constexpr size_t WS_WIN = 0 * MiB;
constexpr size_t WS_WOUT = 8 * MiB;
constexpr size_t WS_W1 = 12 * MiB;
constexpr size_t WS_W2 = 28 * MiB;
constexpr size_t WS_MOD = 44 * MiB;
constexpr size_t WS_X = 48 * MiB;
constexpr size_t WS_H = 304 * MiB;
constexpr size_t WS_F = 432 * MiB;
constexpr size_t WS_Q = 432 * MiB;
constexpr size_t WS_K = 496 * MiB;
constexpr size_t WS_VT = 560 * MiB;
constexpr size_t WS_U = 624 * MiB;
constexpr size_t WS_CAT = 688 * MiB;
constexpr size_t WS_END = 944 * MiB;

constexpr int LDS_BYTES = 147456;

namespace pg8 {
constexpr int BM = 256, BK = 64, HALF = 128, HTB = HALF * BK * 2, STAGE_BYTES = 8 * HTB, NXCD = 8, WGM = 8;
__host__ __device__ __forceinline__ int lds_byte(int r, int c) { const int st = (r >> 4) * 2 + (c >> 5), rr = r & 15, cc = c & 31, ob = rr * 64 + cc * 2; return st * 1024 + (ob ^ (((ob >> 9) & 1) << 5)); }
__host__ __device__ __forceinline__ void stage_rc(int b, int& R, int& C) { const int st = b / 1024, sb = b % 1024, swz = sb ^ (((sb >> 9) & 1) << 5); R = (st >> 1) * 16 + swz / 64; C = (st & 1) * 32 + (swz % 64) / 2; }
__host__ __device__ __forceinline__ int perm32(int rho) { const int n = rho >> 4, i = rho & 15; return 8 * (i >> 2) + 4 * n + (i & 3); }

struct Unit { int pm, pn; };
struct Gemm { const bf16_t* A; const bf16_t* Bt; int M, N, K; };

struct StaticOrder {
    int nM, nN, nwg, G, c;
    __device__ void init(int M_, int N_, int G_, int c_) { nM = M_ / BM; nN = N_ / BM; nwg = nM * nN; G = G_; c = c_; }
    __device__ bool next(int i, Unit& u) const {
        const long L = (long)i * G + c; if (L >= nwg) return false;
        int wgid = (int)L; { const int q = nwg / NXCD, r = nwg % NXCD, xcd = wgid % NXCD, off = wgid / NXCD; wgid = (xcd < r ? xcd * (q + 1) : r * (q + 1) + (xcd - r) * q) + off; }
        const int nig = WGM * nN, gid = wgid / nig, fm = gid * WGM, gsz = (nM - fm) < WGM ? (nM - fm) : WGM;
        u.pm = fm + ((wgid % nig) % gsz); u.pn = (wgid % nig) / gsz; return true;
    }
};

__device__ __forceinline__ unsigned cvt_pk_bf16(float lo, float hi) { unsigned r; asm volatile("v_cvt_pk_bf16_f32 %0, %1, %2" : "=v"(r) : "v"(lo), "v"(hi)); return r; }

struct EpiProj {
    static constexpr bool PERM = true, VSWAP = true;
    bf16_t* Q; bf16_t* Kb; bf16_t* Vt; bf16_t* U;
    __device__ __forceinline__ void operator()(const f32x4 (&acc)[2][2][4][2], const Unit& u, int wr, int wc, int fr, int fq) const {
        const int t = u.pn >> 1;
        if (t == 2) {
            const int dg0 = (u.pn & 1) * 256 + wr * 64 + fr; const int b = u.pm >> 4; const int s0 = (u.pm & 15) * 256 + wc * 32 + 8 * fq;
#pragma unroll
            for (int ai = 0; ai < 2; ++ai)
#pragma unroll
                for (int m = 0; m < 4; ++m) { bf16_t* rowp = Vt + (size_t)(b * 512 + dg0 + ai * HALF + m * 16) * SEQ + s0;
#pragma unroll
                    for (int bj = 0; bj < 2; ++bj) { const f32x4 v0 = acc[ai][bj][m][0], v1 = acc[ai][bj][m][1];
                        u32x4 w; w.x = cvt_pk_bf16(v0[0], v0[1]); w.y = cvt_pk_bf16(v0[2], v0[3]); w.z = cvt_pk_bf16(v1[0], v1[1]); w.w = cvt_pk_bf16(v1[2], v1[3]);
                        *(u32x4*)(rowp + bj * HALF) = w; } }
        } else {
            bf16_t* base = Q + (size_t)t * ((size_t)M * AW); const float sc = t == 0 ? QSCALE : 1.0f;
            const int row0 = u.pm * BM + wr * 64 + fr, col0 = (u.pn & 1) * 256 + wc * 32 + 8 * fq;
#pragma unroll
            for (int ai = 0; ai < 2; ++ai)
#pragma unroll
                for (int m = 0; m < 4; ++m) { bf16_t* rowp = base + (size_t)(row0 + ai * HALF + m * 16) * AW + col0;
#pragma unroll
                    for (int bj = 0; bj < 2; ++bj) { const f32x4 v0 = acc[ai][bj][m][0] * sc, v1 = acc[ai][bj][m][1] * sc;
                        u32x4 w; w.x = cvt_pk_bf16(v0[0], v0[1]); w.y = cvt_pk_bf16(v0[2], v0[3]); w.z = cvt_pk_bf16(v1[0], v1[1]); w.w = cvt_pk_bf16(v1[2], v1[3]);
                        *(u32x4*)(rowp + bj * HALF) = w; } }
        }
    }
};
struct EpiRelu2 {
    static constexpr bool PERM = true, VSWAP = false;
    bf16_t* O; int ldc;
    __device__ __forceinline__ void operator()(const f32x4 (&acc)[2][2][4][2], const Unit& u, int wr, int wc, int fr, int fq) const {
        const int row0 = u.pm * BM + wr * 64 + fr, col0 = u.pn * BM + wc * 32 + 8 * fq;
#pragma unroll
        for (int ai = 0; ai < 2; ++ai)
#pragma unroll
            for (int m = 0; m < 4; ++m) { bf16_t* rowp = O + (size_t)(row0 + ai * HALF + m * 16) * ldc + col0;
#pragma unroll
                for (int bj = 0; bj < 2; ++bj) { f32x4 v0 = acc[ai][bj][m][0], v1 = acc[ai][bj][m][1];
#pragma unroll
                    for (int j = 0; j < 4; ++j) { const float a = fmaxf(v0[j], 0.f), b = fmaxf(v1[j], 0.f); v0[j] = a * a; v1[j] = b * b; }
                    u32x4 w; w.x = cvt_pk_bf16(v0[0], v0[1]); w.y = cvt_pk_bf16(v0[2], v0[3]); w.z = cvt_pk_bf16(v1[0], v1[1]); w.w = cvt_pk_bf16(v1[2], v1[3]);
                    *(u32x4*)(rowp + bj * HALF) = w; } }
    }
};
struct EpiRes {
    static constexpr bool PERM = false, VSWAP = false;
    float* X; const float* gate;
    __device__ __forceinline__ void operator()(const f32x4 (&acc)[2][2][4][2], const Unit& u, int wr, int wc, int fr, int fq) const {
        const int row0 = u.pm * BM + wr * 64 + fr, col0 = u.pn * BM + wc * 32 + 4 * fq; const int b = u.pm >> 4;
        f32x4 gv[2][2];
#pragma unroll
        for (int bj = 0; bj < 2; ++bj)
#pragma unroll
            for (int n = 0; n < 2; ++n) gv[bj][n] = *(const f32x4*)(gate + (size_t)b * NMOD + col0 + bj * HALF + n * 16) + 1.0f;
#pragma unroll
        for (int ai = 0; ai < 2; ++ai)
#pragma unroll
            for (int m = 0; m < 4; ++m) { float* rowp = X + (size_t)(row0 + ai * HALF + m * 16) * D + col0;
#pragma unroll
                for (int bj = 0; bj < 2; ++bj)
#pragma unroll
                    for (int n = 0; n < 2; ++n) { float* p = rowp + bj * HALF + n * 16; const f32x4 x = *(const f32x4*)p; *(f32x4*)p = x * DN_ALPHA + gv[bj][n] * acc[ai][bj][m][n]; }
                asm volatile("" ::: "memory"); }
    }
};

template <class Epi, bool ALIGN_EPI>
__device__ __forceinline__ void gemm_phase(LAS unsigned char* lds, const Gemm g, const StaticOrder& S, const Epi& E) {
    int tid = threadIdx.x; asm volatile("" : "+v"(tid));
    const int wid = __builtin_amdgcn_readfirstlane(tid >> 6), lane = tid & 63, wr = wid >> 2, wc = wid & 3, fr = lane & 15, fq = lane >> 4;
    const int K = g.K, nt = K / BK;
    unsigned voffA[2], voffB[2];
#pragma unroll
    for (int i = 0; i < 2; ++i) { int R, C; stage_rc(tid * 16 + i * 8192, R, C); const int Rb = Epi::PERM ? ((R & ~31) + perm32(R & 31)) : R;
        voffA[i] = (unsigned)(R * K + C) * 2u; voffB[i] = (unsigned)(Rb * K + C) * 2u; }
    const size_t kstep = (size_t)(BK * 2);
    const size_t hstep = (size_t)HALF * K * 2;
    const size_t tstep = 2 * hstep;
    const unsigned ldsw = (unsigned)wid * 1024u;
    const int aoff = lds_byte(wr * 64 + fr, fq * 8), boff = lds_byte(wc * 32 + fr, fq * 8);
#define PG8_SA(b, h) (((b) * 2 + (h)) * HTB)
#define PG8_SB(b, h) ((4 + (b) * 2 + (h)) * HTB)
#define PG8_STAGE(bufoff, gbase, voff) do { _Pragma("unroll") for (int _i = 0; _i < 2; ++_i) \
        __builtin_amdgcn_global_load_lds((const unsigned*)((const char*)(gbase) + (voff)[_i]), (LAS unsigned*)(lds + (bufoff) + ldsw + _i * 8192), 16, 0, 0); } while (0)
#define PG8_LDA(dst, b, h) do { _Pragma("unroll") for (int m = 0; m < 4; ++m) _Pragma("unroll") for (int k = 0; k < 2; ++k) dst[m][k] = *(const LAS bf16x8*)(lds + PG8_SA(b, h) + aoff + m * 2048 + k * 1024); } while (0)
#define PG8_LDB(dst, b, h) do { _Pragma("unroll") for (int n = 0; n < 2; ++n) _Pragma("unroll") for (int k = 0; k < 2; ++k) dst[n][k] = *(const LAS bf16x8*)(lds + PG8_SB(b, h) + boff + n * 2048 + k * 1024); } while (0)
#define PG8_MMA(ai, bj, At, Bt) do { __builtin_amdgcn_s_setprio(1); _Pragma("unroll") for (int m = 0; m < 4; ++m) _Pragma("unroll") for (int n = 0; n < 2; ++n) _Pragma("unroll") for (int k = 0; k < 2; ++k) \
        acc[ai][bj][m][n] = __builtin_amdgcn_mfma_f32_16x16x32_bf16(Bt[n][k], At[m][k], acc[ai][bj][m][n], 0, 0, 0); __builtin_amdgcn_s_setprio(0); } while (0)
#define PG8_WAIT_V(n) asm volatile("s_waitcnt vmcnt(" #n ")" ::: "memory")
#define PG8_WAIT_L(n) asm volatile("s_waitcnt lgkmcnt(" #n ")" ::: "memory")
#define PG8_BAR __builtin_amdgcn_s_barrier()
#define PG8_SCHED __builtin_amdgcn_sched_barrier(0)
#define PG8_PTRS(u, pa, pb) do { const bool _sw = Epi::VSWAP && (((u).pn >> 1) == 2); const char* _a = (const char*)g.A + (size_t)(u).pm * tstep; const char* _b = (const char*)g.Bt + (size_t)(u).pn * tstep; pa = _sw ? _b : _a; pb = _sw ? _a : _b; } while (0)
    Unit cur, nxt; int ui = 0;
    if (!S.next(0, cur)) return;
    f32x4 acc[2][2][4][2];
#pragma unroll
    for (int a = 0; a < 2; ++a)
#pragma unroll
        for (int b = 0; b < 2; ++b)
#pragma unroll
            for (int m = 0; m < 4; ++m)
#pragma unroll
                for (int n = 0; n < 2; ++n) acc[a][b][m][n] = (f32x4){0.f, 0.f, 0.f, 0.f};
    bf16x8 At[4][2], B0[2][2], B1[2][2];
    const char* cA; const char* cB; PG8_PTRS(cur, cA, cB);
    PG8_STAGE(PG8_SB(0, 0), cB, voffB); PG8_STAGE(PG8_SB(0, 1), cB + hstep, voffB); PG8_STAGE(PG8_SA(0, 0), cA, voffA); PG8_STAGE(PG8_SA(0, 1), cA + hstep, voffA);
    if (wr == 1) PG8_BAR;
    PG8_WAIT_V(2); PG8_BAR;
    PG8_STAGE(PG8_SB(1, 0), cB + kstep, voffB); PG8_STAGE(PG8_SA(1, 0), cA + kstep, voffA); PG8_STAGE(PG8_SB(1, 1), cB + hstep + kstep, voffB);
    PG8_WAIT_V(6); PG8_BAR;
    for (;;) {
        const bool has_next = S.next(ui + 1, nxt);
        const char* nA = cA; const char* nB = cB; if (has_next) { PG8_PTRS(nxt, nA, nB); }
        for (int t = 0; t < nt; t += 2) {
            const bool last = (t == nt - 2);
            const char* a1 = cA + (size_t)(t + 1) * kstep;
            const char* a2 = last ? nA : cA + (size_t)(t + 2) * kstep; const char* b2 = last ? nB : cB + (size_t)(t + 2) * kstep;
            const char* a3 = a2 + kstep; const char* b3 = b2 + kstep;
            PG8_LDB(B0, 0, 0); PG8_LDB(B1, 0, 1); PG8_SCHED; PG8_LDA(At, 0, 0); PG8_STAGE(PG8_SA(1, 1), a1 + hstep, voffA);
            PG8_WAIT_V(8); PG8_WAIT_L(0); PG8_BAR; PG8_MMA(0, 0, At, B0); PG8_MMA(0, 1, At, B1); PG8_BAR; PG8_SCHED;
            PG8_LDA(At, 0, 1); PG8_STAGE(PG8_SB(0, 0), b2, voffB); PG8_STAGE(PG8_SB(0, 1), b2 + hstep, voffB); PG8_STAGE(PG8_SA(0, 0), a2, voffA);
            PG8_WAIT_V(8); PG8_WAIT_L(0); PG8_BAR; PG8_MMA(1, 0, At, B0); PG8_MMA(1, 1, At, B1); PG8_BAR; PG8_SCHED;
            PG8_LDB(B0, 1, 0); PG8_LDB(B1, 1, 1); PG8_SCHED; PG8_LDA(At, 1, 0); PG8_STAGE(PG8_SA(0, 1), a2 + hstep, voffA);
            PG8_WAIT_V(8); PG8_WAIT_L(0); PG8_BAR; PG8_MMA(0, 0, At, B0); PG8_MMA(0, 1, At, B1); PG8_BAR; PG8_SCHED;
            PG8_LDA(At, 1, 1); PG8_STAGE(PG8_SB(1, 0), b3, voffB); PG8_STAGE(PG8_SB(1, 1), b3 + hstep, voffB); PG8_STAGE(PG8_SA(1, 0), a3, voffA);
            PG8_WAIT_V(8); PG8_WAIT_L(0); PG8_BAR; PG8_MMA(1, 0, At, B0); PG8_MMA(1, 1, At, B1); PG8_BAR; PG8_SCHED;
        }
        if constexpr (ALIGN_EPI) { if (wr == 0) PG8_BAR; }
        E(acc, cur, wr, wc, fr, fq);
        if (!has_next) break;
#pragma unroll
        for (int a = 0; a < 2; ++a)
#pragma unroll
            for (int b = 0; b < 2; ++b)
#pragma unroll
                for (int m = 0; m < 4; ++m)
#pragma unroll
                    for (int n = 0; n < 2; ++n) acc[a][b][m][n] = (f32x4){0.f, 0.f, 0.f, 0.f};
        cur = nxt; cA = nA; cB = nB; ++ui;
        if constexpr (ALIGN_EPI) { if (wr == 1) PG8_BAR; }
    }
    PG8_WAIT_V(0);
    if constexpr (!ALIGN_EPI) { if (wr == 0) PG8_BAR; }
    PG8_BAR;
#undef PG8_SA
#undef PG8_SB
#undef PG8_STAGE
#undef PG8_LDA
#undef PG8_LDB
#undef PG8_MMA
#undef PG8_WAIT_V
#undef PG8_WAIT_L
#undef PG8_BAR
#undef PG8_SCHED
#undef PG8_PTRS
}
}

__device__ __forceinline__ unsigned f2bf(float f) { unsigned u = __builtin_bit_cast(unsigned, f); return (u + 0x7fffu + ((u >> 16) & 1u)) >> 16; }
__device__ __forceinline__ unsigned pk2(float lo, float hi) { return f2bf(lo) | (f2bf(hi) << 16); }
__device__ __forceinline__ float bflo(unsigned w) { return __builtin_bit_cast(float, w << 16); }
__device__ __forceinline__ float bfhi(unsigned w) { return __builtin_bit_cast(float, w & 0xffff0000u); }
__device__ __forceinline__ float wave_sum(float v) {
#pragma unroll
    for (int o = 1; o < 64; o <<= 1) v += __shfl_xor(v, o);
    return v;
}

__device__ __forceinline__ void transpose_item(const float* W, int N, bf16_t* WT, int ldw, LAS float* scr, int kb, int nb, int lane) {
    const int k0 = 64 * kb, n0 = 32 * nb;
#pragma unroll 8
    for (int i = 0; i < 32; ++i) { const int kk = 2 * i + (lane >> 5); scr[kk * 33 + (lane & 31)] = W[(size_t)(k0 + kk) * N + n0 + (lane & 31)]; }
    asm volatile("s_waitcnt lgkmcnt(0)" ::: "memory");
    const int c = lane & 7;
#pragma unroll
    for (int j = 0; j < 4; ++j) { const int n = (lane >> 3) + 8 * j; const LAS float* s = scr + (8 * c) * 33 + n;
        u32x4 o; o.x = pk2(s[0 * 33], s[1 * 33]); o.y = pk2(s[2 * 33], s[3 * 33]); o.z = pk2(s[4 * 33], s[5 * 33]); o.w = pk2(s[6 * 33], s[7 * 33]);
        *(u32x4*)(WT + (size_t)(n0 + n) * ldw + k0 + 8 * c) = o; }
    asm volatile("s_waitcnt lgkmcnt(0)" ::: "memory");
}

struct Args {
    const float *x, *c, *ln_in_g, *ln_in_b, *w_ada, *b_ada, *w_in, *rpb, *w_pool, *pool_scale, *w_out, *ln1_g, *ln1_b, *w_mlp1, *w_mlp2, *ln2_g, *ln2_b;
    float* out; unsigned char* ws; int ph_lo, ph_hi;
};

__device__ __forceinline__ void p0_prologue(const Args& a, LAS unsigned char* lds, int G, int bid, int tid) {
    asm volatile("" : "+v"(tid));
    const int lane = tid & 63, wave = tid >> 6;
    unsigned char* ws = a.ws;
    float* mod = (float*)(ws + WS_MOD);
    for (int item = bid; item < 2 * (NMOD / 64); item += G) {
        const int l = item / (NMOD / 64), n0 = (item % (NMOD / 64)) * 64;
        LAS float* cact = (LAS float*)lds;
        LAS float* red = (LAS float*)(lds + 65536);
        for (int i = tid; i < BATCH * D; i += 512) { const int b = i >> 10, k = i & 1023; const float v = a.c[i]; cact[k * 16 + b] = v / (1.0f + expf(-v)); }
        __syncthreads();
        const int ks = tid >> 6, col = tid & 63;
        float acc[16];
#pragma unroll
        for (int b = 0; b < 16; ++b) acc[b] = 0.f;
        const float* wp = a.w_ada + (size_t)l * D * NMOD + (size_t)(ks * 128) * NMOD + n0 + col;
#pragma unroll 4
        for (int kk = 0; kk < 128; ++kk) {
            const float w = wp[(size_t)kk * NMOD];
            const LAS f32x4* cp = (const LAS f32x4*)(cact + (ks * 128 + kk) * 16);
#pragma unroll
            for (int q = 0; q < 4; ++q) { const f32x4 cv = cp[q]; acc[4 * q + 0] += cv.x * w; acc[4 * q + 1] += cv.y * w; acc[4 * q + 2] += cv.z * w; acc[4 * q + 3] += cv.w * w; }
        }
#pragma unroll
        for (int b = 0; b < 16; ++b) red[(ks * 16 + b) * 64 + col] = acc[b];
        __syncthreads();
        for (int o = tid; o < 1024; o += 512) { const int b = o >> 6, cc = o & 63; float s = 0.f;
#pragma unroll
            for (int k8 = 0; k8 < 8; ++k8) s += red[(k8 * 16 + b) * 64 + cc];
            mod[(size_t)(l * 16 + b) * NMOD + n0 + cc] = s + a.b_ada[l * NMOD + n0 + cc]; }
        __syncthreads();
    }
    for (int idx = bid * 512 + tid; idx < 2 * 4 * 16 * 1024; idx += G * 512) {
        const int l = idx >> 16, g = (idx >> 14) & 3, cch = (idx >> 10) & 15, n = idx & 1023;
        const float* wo = a.w_out + (size_t)l * D * D + (size_t)(512 + g * 128) * D + n;
        const float* wpl = a.w_pool + ((size_t)(l * 4 + g) * 128 + cch * 8) * 128;
        const float* ps = a.pool_scale + l * 512 + g * 128;
        float acc[8];
#pragma unroll
        for (int i = 0; i < 8; ++i) acc[i] = 0.f;
#pragma unroll 4
        for (int d = 0; d < 128; ++d) { const float v = wo[(size_t)d * D] * ps[d];
#pragma unroll
            for (int i = 0; i < 8; ++i) acc[i] += wpl[i * 128 + d] * v; }
        u32x4 o; o.x = pk2(acc[0], acc[1]); o.y = pk2(acc[2], acc[3]); o.z = pk2(acc[4], acc[5]); o.w = pk2(acc[6], acc[7]);
        *(u32x4*)((bf16_t*)(ws + WS_WOUT) + (size_t)l * D * D + (size_t)n * D + 512 + g * 128 + cch * 8) = o;
    }
    {
        LAS float* scr = (LAS float*)(lds + wave * 16384);
        const int gw = bid * 8 + wave, NGW = G * 8;
        constexpr int I_IN = 16 * 64, I_OUT = 8 * 32, I_1 = 16 * 128, I_2 = 64 * 32, I_L = I_IN + I_OUT + I_1 + I_2;
        for (int it = gw; it < 2 * I_L; it += NGW) {
            const int l = it / I_L; int r = it % I_L;
            if (r < I_IN) { transpose_item(a.w_in + (size_t)l * D * PROJ, PROJ, (bf16_t*)(ws + WS_WIN) + (size_t)l * PROJ * D, D, scr, r / 64, r % 64, lane); continue; } r -= I_IN;
            if (r < I_OUT) { transpose_item(a.w_out + (size_t)l * D * D, D, (bf16_t*)(ws + WS_WOUT) + (size_t)l * D * D, D, scr, r / 32, r % 32, lane); continue; } r -= I_OUT;
            if (r < I_1) { transpose_item(a.w_mlp1 + (size_t)l * D * FF, FF, (bf16_t*)(ws + WS_W1) + (size_t)l * FF * D, D, scr, r / 128, r % 128, lane); continue; } r -= I_1;
            transpose_item(a.w_mlp2 + (size_t)l * FF * D, D, (bf16_t*)(ws + WS_W2) + (size_t)l * D * FF, FF, scr, r / 32, r % 32, lane);
        }
    }
}

__device__ __forceinline__ void ln_phase(const float* src, float* dstX, bf16_t* dstH, const float* g, const float* bt, const float* sc, const float* sh, int G, int bid, int tid) {
    asm volatile("" : "+v"(tid));
    const int lane = tid & 63, wave = tid >> 6;
    const int gw = bid * 8 + wave, NGW = G * 8;
    const int rpw = (M + NGW - 1) / NGW;
    const int r0 = gw * rpw, r1 = (r0 + rpw < M) ? r0 + rpw : M;
    if (r0 >= M) return;
    f32x4 gv[4], bv[4], scv[4], shv[4];
#pragma unroll
    for (int j = 0; j < 4; ++j) { gv[j] = *(const f32x4*)(g + 4 * lane + 256 * j); bv[j] = *(const f32x4*)(bt + 4 * lane + 256 * j); scv[j] = (f32x4){0.f, 0.f, 0.f, 0.f}; shv[j] = scv[j]; }
    int curb = -1;
    f32x4 v[4], nx[4];
#pragma unroll
    for (int j = 0; j < 4; ++j) nx[j] = *(const f32x4*)(src + (size_t)r0 * D + 4 * lane + 256 * j);
    for (int r = r0; r < r1; ++r) {
#pragma unroll
        for (int j = 0; j < 4; ++j) v[j] = nx[j];
        if (r + 1 < r1) {
#pragma unroll
            for (int j = 0; j < 4; ++j) nx[j] = *(const f32x4*)(src + (size_t)(r + 1) * D + 4 * lane + 256 * j);
        }
        const int b = r >> 12;
        if (dstH && b != curb) { curb = b;
#pragma unroll
            for (int j = 0; j < 4; ++j) { scv[j] = *(const f32x4*)(sc + (size_t)b * NMOD + 4 * lane + 256 * j) + 1.0f; shv[j] = *(const f32x4*)(sh + (size_t)b * NMOD + 4 * lane + 256 * j); } }
        float s = 0.f;
#pragma unroll
        for (int j = 0; j < 4; ++j) s += (v[j].x + v[j].y) + (v[j].z + v[j].w);
        const float mean = wave_sum(s) * (1.f / D); float s2 = 0.f;
#pragma unroll
        for (int j = 0; j < 4; ++j) { v[j] = v[j] - mean; s2 += (v[j].x * v[j].x + v[j].y * v[j].y) + (v[j].z * v[j].z + v[j].w * v[j].w); }
        const float rstd = 1.f / sqrtf(wave_sum(s2) * (1.f / D) + LN_EPS);
#pragma unroll
        for (int j = 0; j < 4; ++j) {
            const f32x4 y = v[j] * rstd * gv[j] + bv[j];
            *(f32x4*)(dstX + (size_t)r * D + 4 * lane + 256 * j) = y;
            if (dstH) { const f32x4 h = y * scv[j] + shv[j]; u32x2 w; w.x = pk2(h.x, h.y); w.y = pk2(h.z, h.w); *(u32x2*)(dstH + (size_t)r * D + 4 * lane + 256 * j) = w; }
        }
    }
}

__device__ __forceinline__ void attn_pool_phase(LAS unsigned char* lds, const bf16_t* Qb, const bf16_t* Kb, const bf16_t* Vt, const bf16_t* Ub, bf16_t* cat, const float* rpb_l, int G, int bid, int tid) {
    asm volatile("" : "+v"(tid));
    LAS float* tab = (LAS float*)lds;
    for (int i = tid; i < NHEAD * RPB_N; i += 512) tab[i] = rpb_l[i] * LOG2E;
    __syncthreads();
    const int lane = tid & 63, h = __builtin_amdgcn_readfirstlane(tid >> 6), q16 = lane & 15, g4 = lane >> 4;
    const LAS float* tabh = tab + h * RPB_N;
    for (int unit = bid; unit < BATCH * 64; unit += G) {
        const int b = unit >> 6, r = unit & 63; const int rs = r < 4 ? 0 : (r > 60 ? 56 : r - 4);
        const size_t tok0 = (size_t)b * SEQ + r * 64;
#pragma unroll 1
        for (int j = 0; j < 4; ++j) {
            const int cb = (j == 0) ? 0 : (j == 1) ? 8 : (j == 2) ? 24 : 32;
            const int qc = 16 * j + q16; const int cs = qc < 8 ? 0 : (qc > 56 ? 48 : qc - 8);
            const bf16_t* qp = Qb + (tok0 + qc) * AW + h * 64 + g4 * 8;
            const bf16x8 q0 = *(const bf16x8*)qp, q1 = *(const bf16x8*)(qp + 32);
            f32x4 s[8][2];
            float mx = -1e30f;
#pragma unroll
            for (int i = 0; i < 8; ++i)
#pragma unroll
                for (int hh = 0; hh < 2; ++hh) {
                    const bf16_t* kp = Kb + ((size_t)b * SEQ + (rs + i) * 64 + cb + hh * 16 + q16) * AW + h * 64 + g4 * 8;
                    const bf16x8 k0 = *(const bf16x8*)kp, k1 = *(const bf16x8*)(kp + 32);
                    f32x4 acc = (f32x4){0.f, 0.f, 0.f, 0.f};
                    acc = __builtin_amdgcn_mfma_f32_16x16x32_bf16(k0, q0, acc, 0, 0, 0);
                    acc = __builtin_amdgcn_mfma_f32_16x16x32_bf16(k1, q1, acc, 0, 0, 0);
                    const LAS float* trow = tabh + (rs + i - r + 7) * RPB_W;
#pragma unroll
                    for (int jj = 0; jj < 4; ++jj) {
                        const int kc = cb + hh * 16 + g4 * 4 + jj; const bool valid = (kc >= cs) && (kc < cs + 16);
                        int bi = kc - qc + 15; bi = bi < 0 ? 0 : (bi > 30 ? 30 : bi);
                        const float sv = valid ? acc[jj] + trow[bi] : -1e30f;
                        acc[jj] = sv; mx = fmaxf(mx, sv);
                    }
                    s[i][hh] = acc;
                }
            mx = fmaxf(mx, __shfl_xor(mx, 16)); mx = fmaxf(mx, __shfl_xor(mx, 32));
            float sum = 0.f;
#pragma unroll
            for (int i = 0; i < 8; ++i)
#pragma unroll
                for (int hh = 0; hh < 2; ++hh)
#pragma unroll
                    for (int jj = 0; jj < 4; ++jj) { const float p = __builtin_amdgcn_exp2f(s[i][hh][jj] - mx); s[i][hh][jj] = p; sum += p; }
            sum += __shfl_xor(sum, 16); sum += __shfl_xor(sum, 32);
            f32x4 o[4];
#pragma unroll
            for (int db = 0; db < 4; ++db) o[db] = (f32x4){0.f, 0.f, 0.f, 0.f};
#pragma unroll
            for (int i = 0; i < 8; ++i) {
                u32x4 pw; pw.x = pg8::cvt_pk_bf16(s[i][0][0], s[i][0][1]); pw.y = pg8::cvt_pk_bf16(s[i][0][2], s[i][0][3]); pw.z = pg8::cvt_pk_bf16(s[i][1][0], s[i][1][1]); pw.w = pg8::cvt_pk_bf16(s[i][1][2], s[i][1][3]);
                const bf16x8 pf = __builtin_bit_cast(bf16x8, pw);
#pragma unroll
                for (int db = 0; db < 4; ++db) {
                    const bf16_t* vp = Vt + ((size_t)(b * 512 + h * 64 + db * 16 + q16)) * SEQ + (rs + i) * 64 + cb + g4 * 4;
                    const u32x2 vlo = *(const u32x2*)vp, vhi = *(const u32x2*)(vp + 16);
                    u32x4 vw; vw.x = vlo.x; vw.y = vlo.y; vw.z = vhi.x; vw.w = vhi.y;
                    o[db] = __builtin_amdgcn_mfma_f32_16x16x32_bf16(__builtin_bit_cast(bf16x8, vw), pf, o[db], 0, 0, 0);
                }
            }
            const float inv = 1.0f / sum;
            bf16_t* op = cat + (tok0 + qc) * D + h * 64 + g4 * 4;
#pragma unroll
            for (int db = 0; db < 4; ++db) { u32x2 w; w.x = pg8::cvt_pk_bf16(o[db][0] * inv, o[db][1] * inv); w.y = pg8::cvt_pk_bf16(o[db][2] * inv, o[db][3] * inv); *(u32x2*)(op + db * 16) = w; }
        }
        {
            const int tok = tid >> 3; const int t = r * 64 + tok;
#pragma unroll 1
            for (int it = 0; it < 8; ++it) {
                const int ch8 = (tid & 7) + 8 * it, gidx = it >> 1, w = 2 << gidx;
                int lo = t - (w >> 1), hi = lo + w; lo = lo < 0 ? 0 : lo; hi = hi > SEQ ? SEQ : hi;
                const bf16_t* up = Ub + ((size_t)b * SEQ) * AW + ch8 * 8;
                float accp[8];
#pragma unroll
                for (int e = 0; e < 8; ++e) accp[e] = 0.f;
                for (int tt = lo; tt < hi; ++tt) { const u32x4 uv = *(const u32x4*)(up + (size_t)tt * AW);
                    accp[0] += bflo(uv.x); accp[1] += bfhi(uv.x); accp[2] += bflo(uv.y); accp[3] += bfhi(uv.y); accp[4] += bflo(uv.z); accp[5] += bfhi(uv.z); accp[6] += bflo(uv.w); accp[7] += bfhi(uv.w); }
                const u32x4 uc = *(const u32x4*)(up + (size_t)t * AW); const float ic = 1.0f / (float)(hi - lo);
                u32x4 o;
                o.x = pk2(accp[0] * ic - bflo(uc.x), accp[1] * ic - bfhi(uc.x)); o.y = pk2(accp[2] * ic - bflo(uc.y), accp[3] * ic - bfhi(uc.y));
                o.z = pk2(accp[4] * ic - bflo(uc.z), accp[5] * ic - bfhi(uc.z)); o.w = pk2(accp[6] * ic - bflo(uc.w), accp[7] * ic - bfhi(uc.w));
                *(u32x4*)(cat + (tok0 + tok) * D + 512 + ch8 * 8) = o;
            }
        }
    }
}

constexpr int N_PHASES = 2 + 7 * DEPTH;
__global__ void __launch_bounds__(512, 2) fwd_megakernel(Args a) {
    extern __shared__ __attribute__((aligned(16))) unsigned char lds_raw[];
    LAS unsigned char* lds = (LAS unsigned char*)lds_raw;
    cg::grid_group grid = cg::this_grid();
    const int tid = threadIdx.x, bid = blockIdx.x, G = gridDim.x;
    unsigned char* ws = a.ws;
    float* X = (float*)(ws + WS_X); bf16_t* H = (bf16_t*)(ws + WS_H); bf16_t* F = (bf16_t*)(ws + WS_F);
    bf16_t* Qb = (bf16_t*)(ws + WS_Q); bf16_t* Kb = (bf16_t*)(ws + WS_K); bf16_t* Vt = (bf16_t*)(ws + WS_VT); bf16_t* Ub = (bf16_t*)(ws + WS_U); bf16_t* CAT = (bf16_t*)(ws + WS_CAT);
    const float* mod = (const float*)(ws + WS_MOD);
    const int lo = a.ph_lo, hi = a.ph_hi;
#define IN(k) (lo <= (k) && (k) < hi)
#define SEAM(k) do { if (IN(k) && IN((k) + 1)) grid.sync(); } while (0)

    if (IN(0)) { p0_prologue(a, lds, G, bid, tid); }
    SEAM(0);
    if (IN(1)) { ln_phase(a.x, X, H, a.ln_in_g, a.ln_in_b, mod + 1 * D, mod + 0 * D, G, bid, tid); }
    SEAM(1);
#pragma unroll 1
    for (int l = 0; l < DEPTH; ++l) {
        const int p = 2 + 7 * l;
        const float* modl = mod + (size_t)l * BATCH * NMOD;
        if (IN(p + 0)) {
            pg8::Gemm g{H, (const bf16_t*)(ws + WS_WIN) + (size_t)l * PROJ * D, M, PROJ, D}; pg8::StaticOrder S; S.init(M, PROJ, G, bid);
            pg8::EpiProj E{Qb, Kb, Vt, Ub};
            pg8::gemm_phase<pg8::EpiProj, true>(lds, g, S, E);
        }
        SEAM(p + 0);
        if (IN(p + 1)) { attn_pool_phase(lds, Qb, Kb, Vt, Ub, CAT, a.rpb + (size_t)l * NHEAD * RPB_N, G, bid, tid); }
        SEAM(p + 1);
        if (IN(p + 2)) {
            pg8::Gemm g{CAT, (const bf16_t*)(ws + WS_WOUT) + (size_t)l * D * D, M, D, D}; pg8::StaticOrder S; S.init(M, D, G, bid);
            pg8::EpiRes E{X, modl + 2 * D};
            pg8::gemm_phase<pg8::EpiRes, true>(lds, g, S, E);
        }
        SEAM(p + 2);
        if (IN(p + 3)) { ln_phase(X, X, H, a.ln1_g + l * D, a.ln1_b + l * D, modl + 4 * D, modl + 3 * D, G, bid, tid); }
        SEAM(p + 3);
        if (IN(p + 4)) {
            pg8::Gemm g{H, (const bf16_t*)(ws + WS_W1) + (size_t)l * FF * D, M, FF, D}; pg8::StaticOrder S; S.init(M, FF, G, bid);
            pg8::EpiRelu2 E{F, FF};
            pg8::gemm_phase<pg8::EpiRelu2, true>(lds, g, S, E);
        }
        SEAM(p + 4);
        if (IN(p + 5)) {
            pg8::Gemm g{F, (const bf16_t*)(ws + WS_W2) + (size_t)l * D * FF, M, D, FF}; pg8::StaticOrder S; S.init(M, D, G, bid);
            pg8::EpiRes E{X, modl + 5 * D};
            pg8::gemm_phase<pg8::EpiRes, true>(lds, g, S, E);
        }
        SEAM(p + 5);
        if (IN(p + 6)) {
            const bool lastl = (l == DEPTH - 1);
            const float* modn = mod + (size_t)(lastl ? l : l + 1) * BATCH * NMOD;
            ln_phase(X, lastl ? a.out : X, lastl ? (bf16_t*)nullptr : H, a.ln2_g + l * D, a.ln2_b + l * D, modn + 1 * D, modn + 0 * D, G, bid, tid);
        }
        SEAM(p + 6);
    }
#undef IN
#undef SEAM
}

extern "C" void kernel_launch(void* const* d_in, const int* in_sizes, int n_in, void* d_out, int out_size, void* d_ws, size_t ws_size, hipStream_t stream) {
    static int grid = 0;
    if (grid == 0) {
        if (n_in != 17 || in_sizes[0] != M * D || out_size != M * D || ws_size < WS_END) { fprintf(stderr, "kernel_launch: unexpected shapes / workspace (n_in %d, in0 %d, out %d, ws %zu)\n", n_in, n_in > 0 ? in_sizes[0] : -1, out_size, ws_size); grid = -1; return; }
        int dev = 0, cus = 0, per_cu = 0;
        hipGetDevice(&dev); hipDeviceGetAttribute(&cus, hipDeviceAttributeMultiprocessorCount, dev);
        if (hipFuncSetAttribute((const void*)fwd_megakernel, hipFuncAttributeMaxDynamicSharedMemorySize, LDS_BYTES) != hipSuccess) { fprintf(stderr, "kernel_launch: hipFuncSetAttribute failed\n"); grid = -1; return; }
        if (hipOccupancyMaxActiveBlocksPerMultiprocessor(&per_cu, (const void*)fwd_megakernel, 512, LDS_BYTES) != hipSuccess || per_cu < 1) { per_cu = 1; (void)hipGetLastError(); }
        grid = (cus > 0 ? cus : 256) * per_cu;
    }
    if (grid < 0) return;
    Args a{};
    a.x = (const float*)d_in[0]; a.c = (const float*)d_in[1]; a.ln_in_g = (const float*)d_in[2]; a.ln_in_b = (const float*)d_in[3]; a.w_ada = (const float*)d_in[4]; a.b_ada = (const float*)d_in[5];
    a.w_in = (const float*)d_in[6]; a.rpb = (const float*)d_in[7]; a.w_pool = (const float*)d_in[8]; a.pool_scale = (const float*)d_in[9]; a.w_out = (const float*)d_in[10];
    a.ln1_g = (const float*)d_in[11]; a.ln1_b = (const float*)d_in[12]; a.w_mlp1 = (const float*)d_in[13]; a.w_mlp2 = (const float*)d_in[14]; a.ln2_g = (const float*)d_in[15]; a.ln2_b = (const float*)d_in[16];
    a.out = (float*)d_out; a.ws = (unsigned char*)d_ws;
#if MK_MULTI
    for (int p = 0; p < N_PHASES; ++p) { a.ph_lo = p; a.ph_hi = p + 1; hipLaunchKernelGGL(fwd_megakernel, dim3(grid), dim3(512), LDS_BYTES, stream, a); }
#else
    a.ph_lo = 0; a.ph_hi = N_PHASES;
    void* args[] = {&a};
    hipError_t e = hipLaunchCooperativeKernel((const void*)fwd_megakernel, dim3(grid), dim3(512), args, LDS_BYTES, stream);
    if (e != hipSuccess) fprintf(stderr, "kernel_launch: cooperative launch failed: %s (grid %d)\n", hipGetErrorString(e), grid);
#endif
}
```

```cpp
#include <hip/hip_runtime.h>
#include <hip/hip_cooperative_groups.h>
#include <cstdio>
#include <cstdint>
namespace cg = cooperative_groups;

#define LAS __attribute__((address_space(3)))
typedef unsigned short bf16_t;
typedef short bf16x8 __attribute__((ext_vector_type(8)));
typedef float f32x4 __attribute__((ext_vector_type(4)));
typedef float f32x2 __attribute__((ext_vector_type(2)));
typedef unsigned u32x4 __attribute__((ext_vector_type(4)));
typedef unsigned u32x2 __attribute__((ext_vector_type(2)));

#ifndef MK_MULTI
#define MK_MULTI 0
#endif

constexpr int BATCH = 16, SEQ = 4096, D = 1024, DEPTH = 2, M = BATCH * SEQ;
constexpr int PROJ = 2048, FF = 4096, NMOD = 6 * D, AW = 512;
constexpr int NHEAD = 8;
constexpr float LN_EPS = 1e-5f;
constexpr float DN_ALPHA = 1.41421356237309515f;
constexpr float LOG2E = 1.44269504088896341f;
constexpr float QSCALE = 0.125f * LOG2E;
constexpr int RPB_H = 15, RPB_W = 31, RPB_N = RPB_H * RPB_W;

constexpr size_t MiB = (size_t)1 << 20;
constexpr size_t WS_WIN = 0 * MiB;
constexpr size_t WS_WOUT = 8 * MiB;
constexpr size_t WS_W1 = 12 * MiB;
constexpr size_t WS_W2 = 28 * MiB;
constexpr size_t WS_MOD = 44 * MiB;
constexpr size_t WS_X = 48 * MiB;
constexpr size_t WS_H = 304 * MiB;
constexpr size_t WS_F = 432 * MiB;
constexpr size_t WS_Q = 432 * MiB;
constexpr size_t WS_K = 496 * MiB;
constexpr size_t WS_VT = 560 * MiB;
constexpr size_t WS_U = 624 * MiB;
constexpr size_t WS_CAT = 688 * MiB;
constexpr size_t WS_END = 944 * MiB;

constexpr int LDS_BYTES = 147456;

namespace pg8 {
constexpr int BM = 256, BK = 64, HALF = 128, HTB = HALF * BK * 2, STAGE_BYTES = 8 * HTB, NXCD = 8, WGM = 8;
__host__ __device__ __forceinline__ int lds_byte(int r, int c) { const int st = (r >> 4) * 2 + (c >> 5), rr = r & 15, cc = c & 31, ob = rr * 64 + cc * 2; return st * 1024 + (ob ^ (((ob >> 9) & 1) << 5)); }
__host__ __device__ __forceinline__ void stage_rc(int b, int& R, int& C) { const int st = b / 1024, sb = b % 1024, swz = sb ^ (((sb >> 9) & 1) << 5); R = (st >> 1) * 16 + swz / 64; C = (st & 1) * 32 + (swz % 64) / 2; }
__host__ __device__ __forceinline__ int perm32(int rho) { const int n = rho >> 4, i = rho & 15; return 8 * (i >> 2) + 4 * n + (i & 3); }

struct Unit { int pm, pn; };
struct Gemm { const bf16_t* A; const bf16_t* Bt; int M, N, K; };

struct StaticOrder {
    int nM, nN, nwg, G, c;
    __device__ void init(int M_, int N_, int G_, int c_) { nM = M_ / BM; nN = N_ / BM; nwg = nM * nN; G = G_; c = c_; }
    __device__ bool next(int i, Unit& u) const {
        const long L = (long)i * G + c; if (L >= nwg) return false;
        int wgid = (int)L; { const int q = nwg / NXCD, r = nwg % NXCD, xcd = wgid % NXCD, off = wgid / NXCD; wgid = (xcd < r ? xcd * (q + 1) : r * (q + 1) + (xcd - r) * q) + off; }
        const int nig = WGM * nN, gid = wgid / nig, fm = gid * WGM, gsz = (nM - fm) < WGM ? (nM - fm) : WGM;
        u.pm = fm + ((wgid % nig) % gsz); u.pn = (wgid % nig) / gsz; return true;
    }
};

__device__ __forceinline__ unsigned cvt_pk_bf16(float lo, float hi) { unsigned r; asm volatile("v_cvt_pk_bf16_f32 %0, %1, %2" : "=v"(r) : "v"(lo), "v"(hi)); return r; }

struct EpiProj {
    static constexpr bool PERM = true, VSWAP = true;
    bf16_t* Q; bf16_t* Kb; bf16_t* Vt; bf16_t* U;
    __device__ __forceinline__ void operator()(const f32x4 (&acc)[2][2][4][2], const Unit& u, int wr, int wc, int fr, int fq) const {
        const int t = u.pn >> 1;
        if (t == 2) {
            const int dg0 = (u.pn & 1) * 256 + wr * 64 + fr; const int b = u.pm >> 4; const int s0 = (u.pm & 15) * 256 + wc * 32 + 8 * fq;
#pragma unroll
            for (int ai = 0; ai < 2; ++ai)
#pragma unroll
                for (int m = 0; m < 4; ++m) { bf16_t* rowp = Vt + (size_t)(b * 512 + dg0 + ai * HALF + m * 16) * SEQ + s0;
#pragma unroll
                    for (int bj = 0; bj < 2; ++bj) { const f32x4 v0 = acc[ai][bj][m][0], v1 = acc[ai][bj][m][1];
                        u32x4 w; w.x = cvt_pk_bf16(v0[0], v0[1]); w.y = cvt_pk_bf16(v0[2], v0[3]); w.z = cvt_pk_bf16(v1[0], v1[1]); w.w = cvt_pk_bf16(v1[2], v1[3]);
                        *(u32x4*)(rowp + bj * HALF) = w; } }
        } else {
            bf16_t* base = Q + (size_t)t * ((size_t)M * AW); const float sc = t == 0 ? QSCALE : 1.0f;
            const int row0 = u.pm * BM + wr * 64 + fr, col0 = (u.pn & 1) * 256 + wc * 32 + 8 * fq;
#pragma unroll
            for (int ai = 0; ai < 2; ++ai)
#pragma unroll
                for (int m = 0; m < 4; ++m) { bf16_t* rowp = base + (size_t)(row0 + ai * HALF + m * 16) * AW + col0;
#pragma unroll
                    for (int bj = 0; bj < 2; ++bj) { const f32x4 v0 = acc[ai][bj][m][0] * sc, v1 = acc[ai][bj][m][1] * sc;
                        u32x4 w; w.x = cvt_pk_bf16(v0[0], v0[1]); w.y = cvt_pk_bf16(v0[2], v0[3]); w.z = cvt_pk_bf16(v1[0], v1[1]); w.w = cvt_pk_bf16(v1[2], v1[3]);
                        *(u32x4*)(rowp + bj * HALF) = w; } }
        }
    }
};
struct EpiRelu2 {
    static constexpr bool PERM = true, VSWAP = false;
    bf16_t* O; int ldc;
    __device__ __forceinline__ void operator()(const f32x4 (&acc)[2][2][4][2], const Unit& u, int wr, int wc, int fr, int fq) const {
        const int row0 = u.pm * BM + wr * 64 + fr, col0 = u.pn * BM + wc * 32 + 8 * fq;
#pragma unroll
        for (int ai = 0; ai < 2; ++ai)
#pragma unroll
            for (int m = 0; m < 4; ++m) { bf16_t* rowp = O + (size_t)(row0 + ai * HALF + m * 16) * ldc + col0;
#pragma unroll
                for (int bj = 0; bj < 2; ++bj) { f32x4 v0 = acc[ai][bj][m][0], v1 = acc[ai][bj][m][1];
#pragma unroll
                    for (int j = 0; j < 4; ++j) { const float a = fmaxf(v0[j], 0.f), b = fmaxf(v1[j], 0.f); v0[j] = a * a; v1[j] = b * b; }
                    u32x4 w; w.x = cvt_pk_bf16(v0[0], v0[1]); w.y = cvt_pk_bf16(v0[2], v0[3]); w.z = cvt_pk_bf16(v1[0], v1[1]); w.w = cvt_pk_bf16(v1[2], v1[3]);
                    *(u32x4*)(rowp + bj * HALF) = w; } }
    }
};
struct EpiRes {
    static constexpr bool PERM = true, VSWAP = false;
    bf16_t* H; const float* mod; int sh_off, sc_off, g_off;
    __device__ __forceinline__ void operator()(const f32x4 (&acc)[2][2][4][2], const Unit& u, int wr, int wc, int fr, int fq) const {
        const int row0 = u.pm * BM + wr * 64 + fr, col0 = u.pn * BM + wc * 32 + 8 * fq; const int b = u.pm >> 4;
        const float* mb = mod + (size_t)b * NMOD + col0;
        f32x4 shv[2][2], aiv[2][2], g1v[2][2];
#pragma unroll
        for (int bj = 0; bj < 2; ++bj)
#pragma unroll
            for (int n = 0; n < 2; ++n) { shv[bj][n] = *(const f32x4*)(mb + sh_off + bj * HALF + 4 * n); const f32x4 s1 = *(const f32x4*)(mb + sc_off + bj * HALF + 4 * n) + 1.0f;
                aiv[bj][n] = (f32x4){DN_ALPHA / s1.x, DN_ALPHA / s1.y, DN_ALPHA / s1.z, DN_ALPHA / s1.w}; g1v[bj][n] = *(const f32x4*)(mb + g_off + bj * HALF + 4 * n) + 1.0f; }
#pragma unroll
        for (int ai = 0; ai < 2; ++ai)
#pragma unroll
            for (int m = 0; m < 4; ++m) { bf16_t* rowp = H + (size_t)(row0 + ai * HALF + m * 16) * D + col0;
#pragma unroll
                for (int bj = 0; bj < 2; ++bj) { const u32x4 hw = *(const u32x4*)(rowp + bj * HALF);
                    f32x4 h0, h1; h0.x = __builtin_bit_cast(float, hw.x << 16); h0.y = __builtin_bit_cast(float, hw.x & 0xffff0000u); h0.z = __builtin_bit_cast(float, hw.y << 16); h0.w = __builtin_bit_cast(float, hw.y & 0xffff0000u);
                    h1.x = __builtin_bit_cast(float, hw.z << 16); h1.y = __builtin_bit_cast(float, hw.z & 0xffff0000u); h1.z = __builtin_bit_cast(float, hw.w << 16); h1.w = __builtin_bit_cast(float, hw.w & 0xffff0000u);
                    const f32x4 z0 = (h0 - shv[bj][0]) * aiv[bj][0] + g1v[bj][0] * acc[ai][bj][m][0], z1 = (h1 - shv[bj][1]) * aiv[bj][1] + g1v[bj][1] * acc[ai][bj][m][1];
                    u32x4 w; w.x = cvt_pk_bf16(z0[0], z0[1]); w.y = cvt_pk_bf16(z0[2], z0[3]); w.z = cvt_pk_bf16(z1[0], z1[1]); w.w = cvt_pk_bf16(z1[2], z1[3]);
                    *(u32x4*)(rowp + bj * HALF) = w; }
                asm volatile("" ::: "memory"); }
    }
};

template <class Epi, bool ALIGN_EPI>
__device__ __forceinline__ void gemm_phase(LAS unsigned char* lds, const Gemm g, const StaticOrder& S, const Epi& E) {
    int tid = threadIdx.x; asm volatile("" : "+v"(tid));
    const int wid = __builtin_amdgcn_readfirstlane(tid >> 6), lane = tid & 63, wr = wid >> 2, wc = wid & 3, fr = lane & 15, fq = lane >> 4;
    const int K = g.K, nt = K / BK;
    unsigned voffA[2], voffB[2];
#pragma unroll
    for (int i = 0; i < 2; ++i) { int R, C; stage_rc(tid * 16 + i * 8192, R, C); const int Rb = Epi::PERM ? ((R & ~31) + perm32(R & 31)) : R;
        voffA[i] = (unsigned)(R * K + C) * 2u; voffB[i] = (unsigned)(Rb * K + C) * 2u; }
    const size_t kstep = (size_t)(BK * 2);
    const size_t hstep = (size_t)HALF * K * 2;
    const size_t tstep = 2 * hstep;
    const unsigned ldsw = (unsigned)wid * 1024u;
    const int aoff = lds_byte(wr * 64 + fr, fq * 8), boff = lds_byte(wc * 32 + fr, fq * 8);
#define PG8_SA(b, h) (((b) * 2 + (h)) * HTB)
#define PG8_SB(b, h) ((4 + (b) * 2 + (h)) * HTB)
#define PG8_STAGE(bufoff, gbase, voff) do { _Pragma("unroll") for (int _i = 0; _i < 2; ++_i) \
        __builtin_amdgcn_global_load_lds((const unsigned*)((const char*)(gbase) + (voff)[_i]), (LAS unsigned*)(lds + (bufoff) + ldsw + _i * 8192), 16, 0, 0); } while (0)
#define PG8_LDA(dst, b, h) do { _Pragma("unroll") for (int m = 0; m < 4; ++m) _Pragma("unroll") for (int k = 0; k < 2; ++k) dst[m][k] = *(const LAS bf16x8*)(lds + PG8_SA(b, h) + aoff + m * 2048 + k * 1024); } while (0)
#define PG8_LDB(dst, b, h) do { _Pragma("unroll") for (int n = 0; n < 2; ++n) _Pragma("unroll") for (int k = 0; k < 2; ++k) dst[n][k] = *(const LAS bf16x8*)(lds + PG8_SB(b, h) + boff + n * 2048 + k * 1024); } while (0)
#define PG8_MMA(ai, bj, At, Bt) do { __builtin_amdgcn_s_setprio(1); _Pragma("unroll") for (int m = 0; m < 4; ++m) _Pragma("unroll") for (int n = 0; n < 2; ++n) _Pragma("unroll") for (int k = 0; k < 2; ++k) \
        acc[ai][bj][m][n] = __builtin_amdgcn_mfma_f32_16x16x32_bf16(Bt[n][k], At[m][k], acc[ai][bj][m][n], 0, 0, 0); __builtin_amdgcn_s_setprio(0); } while (0)
#define PG8_WAIT_V(n) asm volatile("s_waitcnt vmcnt(" #n ")" ::: "memory")
#define PG8_WAIT_L(n) asm volatile("s_waitcnt lgkmcnt(" #n ")" ::: "memory")
#define PG8_BAR __builtin_amdgcn_s_barrier()
#define PG8_SCHED __builtin_amdgcn_sched_barrier(0)
#define PG8_PTRS(u, pa, pb) do { const bool _sw = Epi::VSWAP && (((u).pn >> 1) == 2); const char* _a = (const char*)g.A + (size_t)(u).pm * tstep; const char* _b = (const char*)g.Bt + (size_t)(u).pn * tstep; pa = _sw ? _b : _a; pb = _sw ? _a : _b; } while (0)
    Unit cur, nxt; int ui = 0;
    if (!S.next(0, cur)) return;
    f32x4 acc[2][2][4][2];
#pragma unroll
    for (int a = 0; a < 2; ++a)
#pragma unroll
        for (int b = 0; b < 2; ++b)
#pragma unroll
            for (int m = 0; m < 4; ++m)
#pragma unroll
                for (int n = 0; n < 2; ++n) acc[a][b][m][n] = (f32x4){0.f, 0.f, 0.f, 0.f};
    bf16x8 At[4][2], B0[2][2], B1[2][2];
    const char* cA; const char* cB; PG8_PTRS(cur, cA, cB);
    PG8_STAGE(PG8_SB(0, 0), cB, voffB); PG8_STAGE(PG8_SB(0, 1), cB + hstep, voffB); PG8_STAGE(PG8_SA(0, 0), cA, voffA); PG8_STAGE(PG8_SA(0, 1), cA + hstep, voffA);
    if (wr == 1) PG8_BAR;
    PG8_WAIT_V(2); PG8_BAR;
    PG8_STAGE(PG8_SB(1, 0), cB + kstep, voffB); PG8_STAGE(PG8_SA(1, 0), cA + kstep, voffA); PG8_STAGE(PG8_SB(1, 1), cB + hstep + kstep, voffB);
    PG8_WAIT_V(6); PG8_BAR;
    for (;;) {
        const bool has_next = S.next(ui + 1, nxt);
        const char* nA = cA; const char* nB = cB; if (has_next) { PG8_PTRS(nxt, nA, nB); }
        for (int t = 0; t < nt; t += 2) {
            const bool last = (t == nt - 2);
            const char* a1 = cA + (size_t)(t + 1) * kstep;
            const char* a2 = last ? nA : cA + (size_t)(t + 2) * kstep; const char* b2 = last ? nB : cB + (size_t)(t + 2) * kstep;
            const char* a3 = a2 + kstep; const char* b3 = b2 + kstep;
            PG8_LDB(B0, 0, 0); PG8_LDB(B1, 0, 1); PG8_SCHED; PG8_LDA(At, 0, 0); PG8_STAGE(PG8_SA(1, 1), a1 + hstep, voffA);
            PG8_WAIT_V(8); PG8_WAIT_L(0); PG8_BAR; PG8_MMA(0, 0, At, B0); PG8_MMA(0, 1, At, B1); PG8_BAR; PG8_SCHED;
            PG8_LDA(At, 0, 1); PG8_STAGE(PG8_SB(0, 0), b2, voffB); PG8_STAGE(PG8_SB(0, 1), b2 + hstep, voffB); PG8_STAGE(PG8_SA(0, 0), a2, voffA);
            PG8_WAIT_V(8); PG8_WAIT_L(0); PG8_BAR; PG8_MMA(1, 0, At, B0); PG8_MMA(1, 1, At, B1); PG8_BAR; PG8_SCHED;
            PG8_LDB(B0, 1, 0); PG8_LDB(B1, 1, 1); PG8_SCHED; PG8_LDA(At, 1, 0); PG8_STAGE(PG8_SA(0, 1), a2 + hstep, voffA);
            PG8_WAIT_V(8); PG8_WAIT_L(0); PG8_BAR; PG8_MMA(0, 0, At, B0); PG8_MMA(0, 1, At, B1); PG8_BAR; PG8_SCHED;
            PG8_LDA(At, 1, 1); PG8_STAGE(PG8_SB(1, 0), b3, voffB); PG8_STAGE(PG8_SB(1, 1), b3 + hstep, voffB); PG8_STAGE(PG8_SA(1, 0), a3, voffA);
            PG8_WAIT_V(8); PG8_WAIT_L(0); PG8_BAR; PG8_MMA(1, 0, At, B0); PG8_MMA(1, 1, At, B1); PG8_BAR; PG8_SCHED;
        }
        if constexpr (ALIGN_EPI) { if (wr == 0) PG8_BAR; }
        E(acc, cur, wr, wc, fr, fq);
        if (!has_next) break;
#pragma unroll
        for (int a = 0; a < 2; ++a)
#pragma unroll
            for (int b = 0; b < 2; ++b)
#pragma unroll
                for (int m = 0; m < 4; ++m)
#pragma unroll
                    for (int n = 0; n < 2; ++n) acc[a][b][m][n] = (f32x4){0.f, 0.f, 0.f, 0.f};
        cur = nxt; cA = nA; cB = nB; ++ui;
        if constexpr (ALIGN_EPI) { if (wr == 1) PG8_BAR; }
    }
    PG8_WAIT_V(0);
    if constexpr (!ALIGN_EPI) { if (wr == 0) PG8_BAR; }
    PG8_BAR;
#undef PG8_SA
#undef PG8_SB
#undef PG8_STAGE
#undef PG8_LDA
#undef PG8_LDB
#undef PG8_MMA
#undef PG8_WAIT_V
#undef PG8_WAIT_L
#undef PG8_BAR
#undef PG8_SCHED
#undef PG8_PTRS
}
}

__device__ __forceinline__ unsigned f2bf(float f) { unsigned u = __builtin_bit_cast(unsigned, f); return (u + 0x7fffu + ((u >> 16) & 1u)) >> 16; }
__device__ __forceinline__ unsigned pk2(float lo, float hi) { return f2bf(lo) | (f2bf(hi) << 16); }
__device__ __forceinline__ float bflo(unsigned w) { return __builtin_bit_cast(float, w << 16); }
__device__ __forceinline__ float bfhi(unsigned w) { return __builtin_bit_cast(float, w & 0xffff0000u); }
__device__ __forceinline__ float wave_sum(float v) {
#pragma unroll
    for (int o = 1; o < 64; o <<= 1) v += __shfl_xor(v, o);
    return v;
}

__device__ __forceinline__ void transpose_item(const float* W, int N, bf16_t* WT, int ldw, LAS float* scr, int kb, int nb, int lane) {
    const int k0 = 64 * kb, n0 = 32 * nb;
#pragma unroll 8
    for (int i = 0; i < 32; ++i) { const int kk = 2 * i + (lane >> 5); scr[kk * 33 + (lane & 31)] = W[(size_t)(k0 + kk) * N + n0 + (lane & 31)]; }
    asm volatile("s_waitcnt lgkmcnt(0)" ::: "memory");
    const int c = lane & 7;
#pragma unroll
    for (int j = 0; j < 4; ++j) { const int n = (lane >> 3) + 8 * j; const LAS float* s = scr + (8 * c) * 33 + n;
        u32x4 o; o.x = pk2(s[0 * 33], s[1 * 33]); o.y = pk2(s[2 * 33], s[3 * 33]); o.z = pk2(s[4 * 33], s[5 * 33]); o.w = pk2(s[6 * 33], s[7 * 33]);
        *(u32x4*)(WT + (size_t)(n0 + n) * ldw + k0 + 8 * c) = o; }
    asm volatile("s_waitcnt lgkmcnt(0)" ::: "memory");
}

struct Args {
    const float *x, *c, *ln_in_g, *ln_in_b, *w_ada, *b_ada, *w_in, *rpb, *w_pool, *pool_scale, *w_out, *ln1_g, *ln1_b, *w_mlp1, *w_mlp2, *ln2_g, *ln2_b;
    float* out; unsigned char* ws; int ph_lo, ph_hi;
};

__device__ __forceinline__ void p0_prologue(const Args& a, LAS unsigned char* lds, int G, int bid, int tid) {
    asm volatile("" : "+v"(tid));
    const int lane = tid & 63, wave = tid >> 6;
    unsigned char* ws = a.ws;
    float* mod = (float*)(ws + WS_MOD);
    for (int item = bid; item < 2 * (NMOD / 64); item += G) {
        const int l = item / (NMOD / 64), n0 = (item % (NMOD / 64)) * 64;
        LAS float* cact = (LAS float*)lds;
        LAS float* red = (LAS float*)(lds + 65536);
        for (int i = tid; i < BATCH * D; i += 512) { const int b = i >> 10, k = i & 1023; const float v = a.c[i]; cact[k * 16 + b] = v / (1.0f + expf(-v)); }
        __syncthreads();
        const int ks = tid >> 6, col = tid & 63;
        float acc[16];
#pragma unroll
        for (int b = 0; b < 16; ++b) acc[b] = 0.f;
        const float* wp = a.w_ada + (size_t)l * D * NMOD + (size_t)(ks * 128) * NMOD + n0 + col;
#pragma unroll 4
        for (int kk = 0; kk < 128; ++kk) {
            const float w = wp[(size_t)kk * NMOD];
            const LAS f32x4* cp = (const LAS f32x4*)(cact + (ks * 128 + kk) * 16);
#pragma unroll
            for (int q = 0; q < 4; ++q) { const f32x4 cv = cp[q]; acc[4 * q + 0] += cv.x * w; acc[4 * q + 1] += cv.y * w; acc[4 * q + 2] += cv.z * w; acc[4 * q + 3] += cv.w * w; }
        }
#pragma unroll
        for (int b = 0; b < 16; ++b) red[(ks * 16 + b) * 64 + col] = acc[b];
        __syncthreads();
        for (int o = tid; o < 1024; o += 512) { const int b = o >> 6, cc = o & 63; float s = 0.f;
#pragma unroll
            for (int k8 = 0; k8 < 8; ++k8) s += red[(k8 * 16 + b) * 64 + cc];
            mod[(size_t)(l * 16 + b) * NMOD + n0 + cc] = s + a.b_ada[l * NMOD + n0 + cc]; }
        __syncthreads();
    }
    for (int idx = bid * 512 + tid; idx < 2 * 4 * 16 * 1024; idx += G * 512) {
        const int l = idx >> 16, g = (idx >> 14) & 3, cch = (idx >> 10) & 15, n = idx & 1023;
        const float* wo = a.w_out + (size_t)l * D * D + (size_t)(512 + g * 128) * D + n;
        const float* wpl = a.w_pool + ((size_t)(l * 4 + g) * 128 + cch * 8) * 128;
        const float* ps = a.pool_scale + l * 512 + g * 128;
        float acc[8];
#pragma unroll
        for (int i = 0; i < 8; ++i) acc[i] = 0.f;
#pragma unroll 4
        for (int d = 0; d < 128; ++d) { const float v = wo[(size_t)d * D] * ps[d];
#pragma unroll
            for (int i = 0; i < 8; ++i) acc[i] += wpl[i * 128 + d] * v; }
        u32x4 o; o.x = pk2(acc[0], acc[1]); o.y = pk2(acc[2], acc[3]); o.z = pk2(acc[4], acc[5]); o.w = pk2(acc[6], acc[7]);
        *(u32x4*)((bf16_t*)(ws + WS_WOUT) + (size_t)l * D * D + (size_t)n * D + 512 + g * 128 + cch * 8) = o;
    }
    {
        LAS float* scr = (LAS float*)(lds + wave * 16384);
        const int gw = bid * 8 + wave, NGW = G * 8;
        constexpr int I_IN = 16 * 64, I_OUT = 8 * 32, I_1 = 16 * 128, I_2 = 64 * 32, I_L = I_IN + I_OUT + I_1 + I_2;
        for (int it = gw; it < 2 * I_L; it += NGW) {
            const int l = it / I_L; int r = it % I_L;
            if (r < I_IN) { transpose_item(a.w_in + (size_t)l * D * PROJ, PROJ, (bf16_t*)(ws + WS_WIN) + (size_t)l * PROJ * D, D, scr, r / 64, r % 64, lane); continue; } r -= I_IN;
            if (r < I_OUT) { transpose_item(a.w_out + (size_t)l * D * D, D, (bf16_t*)(ws + WS_WOUT) + (size_t)l * D * D, D, scr, r / 32, r % 32, lane); continue; } r -= I_OUT;
            if (r < I_1) { transpose_item(a.w_mlp1 + (size_t)l * D * FF, FF, (bf16_t*)(ws + WS_W1) + (size_t)l * FF * D, D, scr, r / 128, r % 128, lane); continue; } r -= I_1;
            transpose_item(a.w_mlp2 + (size_t)l * FF * D, D, (bf16_t*)(ws + WS_W2) + (size_t)l * D * FF, FF, scr, r / 32, r % 32, lane);
        }
    }
}

template <bool SRC_BF16, bool OUT_F32>
__device__ __forceinline__ void ln_phase(const void* srcv, float* dstF, bf16_t* dstH, const float* g, const float* bt, const float* sc, const float* sh, int G, int bid, int tid) {
    asm volatile("" : "+v"(tid));
    const int lane = tid & 63, wave = tid >> 6;
    const int gw = bid * 8 + wave, NGW = G * 8;
    const int rpw = (M + NGW - 1) / NGW;
    const int r0 = gw * rpw, r1 = (r0 + rpw < M) ? r0 + rpw : M;
    if (r0 >= M) return;
    const int c0 = 8 * lane;
    f32x4 gv[4], bv[4], scv[4], shv[4];
#pragma unroll
    for (int j = 0; j < 4; ++j) { const int cj = c0 + (j >> 1) * 512 + (j & 1) * 4; gv[j] = *(const f32x4*)(g + cj); bv[j] = *(const f32x4*)(bt + cj); scv[j] = (f32x4){1.f, 1.f, 1.f, 1.f}; shv[j] = (f32x4){0.f, 0.f, 0.f, 0.f}; }
    int curb = -1;
    f32x4 v[4]; f32x4 nf[4]; u32x4 nb[2];
    if (SRC_BF16) { const bf16_t* p = (const bf16_t*)srcv + (size_t)r0 * D + c0; nb[0] = *(const u32x4*)p; nb[1] = *(const u32x4*)(p + 512); }
    else { const float* p = (const float*)srcv + (size_t)r0 * D + c0; nf[0] = *(const f32x4*)p; nf[1] = *(const f32x4*)(p + 4); nf[2] = *(const f32x4*)(p + 512); nf[3] = *(const f32x4*)(p + 516); }
    for (int r = r0; r < r1; ++r) {
        if (SRC_BF16) {
#pragma unroll
            for (int q = 0; q < 2; ++q) { v[2 * q].x = bflo(nb[q].x); v[2 * q].y = bfhi(nb[q].x); v[2 * q].z = bflo(nb[q].y); v[2 * q].w = bfhi(nb[q].y); v[2 * q + 1].x = bflo(nb[q].z); v[2 * q + 1].y = bfhi(nb[q].z); v[2 * q + 1].z = bflo(nb[q].w); v[2 * q + 1].w = bfhi(nb[q].w); }
        } else {
#pragma unroll
            for (int j = 0; j < 4; ++j) v[j] = nf[j];
        }
        if (r + 1 < r1) {
            if (SRC_BF16) { const bf16_t* p = (const bf16_t*)srcv + (size_t)(r + 1) * D + c0; nb[0] = *(const u32x4*)p; nb[1] = *(const u32x4*)(p + 512); }
            else { const float* p = (const float*)srcv + (size_t)(r + 1) * D + c0; nf[0] = *(const f32x4*)p; nf[1] = *(const f32x4*)(p + 4); nf[2] = *(const f32x4*)(p + 512); nf[3] = *(const f32x4*)(p + 516); }
        }
        const int b = r >> 12;
        if (!OUT_F32 && b != curb) { curb = b;
#pragma unroll
            for (int j = 0; j < 4; ++j) { const int cj = c0 + (j >> 1) * 512 + (j & 1) * 4; scv[j] = *(const f32x4*)(sc + (size_t)b * NMOD + cj) + 1.0f; shv[j] = *(const f32x4*)(sh + (size_t)b * NMOD + cj); } }
        float s = 0.f;
#pragma unroll
        for (int j = 0; j < 4; ++j) s += (v[j].x + v[j].y) + (v[j].z + v[j].w);
        const float mean = wave_sum(s) * (1.f / D); float s2 = 0.f;
#pragma unroll
        for (int j = 0; j < 4; ++j) { v[j] = v[j] - mean; s2 += (v[j].x * v[j].x + v[j].y * v[j].y) + (v[j].z * v[j].z + v[j].w * v[j].w); }
        const float rstd = 1.f / sqrtf(wave_sum(s2) * (1.f / D) + LN_EPS);
#pragma unroll
        for (int j = 0; j < 4; ++j) v[j] = v[j] * rstd * gv[j] + bv[j];
        if (OUT_F32) { float* p = dstF + (size_t)r * D + c0; *(f32x4*)p = v[0]; *(f32x4*)(p + 4) = v[1]; *(f32x4*)(p + 512) = v[2]; *(f32x4*)(p + 516) = v[3]; }
        else {
#pragma unroll
            for (int j = 0; j < 4; ++j) v[j] = v[j] * scv[j] + shv[j];
            bf16_t* p = dstH + (size_t)r * D + c0;
            u32x4 w0, w1; w0.x = pk2(v[0].x, v[0].y); w0.y = pk2(v[0].z, v[0].w); w0.z = pk2(v[1].x, v[1].y); w0.w = pk2(v[1].z, v[1].w);
            w1.x = pk2(v[2].x, v[2].y); w1.y = pk2(v[2].z, v[2].w); w1.z = pk2(v[3].x, v[3].y); w1.w = pk2(v[3].z, v[3].w);
            *(u32x4*)p = w0; *(u32x4*)(p + 512) = w1;
        }
    }
}

__device__ __forceinline__ void attn_pool_phase(LAS unsigned char* lds, const bf16_t* Qb, const bf16_t* Kb, const bf16_t* Vt, const bf16_t* Ub, bf16_t* cat, const float* rpb_l, int G, int bid, int tid) {
    asm volatile("" : "+v"(tid));
    LAS float* tab = (LAS float*)lds;
    for (int i = tid; i < NHEAD * RPB_N; i += 512) tab[i] = rpb_l[i] * LOG2E;
    __syncthreads();
    const int lane = tid & 63, h = __builtin_amdgcn_readfirstlane(tid >> 6), q16 = lane & 15, g4 = lane >> 4;
    const LAS float* tabh = tab + h * RPB_N;
    for (int unit = bid; unit < BATCH * 64; unit += G) {
        const int b = unit >> 6, r = unit & 63; const int rs = r < 4 ? 0 : (r > 60 ? 56 : r - 4);
        const size_t tok0 = (size_t)b * SEQ + r * 64;
#pragma unroll 1
        for (int j = 0; j < 4; ++j) {
            const int cb = (j == 0) ? 0 : (j == 1) ? 8 : (j == 2) ? 24 : 32;
            const int qc = 16 * j + q16; const int cs = qc < 8 ? 0 : (qc > 56 ? 48 : qc - 8);
            const bf16_t* qp = Qb + (tok0 + qc) * AW + h * 64 + g4 * 8;
            const bf16x8 q0 = *(const bf16x8*)qp, q1 = *(const bf16x8*)(qp + 32);
            f32x4 s[8][2];
            float mx = -1e30f;
#pragma unroll
            for (int i = 0; i < 8; ++i)
#pragma unroll
                for (int hh = 0; hh < 2; ++hh) {
                    const bf16_t* kp = Kb + ((size_t)b * SEQ + (rs + i) * 64 + cb + hh * 16 + q16) * AW + h * 64 + g4 * 8;
                    const bf16x8 k0 = *(const bf16x8*)kp, k1 = *(const bf16x8*)(kp + 32);
                    f32x4 acc = (f32x4){0.f, 0.f, 0.f, 0.f};
                    acc = __builtin_amdgcn_mfma_f32_16x16x32_bf16(k0, q0, acc, 0, 0, 0);
                    acc = __builtin_amdgcn_mfma_f32_16x16x32_bf16(k1, q1, acc, 0, 0, 0);
                    const LAS float* trow = tabh + (rs + i - r + 7) * RPB_W;
#pragma unroll
                    for (int jj = 0; jj < 4; ++jj) {
                        const int kc = cb + hh * 16 + g4 * 4 + jj; const bool valid = (kc >= cs) && (kc < cs + 16);
                        int bi = kc - qc + 15; bi = bi < 0 ? 0 : (bi > 30 ? 30 : bi);
                        const float sv = valid ? acc[jj] + trow[bi] : -1e30f;
                        acc[jj] = sv; mx = fmaxf(mx, sv);
                    }
                    s[i][hh] = acc;
                }
            mx = fmaxf(mx, __shfl_xor(mx, 16)); mx = fmaxf(mx, __shfl_xor(mx, 32));
            float sum = 0.f;
#pragma unroll
            for (int i = 0; i < 8; ++i)
#pragma unroll
                for (int hh = 0; hh < 2; ++hh)
#pragma unroll
                    for (int jj = 0; jj < 4; ++jj) { const float p = __builtin_amdgcn_exp2f(s[i][hh][jj] - mx); s[i][hh][jj] = p; sum += p; }
            sum += __shfl_xor(sum, 16); sum += __shfl_xor(sum, 32);
            f32x4 o[4];
#pragma unroll
            for (int db = 0; db < 4; ++db) o[db] = (f32x4){0.f, 0.f, 0.f, 0.f};
#pragma unroll
            for (int i = 0; i < 8; ++i) {
                u32x4 pw; pw.x = pg8::cvt_pk_bf16(s[i][0][0], s[i][0][1]); pw.y = pg8::cvt_pk_bf16(s[i][0][2], s[i][0][3]); pw.z = pg8::cvt_pk_bf16(s[i][1][0], s[i][1][1]); pw.w = pg8::cvt_pk_bf16(s[i][1][2], s[i][1][3]);
                const bf16x8 pf = __builtin_bit_cast(bf16x8, pw);
#pragma unroll
                for (int db = 0; db < 4; ++db) {
                    const bf16_t* vp = Vt + ((size_t)(b * 512 + h * 64 + db * 16 + q16)) * SEQ + (rs + i) * 64 + cb + g4 * 4;
                    const u32x2 vlo = *(const u32x2*)vp, vhi = *(const u32x2*)(vp + 16);
                    u32x4 vw; vw.x = vlo.x; vw.y = vlo.y; vw.z = vhi.x; vw.w = vhi.y;
                    o[db] = __builtin_amdgcn_mfma_f32_16x16x32_bf16(__builtin_bit_cast(bf16x8, vw), pf, o[db], 0, 0, 0);
                }
            }
            const float inv = 1.0f / sum;
            bf16_t* op = cat + (tok0 + qc) * D + h * 64 + g4 * 4;
#pragma unroll
            for (int db = 0; db < 4; ++db) { u32x2 w; w.x = pg8::cvt_pk_bf16(o[db][0] * inv, o[db][1] * inv); w.y = pg8::cvt_pk_bf16(o[db][2] * inv, o[db][3] * inv); *(u32x2*)(op + db * 16) = w; }
        }
        {
            const int tok = tid >> 3; const int t = r * 64 + tok;
#pragma unroll 1
            for (int it = 0; it < 8; ++it) {
                const int ch8 = (tid & 7) + 8 * it, gidx = it >> 1, w = 2 << gidx;
                int lo = t - (w >> 1), hi = lo + w; lo = lo < 0 ? 0 : lo; hi = hi > SEQ ? SEQ : hi;
                const bf16_t* up = Ub + ((size_t)b * SEQ) * AW + ch8 * 8;
                float accp[8];
#pragma unroll
                for (int e = 0; e < 8; ++e) accp[e] = 0.f;
                for (int tt = lo; tt < hi; ++tt) { const u32x4 uv = *(const u32x4*)(up + (size_t)tt * AW);
                    accp[0] += bflo(uv.x); accp[1] += bfhi(uv.x); accp[2] += bflo(uv.y); accp[3] += bfhi(uv.y); accp[4] += bflo(uv.z); accp[5] += bfhi(uv.z); accp[6] += bflo(uv.w); accp[7] += bfhi(uv.w); }
                const u32x4 uc = *(const u32x4*)(up + (size_t)t * AW); const float ic = 1.0f / (float)(hi - lo);
                u32x4 o;
                o.x = pk2(accp[0] * ic - bflo(uc.x), accp[1] * ic - bfhi(uc.x)); o.y = pk2(accp[2] * ic - bflo(uc.y), accp[3] * ic - bfhi(uc.y));
                o.z = pk2(accp[4] * ic - bflo(uc.z), accp[5] * ic - bfhi(uc.z)); o.w = pk2(accp[6] * ic - bflo(uc.w), accp[7] * ic - bfhi(uc.w));
                *(u32x4*)(cat + (tok0 + tok) * D + 512 + ch8 * 8) = o;
            }
        }
    }
}

constexpr int N_PHASES = 2 + 7 * DEPTH;
__global__ void __launch_bounds__(512, 2) fwd_megakernel(Args a) {
    extern __shared__ __attribute__((aligned(16))) unsigned char lds_raw[];
    LAS unsigned char* lds = (LAS unsigned char*)lds_raw;
    cg::grid_group grid = cg::this_grid();
    const int tid = threadIdx.x, bid = blockIdx.x, G = gridDim.x;
    unsigned char* ws = a.ws;
    bf16_t* H = (bf16_t*)(ws + WS_H); bf16_t* F = (bf16_t*)(ws + WS_F);
    bf16_t* Qb = (bf16_t*)(ws + WS_Q); bf16_t* Kb = (bf16_t*)(ws + WS_K); bf16_t* Vt = (bf16_t*)(ws + WS_VT); bf16_t* Ub = (bf16_t*)(ws + WS_U); bf16_t* CAT = (bf16_t*)(ws + WS_CAT);
    const float* mod = (const float*)(ws + WS_MOD);
    const int lo = a.ph_lo, hi = a.ph_hi;
#define IN(k) (lo <= (k) && (k) < hi)
#define SEAM(k) do { if (IN(k) && IN((k) + 1)) grid.sync(); } while (0)

    if (IN(0)) { p0_prologue(a, lds, G, bid, tid); }
    SEAM(0);
    if (IN(1)) { ln_phase<false, false>(a.x, nullptr, H, a.ln_in_g, a.ln_in_b, mod + 1 * D, mod + 0 * D, G, bid, tid); }
    SEAM(1);
#pragma unroll 1
    for (int l = 0; l < DEPTH; ++l) {
        const int p = 2 + 7 * l;
        const float* modl = mod + (size_t)l * BATCH * NMOD;
        if (IN(p + 0)) {
            pg8::Gemm g{H, (const bf16_t*)(ws + WS_WIN) + (size_t)l * PROJ * D, M, PROJ, D}; pg8::StaticOrder S; S.init(M, PROJ, G, bid);
            pg8::EpiProj E{Qb, Kb, Vt, Ub};
            pg8::gemm_phase<pg8::EpiProj, true>(lds, g, S, E);
        }
        SEAM(p + 0);
        if (IN(p + 1)) { attn_pool_phase(lds, Qb, Kb, Vt, Ub, CAT, a.rpb + (size_t)l * NHEAD * RPB_N, G, bid, tid); }
        SEAM(p + 1);
        if (IN(p + 2)) {
            pg8::Gemm g{CAT, (const bf16_t*)(ws + WS_WOUT) + (size_t)l * D * D, M, D, D}; pg8::StaticOrder S; S.init(M, D, G, bid);
            pg8::EpiRes E{H, modl, 0 * D, 1 * D, 2 * D};
            pg8::gemm_phase<pg8::EpiRes, true>(lds, g, S, E);
        }
        SEAM(p + 2);
        if (IN(p + 3)) { ln_phase<true, false>(H, nullptr, H, a.ln1_g + l * D, a.ln1_b + l * D, modl + 4 * D, modl + 3 * D, G, bid, tid); }
        SEAM(p + 3);
        if (IN(p + 4)) {
            pg8::Gemm g{H, (const bf16_t*)(ws + WS_W1) + (size_t)l * FF * D, M, FF, D}; pg8::StaticOrder S; S.init(M, FF, G, bid);
            pg8::EpiRelu2 E{F, FF};
            pg8::gemm_phase<pg8::EpiRelu2, true>(lds, g, S, E);
        }
        SEAM(p + 4);
        if (IN(p + 5)) {
            pg8::Gemm g{F, (const bf16_t*)(ws + WS_W2) + (size_t)l * D * FF, M, D, FF}; pg8::StaticOrder S; S.init(M, D, G, bid);
            pg8::EpiRes E{H, modl, 3 * D, 4 * D, 5 * D};
            pg8::gemm_phase<pg8::EpiRes, true>(lds, g, S, E);
        }
        SEAM(p + 5);
        if (IN(p + 6)) {
            const bool lastl = (l == DEPTH - 1);
            const float* modn = mod + (size_t)(lastl ? l : l + 1) * BATCH * NMOD;
            if (lastl) ln_phase<true, true>(H, a.out, nullptr, a.ln2_g + l * D, a.ln2_b + l * D, modn, modn, G, bid, tid);
            else ln_phase<true, false>(H, nullptr, H, a.ln2_g + l * D, a.ln2_b + l * D, modn + 1 * D, modn + 0 * D, G, bid, tid);
        }
        SEAM(p + 6);
    }
#undef IN
#undef SEAM
}

extern "C" void kernel_launch(void* const* d_in, const int* in_sizes, int n_in, void* d_out, int out_size, void* d_ws, size_t ws_size, hipStream_t stream) {
    static int grid = 0;
    if (grid == 0) {
        if (n_in != 17 || in_sizes[0] != M * D || out_size != M * D || ws_size < WS_END) { fprintf(stderr, "kernel_launch: unexpected shapes / workspace (n_in %d, in0 %d, out %d, ws %zu)\n", n_in, n_in > 0 ? in_sizes[0] : -1, out_size, ws_size); grid = -1; return; }
        int dev = 0, cus = 0, per_cu = 0;
        hipGetDevice(&dev); hipDeviceGetAttribute(&cus, hipDeviceAttributeMultiprocessorCount, dev);
        if (hipFuncSetAttribute((const void*)fwd_megakernel, hipFuncAttributeMaxDynamicSharedMemorySize, LDS_BYTES) != hipSuccess) { fprintf(stderr, "kernel_launch: hipFuncSetAttribute failed\n"); grid = -1; return; }
        if (hipOccupancyMaxActiveBlocksPerMultiprocessor(&per_cu, (const void*)fwd_megakernel, 512, LDS_BYTES) != hipSuccess || per_cu < 1) { per_cu = 1; (void)hipGetLastError(); }
        grid = (cus > 0 ? cus : 256) * per_cu;
    }
    if (grid < 0) return;
    Args a{};
    a.x = (const float*)d_in[0]; a.c = (const float*)d_in[1]; a.ln_in_g = (const float*)d_in[2]; a.ln_in_b = (const float*)d_in[3]; a.w_ada = (const float*)d_in[4]; a.b_ada = (const float*)d_in[5];
    a.w_in = (const float*)d_in[6]; a.rpb = (const float*)d_in[7]; a.w_pool = (const float*)d_in[8]; a.pool_scale = (const float*)d_in[9]; a.w_out = (const float*)d_in[10];
    a.ln1_g = (const float*)d_in[11]; a.ln1_b = (const float*)d_in[12]; a.w_mlp1 = (const float*)d_in[13]; a.w_mlp2 = (const float*)d_in[14]; a.ln2_g = (const float*)d_in[15]; a.ln2_b = (const float*)d_in[16];
    a.out = (float*)d_out; a.ws = (unsigned char*)d_ws;
#if MK_MULTI
    for (int p = 0; p < N_PHASES; ++p) { a.ph_lo = p; a.ph_hi = p + 1; hipLaunchKernelGGL(fwd_megakernel, dim3(grid), dim3(512), LDS_BYTES, stream, a); }
#else
    a.ph_lo = 0; a.ph_hi = N_PHASES;
    void* args[] = {&a};
    hipError_t e = hipLaunchCooperativeKernel((const void*)fwd_megakernel, dim3(grid), dim3(512), args, LDS_BYTES, stream);
    if (e != hipSuccess) fprintf(stderr, "kernel_launch: cooperative launch failed: %s (grid %d)\n", hipGetErrorString(e), grid);
#endif
}
```

```cpp
#include <hip/hip_runtime.h>
#include <hip/hip_cooperative_groups.h>
#include <cstdio>
#include <cstdint>
namespace cg = cooperative_groups;

#define LAS __attribute__((address_space(3)))
typedef unsigned short bf16_t;
typedef short bf16x8 __attribute__((ext_vector_type(8)));
typedef float f32x4 __attribute__((ext_vector_type(4)));
typedef float f32x2 __attribute__((ext_vector_type(2)));
typedef unsigned u32x4 __attribute__((ext_vector_type(4)));
typedef unsigned u32x2 __attribute__((ext_vector_type(2)));

#ifndef PROBE_ATT
#define PROBE_ATT 0
#endif
#ifndef PROBE_P0
#define PROBE_P0 0
#endif
#ifndef MK_MULTI
#define MK_MULTI 0
#endif

constexpr int BATCH = 16, SEQ = 4096, D = 1024, DEPTH = 2, M = BATCH * SEQ;
constexpr int PROJ = 2048, FF = 4096, NMOD = 6 * D, AW = 512;
constexpr int NHEAD = 8;
constexpr float LN_EPS = 1e-5f;
constexpr float DN_ALPHA = 1.41421356237309515f;
constexpr float LOG2E = 1.44269504088896341f;
constexpr float QSCALE = 0.125f * LOG2E;
constexpr int RPB_H = 15, RPB_W = 31, RPB_N = RPB_H * RPB_W;

constexpr size_t MiB = (size_t)1 << 20;
constexpr size_t WS_WIN = 0 * MiB;
constexpr size_t WS_WOUT = 8 * MiB;
constexpr size_t WS_W1 = 12 * MiB;
constexpr size_t WS_W2 = 28 * MiB;
constexpr size_t WS_MOD = 44 * MiB;
constexpr size_t WS_X = 48 * MiB;
constexpr size_t WS_H = 304 * MiB;
constexpr size_t WS_F = 432 * MiB;
constexpr size_t WS_Q = 432 * MiB;
constexpr size_t WS_K = 496 * MiB;
constexpr size_t WS_VT = 560 * MiB;
constexpr size_t WS_U = 624 * MiB;
constexpr size_t WS_CAT = 688 * MiB;
constexpr size_t WS_END = 944 * MiB;

constexpr int LDS_BYTES = 147456;

namespace pg8 {
constexpr int BM = 256, BK = 64, HALF = 128, HTB = HALF * BK * 2, STAGE_BYTES = 8 * HTB, NXCD = 8, WGM = 8;
__host__ __device__ __forceinline__ int lds_byte(int r, int c) { const int st = (r >> 4) * 2 + (c >> 5), rr = r & 15, cc = c & 31, ob = rr * 64 + cc * 2; return st * 1024 + (ob ^ (((ob >> 9) & 1) << 5)); }
__host__ __device__ __forceinline__ void stage_rc(int b, int& R, int& C) { const int st = b / 1024, sb = b % 1024, swz = sb ^ (((sb >> 9) & 1) << 5); R = (st >> 1) * 16 + swz / 64; C = (st & 1) * 32 + (swz % 64) / 2; }
__host__ __device__ __forceinline__ int perm32(int rho) { const int n = rho >> 4, i = rho & 15; return 8 * (i >> 2) + 4 * n + (i & 3); }

struct Unit { int pm, pn; };
struct Gemm { const bf16_t* A; const bf16_t* Bt; int M, N, K; };

struct StaticOrder {
    int nM, nN, nwg, G, c;
    __device__ void init(int M_, int N_, int G_, int c_) { nM = M_ / BM; nN = N_ / BM; nwg = nM * nN; G = G_; c = c_; }
    __device__ bool next(int i, Unit& u) const {
        const long L = (long)i * G + c; if (L >= nwg) return false;
        int wgid = (int)L; { const int q = nwg / NXCD, r = nwg % NXCD, xcd = wgid % NXCD, off = wgid / NXCD; wgid = (xcd < r ? xcd * (q + 1) : r * (q + 1) + (xcd - r) * q) + off; }
        const int nig = WGM * nN, gid = wgid / nig, fm = gid * WGM, gsz = (nM - fm) < WGM ? (nM - fm) : WGM;
        u.pm = fm + ((wgid % nig) % gsz); u.pn = (wgid % nig) / gsz; return true;
    }
};

__device__ __forceinline__ unsigned cvt_pk_bf16(float lo, float hi) { unsigned r; asm volatile("v_cvt_pk_bf16_f32 %0, %1, %2" : "=v"(r) : "v"(lo), "v"(hi)); return r; }

struct EpiProj {
    static constexpr bool PERM = true, VSWAP = true;
    bf16_t* Q; bf16_t* Kb; bf16_t* Vt; bf16_t* U;
    __device__ __forceinline__ void operator()(const f32x4 (&acc)[2][2][4][2], const Unit& u, int wr, int wc, int fr, int fq) const {
        const int t = u.pn >> 1;
        if (t == 2) {
            const int dg0 = (u.pn & 1) * 256 + wr * 64 + fr; const int b = u.pm >> 4; const int s0 = (u.pm & 15) * 256 + wc * 32 + 8 * fq;
#pragma unroll
            for (int ai = 0; ai < 2; ++ai)
#pragma unroll
                for (int m = 0; m < 4; ++m) { bf16_t* rowp = Vt + (size_t)(b * 512 + dg0 + ai * HALF + m * 16) * SEQ + s0;
#pragma unroll
                    for (int bj = 0; bj < 2; ++bj) { const f32x4 v0 = acc[ai][bj][m][0], v1 = acc[ai][bj][m][1];
                        u32x4 w; w.x = cvt_pk_bf16(v0[0], v0[1]); w.y = cvt_pk_bf16(v0[2], v0[3]); w.z = cvt_pk_bf16(v1[0], v1[1]); w.w = cvt_pk_bf16(v1[2], v1[3]);
                        *(u32x4*)(rowp + bj * HALF) = w; } }
        } else {
            bf16_t* base = Q + (size_t)t * ((size_t)M * AW); const float sc = t == 0 ? QSCALE : 1.0f;
            const int row0 = u.pm * BM + wr * 64 + fr, col0 = (u.pn & 1) * 256 + wc * 32 + 8 * fq;
#pragma unroll
            for (int ai = 0; ai < 2; ++ai)
#pragma unroll
                for (int m = 0; m < 4; ++m) { bf16_t* rowp = base + (size_t)(row0 + ai * HALF + m * 16) * AW + col0;
#pragma unroll
                    for (int bj = 0; bj < 2; ++bj) { const f32x4 v0 = acc[ai][bj][m][0] * sc, v1 = acc[ai][bj][m][1] * sc;
                        u32x4 w; w.x = cvt_pk_bf16(v0[0], v0[1]); w.y = cvt_pk_bf16(v0[2], v0[3]); w.z = cvt_pk_bf16(v1[0], v1[1]); w.w = cvt_pk_bf16(v1[2], v1[3]);
                        *(u32x4*)(rowp + bj * HALF) = w; } }
        }
    }
};
struct EpiRelu2 {
    static constexpr bool PERM = true, VSWAP = false;
    bf16_t* O; int ldc;
    __device__ __forceinline__ void operator()(const f32x4 (&acc)[2][2][4][2], const Unit& u, int wr, int wc, int fr, int fq) const {
        const int row0 = u.pm * BM + wr * 64 + fr, col0 = u.pn * BM + wc * 32 + 8 * fq;
#pragma unroll
        for (int ai = 0; ai < 2; ++ai)
#pragma unroll
            for (int m = 0; m < 4; ++m) { bf16_t* rowp = O + (size_t)(row0 + ai * HALF + m * 16) * ldc + col0;
#pragma unroll
                for (int bj = 0; bj < 2; ++bj) { f32x4 v0 = acc[ai][bj][m][0], v1 = acc[ai][bj][m][1];
#pragma unroll
                    for (int j = 0; j < 4; ++j) { const float a = fmaxf(v0[j], 0.f), b = fmaxf(v1[j], 0.f); v0[j] = a * a; v1[j] = b * b; }
                    u32x4 w; w.x = cvt_pk_bf16(v0[0], v0[1]); w.y = cvt_pk_bf16(v0[2], v0[3]); w.z = cvt_pk_bf16(v1[0], v1[1]); w.w = cvt_pk_bf16(v1[2], v1[3]);
                    *(u32x4*)(rowp + bj * HALF) = w; } }
    }
};
struct EpiRes {
    static constexpr bool PERM = true, VSWAP = false;
    bf16_t* H; const float* mod; int sh_off, sc_off, g_off;
    __device__ __forceinline__ void operator()(const f32x4 (&acc)[2][2][4][2], const Unit& u, int wr, int wc, int fr, int fq) const {
        const int row0 = u.pm * BM + wr * 64 + fr, col0 = u.pn * BM + wc * 32 + 8 * fq; const int b = u.pm >> 4;
        const float* mb = mod + (size_t)b * NMOD + col0;
        f32x4 shv[2][2], aiv[2][2], g1v[2][2];
#pragma unroll
        for (int bj = 0; bj < 2; ++bj)
#pragma unroll
            for (int n = 0; n < 2; ++n) { shv[bj][n] = *(const f32x4*)(mb + sh_off + bj * HALF + 4 * n); const f32x4 s1 = *(const f32x4*)(mb + sc_off + bj * HALF + 4 * n) + 1.0f;
                aiv[bj][n] = (f32x4){DN_ALPHA / s1.x, DN_ALPHA / s1.y, DN_ALPHA / s1.z, DN_ALPHA / s1.w}; g1v[bj][n] = *(const f32x4*)(mb + g_off + bj * HALF + 4 * n) + 1.0f; }
#pragma unroll
        for (int ai = 0; ai < 2; ++ai)
#pragma unroll
            for (int m = 0; m < 4; ++m) { bf16_t* rowp = H + (size_t)(row0 + ai * HALF + m * 16) * D + col0;
#pragma unroll
                for (int bj = 0; bj < 2; ++bj) { const u32x4 hw = *(const u32x4*)(rowp + bj * HALF);
                    f32x4 h0, h1; h0.x = __builtin_bit_cast(float, hw.x << 16); h0.y = __builtin_bit_cast(float, hw.x & 0xffff0000u); h0.z = __builtin_bit_cast(float, hw.y << 16); h0.w = __builtin_bit_cast(float, hw.y & 0xffff0000u);
                    h1.x = __builtin_bit_cast(float, hw.z << 16); h1.y = __builtin_bit_cast(float, hw.z & 0xffff0000u); h1.z = __builtin_bit_cast(float, hw.w << 16); h1.w = __builtin_bit_cast(float, hw.w & 0xffff0000u);
                    const f32x4 z0 = (h0 - shv[bj][0]) * aiv[bj][0] + g1v[bj][0] * acc[ai][bj][m][0], z1 = (h1 - shv[bj][1]) * aiv[bj][1] + g1v[bj][1] * acc[ai][bj][m][1];
                    u32x4 w; w.x = cvt_pk_bf16(z0[0], z0[1]); w.y = cvt_pk_bf16(z0[2], z0[3]); w.z = cvt_pk_bf16(z1[0], z1[1]); w.w = cvt_pk_bf16(z1[2], z1[3]);
                    *(u32x4*)(rowp + bj * HALF) = w; }
                asm volatile("" ::: "memory"); }
    }
};

template <class Epi, bool ALIGN_EPI>
__device__ __forceinline__ void gemm_phase(LAS unsigned char* lds, const Gemm g, const StaticOrder& S, const Epi& E) {
    int tid = threadIdx.x; asm volatile("" : "+v"(tid));
    const int wid = __builtin_amdgcn_readfirstlane(tid >> 6), lane = tid & 63, wr = wid >> 2, wc = wid & 3, fr = lane & 15, fq = lane >> 4;
    const int K = g.K, nt = K / BK;
    unsigned voffA[2], voffB[2];
#pragma unroll
    for (int i = 0; i < 2; ++i) { int R, C; stage_rc(tid * 16 + i * 8192, R, C); const int Rb = Epi::PERM ? ((R & ~31) + perm32(R & 31)) : R;
        voffA[i] = (unsigned)(R * K + C) * 2u; voffB[i] = (unsigned)(Rb * K + C) * 2u; }
    const size_t kstep = (size_t)(BK * 2);
    const size_t hstep = (size_t)HALF * K * 2;
    const size_t tstep = 2 * hstep;
    const unsigned ldsw = (unsigned)wid * 1024u;
    const int aoff = lds_byte(wr * 64 + fr, fq * 8), boff = lds_byte(wc * 32 + fr, fq * 8);
#define PG8_SA(b, h) (((b) * 2 + (h)) * HTB)
#define PG8_SB(b, h) ((4 + (b) * 2 + (h)) * HTB)
#define PG8_STAGE(bufoff, gbase, voff) do { _Pragma("unroll") for (int _i = 0; _i < 2; ++_i) \
        __builtin_amdgcn_global_load_lds((const unsigned*)((const char*)(gbase) + (voff)[_i]), (LAS unsigned*)(lds + (bufoff) + ldsw + _i * 8192), 16, 0, 0); } while (0)
#define PG8_LDA(dst, b, h) do { _Pragma("unroll") for (int m = 0; m < 4; ++m) _Pragma("unroll") for (int k = 0; k < 2; ++k) dst[m][k] = *(const LAS bf16x8*)(lds + PG8_SA(b, h) + aoff + m * 2048 + k * 1024); } while (0)
#define PG8_LDB(dst, b, h) do { _Pragma("unroll") for (int n = 0; n < 2; ++n) _Pragma("unroll") for (int k = 0; k < 2; ++k) dst[n][k] = *(const LAS bf16x8*)(lds + PG8_SB(b, h) + boff + n * 2048 + k * 1024); } while (0)
#define PG8_MMA(ai, bj, At, Bt) do { __builtin_amdgcn_s_setprio(1); _Pragma("unroll") for (int m = 0; m < 4; ++m) _Pragma("unroll") for (int n = 0; n < 2; ++n) _Pragma("unroll") for (int k = 0; k < 2; ++k) \
        acc[ai][bj][m][n] = __builtin_amdgcn_mfma_f32_16x16x32_bf16(Bt[n][k], At[m][k], acc[ai][bj][m][n], 0, 0, 0); __builtin_amdgcn_s_setprio(0); } while (0)
#define PG8_WAIT_V(n) asm volatile("s_waitcnt vmcnt(" #n ")" ::: "memory")
#define PG8_WAIT_L(n) asm volatile("s_waitcnt lgkmcnt(" #n ")" ::: "memory")
#define PG8_BAR __builtin_amdgcn_s_barrier()
#define PG8_SCHED __builtin_amdgcn_sched_barrier(0)
#define PG8_PTRS(u, pa, pb) do { const bool _sw = Epi::VSWAP && (((u).pn >> 1) == 2); const char* _a = (const char*)g.A + (size_t)(u).pm * tstep; const char* _b = (const char*)g.Bt + (size_t)(u).pn * tstep; pa = _sw ? _b : _a; pb = _sw ? _a : _b; } while (0)
    Unit cur, nxt; int ui = 0;
    if (!S.next(0, cur)) return;
    f32x4 acc[2][2][4][2];
#pragma unroll
    for (int a = 0; a < 2; ++a)
#pragma unroll
        for (int b = 0; b < 2; ++b)
#pragma unroll
            for (int m = 0; m < 4; ++m)
#pragma unroll
                for (int n = 0; n < 2; ++n) acc[a][b][m][n] = (f32x4){0.f, 0.f, 0.f, 0.f};
    bf16x8 At[4][2], B0[2][2], B1[2][2];
    const char* cA; const char* cB; PG8_PTRS(cur, cA, cB);
    PG8_STAGE(PG8_SB(0, 0), cB, voffB); PG8_STAGE(PG8_SB(0, 1), cB + hstep, voffB); PG8_STAGE(PG8_SA(0, 0), cA, voffA); PG8_STAGE(PG8_SA(0, 1), cA + hstep, voffA);
    if (wr == 1) PG8_BAR;
    PG8_WAIT_V(2); PG8_BAR;
    PG8_STAGE(PG8_SB(1, 0), cB + kstep, voffB); PG8_STAGE(PG8_SA(1, 0), cA + kstep, voffA); PG8_STAGE(PG8_SB(1, 1), cB + hstep + kstep, voffB);
    PG8_WAIT_V(6); PG8_BAR;
    for (;;) {
        const bool has_next = S.next(ui + 1, nxt);
        const char* nA = cA; const char* nB = cB; if (has_next) { PG8_PTRS(nxt, nA, nB); }
        for (int t = 0; t < nt; t += 2) {
            const bool last = (t == nt - 2);
            const char* a1 = cA + (size_t)(t + 1) * kstep;
            const char* a2 = last ? nA : cA + (size_t)(t + 2) * kstep; const char* b2 = last ? nB : cB + (size_t)(t + 2) * kstep;
            const char* a3 = a2 + kstep; const char* b3 = b2 + kstep;
            PG8_LDB(B0, 0, 0); PG8_LDB(B1, 0, 1); PG8_SCHED; PG8_LDA(At, 0, 0); PG8_STAGE(PG8_SA(1, 1), a1 + hstep, voffA);
            PG8_WAIT_V(8); PG8_WAIT_L(0); PG8_BAR; PG8_MMA(0, 0, At, B0); PG8_MMA(0, 1, At, B1); PG8_BAR; PG8_SCHED;
            PG8_LDA(At, 0, 1); PG8_STAGE(PG8_SB(0, 0), b2, voffB); PG8_STAGE(PG8_SB(0, 1), b2 + hstep, voffB); PG8_STAGE(PG8_SA(0, 0), a2, voffA);
            PG8_WAIT_V(8); PG8_WAIT_L(0); PG8_BAR; PG8_MMA(1, 0, At, B0); PG8_MMA(1, 1, At, B1); PG8_BAR; PG8_SCHED;
            PG8_LDB(B0, 1, 0); PG8_LDB(B1, 1, 1); PG8_SCHED; PG8_LDA(At, 1, 0); PG8_STAGE(PG8_SA(0, 1), a2 + hstep, voffA);
            PG8_WAIT_V(8); PG8_WAIT_L(0); PG8_BAR; PG8_MMA(0, 0, At, B0); PG8_MMA(0, 1, At, B1); PG8_BAR; PG8_SCHED;
            PG8_LDA(At, 1, 1); PG8_STAGE(PG8_SB(1, 0), b3, voffB); PG8_STAGE(PG8_SB(1, 1), b3 + hstep, voffB); PG8_STAGE(PG8_SA(1, 0), a3, voffA);
            PG8_WAIT_V(8); PG8_WAIT_L(0); PG8_BAR; PG8_MMA(1, 0, At, B0); PG8_MMA(1, 1, At, B1); PG8_BAR; PG8_SCHED;
        }
        if constexpr (ALIGN_EPI) { if (wr == 0) PG8_BAR; }
        E(acc, cur, wr, wc, fr, fq);
        if (!has_next) break;
#pragma unroll
        for (int a = 0; a < 2; ++a)
#pragma unroll
            for (int b = 0; b < 2; ++b)
#pragma unroll
                for (int m = 0; m < 4; ++m)
#pragma unroll
                    for (int n = 0; n < 2; ++n) acc[a][b][m][n] = (f32x4){0.f, 0.f, 0.f, 0.f};
        cur = nxt; cA = nA; cB = nB; ++ui;
        if constexpr (ALIGN_EPI) { if (wr == 1) PG8_BAR; }
    }
    PG8_WAIT_V(0);
    if constexpr (!ALIGN_EPI) { if (wr == 0) PG8_BAR; }
    PG8_BAR;
#undef PG8_SA
#undef PG8_SB
#undef PG8_STAGE
#undef PG8_LDA
#undef PG8_LDB
#undef PG8_MMA
#undef PG8_WAIT_V
#undef PG8_WAIT_L
#undef PG8_BAR
#undef PG8_SCHED
#undef PG8_PTRS
}
}

__device__ __forceinline__ unsigned f2bf(float f) { unsigned u = __builtin_bit_cast(unsigned, f); return (u + 0x7fffu + ((u >> 16) & 1u)) >> 16; }
__device__ __forceinline__ unsigned pk2(float lo, float hi) { return f2bf(lo) | (f2bf(hi) << 16); }
__device__ __forceinline__ float bflo(unsigned w) { return __builtin_bit_cast(float, w << 16); }
__device__ __forceinline__ float bfhi(unsigned w) { return __builtin_bit_cast(float, w & 0xffff0000u); }
__device__ __forceinline__ float wave_sum(float v) {
#pragma unroll
    for (int o = 1; o < 64; o <<= 1) v += __shfl_xor(v, o);
    return v;
}

__device__ __forceinline__ void transpose_item(const float* W, int N, bf16_t* WT, int ldw, LAS float* scr, int kb, int nb, int lane) {
    const int k0 = 64 * kb, n0 = 32 * nb;
#pragma unroll 8
    for (int i = 0; i < 32; ++i) { const int kk = 2 * i + (lane >> 5); scr[kk * 33 + (lane & 31)] = W[(size_t)(k0 + kk) * N + n0 + (lane & 31)]; }
    asm volatile("s_waitcnt lgkmcnt(0)" ::: "memory");
    const int c = lane & 7;
#pragma unroll
    for (int j = 0; j < 4; ++j) { const int n = (lane >> 3) + 8 * j; const LAS float* s = scr + (8 * c) * 33 + n;
        u32x4 o; o.x = pk2(s[0 * 33], s[1 * 33]); o.y = pk2(s[2 * 33], s[3 * 33]); o.z = pk2(s[4 * 33], s[5 * 33]); o.w = pk2(s[6 * 33], s[7 * 33]);
        *(u32x4*)(WT + (size_t)(n0 + n) * ldw + k0 + 8 * c) = o; }
    asm volatile("s_waitcnt lgkmcnt(0)" ::: "memory");
}

struct Args {
    const float *x, *c, *ln_in_g, *ln_in_b, *w_ada, *b_ada, *w_in, *rpb, *w_pool, *pool_scale, *w_out, *ln1_g, *ln1_b, *w_mlp1, *w_mlp2, *ln2_g, *ln2_b;
    float* out; unsigned char* ws; int ph_lo, ph_hi;
};

__device__ __forceinline__ void p0_prologue(const Args& a, LAS unsigned char* lds, int G, int bid, int tid) {
    asm volatile("" : "+v"(tid));
    const int lane = tid & 63, wave = tid >> 6;
    unsigned char* ws = a.ws;
    float* mod = (float*)(ws + WS_MOD);
    for (int item = bid; item < 2 * (NMOD / 64); item += G) {
        const int l = item / (NMOD / 64), n0 = (item % (NMOD / 64)) * 64;
        LAS float* cact = (LAS float*)lds;
        LAS float* red = (LAS float*)(lds + 65536);
        for (int i = tid; i < BATCH * D; i += 512) { const int b = i >> 10, k = i & 1023; const float v = a.c[i]; cact[k * 16 + b] = v / (1.0f + expf(-v)); }
        __syncthreads();
        const int ks = tid >> 6, col = tid & 63;
        float acc[16];
#pragma unroll
        for (int b = 0; b < 16; ++b) acc[b] = 0.f;
        const float* wp = a.w_ada + (size_t)l * D * NMOD + (size_t)(ks * 128) * NMOD + n0 + col;
#pragma unroll 4
        for (int kk = 0; kk < 128; ++kk) {
            const float w = wp[(size_t)kk * NMOD];
            const LAS f32x4* cp = (const LAS f32x4*)(cact + (ks * 128 + kk) * 16);
#pragma unroll
            for (int q = 0; q < 4; ++q) { const f32x4 cv = cp[q]; acc[4 * q + 0] += cv.x * w; acc[4 * q + 1] += cv.y * w; acc[4 * q + 2] += cv.z * w; acc[4 * q + 3] += cv.w * w; }
        }
#pragma unroll
        for (int b = 0; b < 16; ++b) red[(ks * 16 + b) * 64 + col] = acc[b];
        __syncthreads();
        for (int o = tid; o < 1024; o += 512) { const int b = o >> 6, cc = o & 63; float s = 0.f;
#pragma unroll
            for (int k8 = 0; k8 < 8; ++k8) s += red[(k8 * 16 + b) * 64 + cc];
            mod[(size_t)(l * 16 + b) * NMOD + n0 + cc] = s + a.b_ada[l * NMOD + n0 + cc]; }
        __syncthreads();
    }
    for (int idx = bid * 512 + tid; idx < 2 * 4 * 16 * 1024; idx += G * 512) {
        const int l = idx >> 16, g = (idx >> 14) & 3, cch = (idx >> 10) & 15, n = idx & 1023;
        const float* wo = a.w_out + (size_t)l * D * D + (size_t)(512 + g * 128) * D + n;
        const float* wpl = a.w_pool + ((size_t)(l * 4 + g) * 128 + cch * 8) * 128;
        const float* ps = a.pool_scale + l * 512 + g * 128;
        float acc[8];
#pragma unroll
        for (int i = 0; i < 8; ++i) acc[i] = 0.f;
#pragma unroll 4
        for (int d = 0; d < 128; ++d) { const float v = wo[(size_t)d * D] * ps[d];
#pragma unroll
            for (int i = 0; i < 8; ++i) acc[i] += wpl[i * 128 + d] * v; }
        u32x4 o; o.x = pk2(acc[0], acc[1]); o.y = pk2(acc[2], acc[3]); o.z = pk2(acc[4], acc[5]); o.w = pk2(acc[6], acc[7]);
        *(u32x4*)((bf16_t*)(ws + WS_WOUT) + (size_t)l * D * D + (size_t)n * D + 512 + g * 128 + cch * 8) = o;
    }
    {
        LAS float* scr = (LAS float*)(lds + wave * 16384);
        const int gw = bid * 8 + wave, NGW = G * 8;
        constexpr int I_IN = 16 * 64, I_OUT = 8 * 32, I_1 = 16 * 128, I_2 = 64 * 32, I_L = I_IN + I_OUT + I_1 + I_2;
        for (int it = gw; it < 2 * I_L; it += NGW) {
            const int l = it / I_L; int r = it % I_L;
            if (r < I_IN) { transpose_item(a.w_in + (size_t)l * D * PROJ, PROJ, (bf16_t*)(ws + WS_WIN) + (size_t)l * PROJ * D, D, scr, r / 64, r % 64, lane); continue; } r -= I_IN;
            if (r < I_OUT) { transpose_item(a.w_out + (size_t)l * D * D, D, (bf16_t*)(ws + WS_WOUT) + (size_t)l * D * D, D, scr, r / 32, r % 32, lane); continue; } r -= I_OUT;
            if (r < I_1) { transpose_item(a.w_mlp1 + (size_t)l * D * FF, FF, (bf16_t*)(ws + WS_W1) + (size_t)l * FF * D, D, scr, r / 128, r % 128, lane); continue; } r -= I_1;
            transpose_item(a.w_mlp2 + (size_t)l * FF * D, D, (bf16_t*)(ws + WS_W2) + (size_t)l * D * FF, FF, scr, r / 32, r % 32, lane);
        }
    }
}

template <bool SRC_BF16, bool OUT_F32>
__device__ __forceinline__ void ln_phase(const void* srcv, float* dstF, bf16_t* dstH, const float* g, const float* bt, const float* sc, const float* sh, int G, int bid, int tid) {
    asm volatile("" : "+v"(tid));
    const int lane = tid & 63, wave = tid >> 6;
    const int gw = bid * 8 + wave, NGW = G * 8;
    const int rpw = (M + NGW - 1) / NGW;
    const int r0 = gw * rpw, r1 = (r0 + rpw < M) ? r0 + rpw : M;
    if (r0 >= M) return;
    const int c0 = 8 * lane;
    f32x4 gv[4], bv[4], scv[4], shv[4];
#pragma unroll
    for (int j = 0; j < 4; ++j) { const int cj = c0 + (j >> 1) * 512 + (j & 1) * 4; gv[j] = *(const f32x4*)(g + cj); bv[j] = *(const f32x4*)(bt + cj); scv[j] = (f32x4){1.f, 1.f, 1.f, 1.f}; shv[j] = (f32x4){0.f, 0.f, 0.f, 0.f}; }
    int curb = -1;
    f32x4 v[4]; f32x4 nf[4]; u32x4 nb[2];
    if (SRC_BF16) { const bf16_t* p = (const bf16_t*)srcv + (size_t)r0 * D + c0; nb[0] = *(const u32x4*)p; nb[1] = *(const u32x4*)(p + 512); }
    else { const float* p = (const float*)srcv + (size_t)r0 * D + c0; nf[0] = *(const f32x4*)p; nf[1] = *(const f32x4*)(p + 4); nf[2] = *(const f32x4*)(p + 512); nf[3] = *(const f32x4*)(p + 516); }
    for (int r = r0; r < r1; ++r) {
        if (SRC_BF16) {
#pragma unroll
            for (int q = 0; q < 2; ++q) { v[2 * q].x = bflo(nb[q].x); v[2 * q].y = bfhi(nb[q].x); v[2 * q].z = bflo(nb[q].y); v[2 * q].w = bfhi(nb[q].y); v[2 * q + 1].x = bflo(nb[q].z); v[2 * q + 1].y = bfhi(nb[q].z); v[2 * q + 1].z = bflo(nb[q].w); v[2 * q + 1].w = bfhi(nb[q].w); }
        } else {
#pragma unroll
            for (int j = 0; j < 4; ++j) v[j] = nf[j];
        }
        if (r + 1 < r1) {
            if (SRC_BF16) { const bf16_t* p = (const bf16_t*)srcv + (size_t)(r + 1) * D + c0; nb[0] = *(const u32x4*)p; nb[1] = *(const u32x4*)(p + 512); }
            else { const float* p = (const float*)srcv + (size_t)(r + 1) * D + c0; nf[0] = *(const f32x4*)p; nf[1] = *(const f32x4*)(p + 4); nf[2] = *(const f32x4*)(p + 512); nf[3] = *(const f32x4*)(p + 516); }
        }
        const int b = r >> 12;
        if (!OUT_F32 && b != curb) { curb = b;
#pragma unroll
            for (int j = 0; j < 4; ++j) { const int cj = c0 + (j >> 1) * 512 + (j & 1) * 4; scv[j] = *(const f32x4*)(sc + (size_t)b * NMOD + cj) + 1.0f; shv[j] = *(const f32x4*)(sh + (size_t)b * NMOD + cj); } }
        float s = 0.f;
#pragma unroll
        for (int j = 0; j < 4; ++j) s += (v[j].x + v[j].y) + (v[j].z + v[j].w);
        const float mean = wave_sum(s) * (1.f / D); float s2 = 0.f;
#pragma unroll
        for (int j = 0; j < 4; ++j) { v[j] = v[j] - mean; s2 += (v[j].x * v[j].x + v[j].y * v[j].y) + (v[j].z * v[j].z + v[j].w * v[j].w); }
        const float rstd = 1.f / sqrtf(wave_sum(s2) * (1.f / D) + LN_EPS);
#pragma unroll
        for (int j = 0; j < 4; ++j) v[j] = v[j] * rstd * gv[j] + bv[j];
        if (OUT_F32) { float* p = dstF + (size_t)r * D + c0; *(f32x4*)p = v[0]; *(f32x4*)(p + 4) = v[1]; *(f32x4*)(p + 512) = v[2]; *(f32x4*)(p + 516) = v[3]; }
        else {
#pragma unroll
            for (int j = 0; j < 4; ++j) v[j] = v[j] * scv[j] + shv[j];
            bf16_t* p = dstH + (size_t)r * D + c0;
            u32x4 w0, w1; w0.x = pk2(v[0].x, v[0].y); w0.y = pk2(v[0].z, v[0].w); w0.z = pk2(v[1].x, v[1].y); w0.w = pk2(v[1].z, v[1].w);
            w1.x = pk2(v[2].x, v[2].y); w1.y = pk2(v[2].z, v[2].w); w1.z = pk2(v[3].x, v[3].y); w1.w = pk2(v[3].z, v[3].w);
            *(u32x4*)p = w0; *(u32x4*)(p + 512) = w1;
        }
    }
}

__device__ __forceinline__ void add8(float (&s)[8], const u32x4 w) { s[0] += bflo(w.x); s[1] += bfhi(w.x); s[2] += bflo(w.y); s[3] += bfhi(w.y); s[4] += bflo(w.z); s[5] += bfhi(w.z); s[6] += bflo(w.w); s[7] += bfhi(w.w); }
__device__ __forceinline__ void sub8(float (&s)[8], const u32x4 w) { s[0] -= bflo(w.x); s[1] -= bfhi(w.x); s[2] -= bflo(w.y); s[3] -= bfhi(w.y); s[4] -= bflo(w.z); s[5] -= bfhi(w.z); s[6] -= bflo(w.w); s[7] -= bfhi(w.w); }
template <int W>
__device__ __forceinline__ void pool_lane(const bf16_t* Ubc  , bf16_t* catc  , int T0) {
    constexpr int HW = W / 2, NL = 8 + W - 1;
    u32x4 raw[NL];
#pragma unroll
    for (int k = 0; k < NL; ++k) { const int tk = T0 - HW + k; const int tc = tk < 0 ? 0 : (tk > SEQ - 1 ? SEQ - 1 : tk); u32x4 v = *(const u32x4*)(Ubc + (size_t)tc * AW);
        if (tk != tc) v = (u32x4){0u, 0u, 0u, 0u}; raw[k] = v; }
    float sm[8];
#pragma unroll
    for (int e = 0; e < 8; ++e) sm[e] = 0.f;
#pragma unroll
    for (int k = 0; k < W; ++k) add8(sm, raw[k]);
#pragma unroll
    for (int o = 0; o < 8; ++o) {
        int lo = T0 + o - HW, hi = lo + W; lo = lo < 0 ? 0 : lo; hi = hi > SEQ ? SEQ : hi; const float ic = 1.0f / (float)(hi - lo);
        const u32x4 c = raw[o + HW];
        u32x4 w; w.x = pk2(sm[0] * ic - bflo(c.x), sm[1] * ic - bfhi(c.x)); w.y = pk2(sm[2] * ic - bflo(c.y), sm[3] * ic - bfhi(c.y));
        w.z = pk2(sm[4] * ic - bflo(c.z), sm[5] * ic - bfhi(c.z)); w.w = pk2(sm[6] * ic - bflo(c.w), sm[7] * ic - bfhi(c.w));
        *(u32x4*)(catc + (size_t)(T0 + o) * D) = w;
        if (o < 7) { add8(sm, raw[o + W]); sub8(sm, raw[o]); }
    }
}
__device__ __forceinline__ void attn_pool_phase(LAS unsigned char* lds, const bf16_t* Qb, const bf16_t* Kb, const bf16_t* Vt, const bf16_t* Ub, bf16_t* cat, const float* rpb_l, int G, int bid, int tid) {
    asm volatile("" : "+v"(tid));
    LAS float* tab = (LAS float*)lds;
    for (int i = tid; i < NHEAD * RPB_N; i += 512) tab[i] = rpb_l[i] * LOG2E;
    __syncthreads();
    const int lane = tid & 63, h = __builtin_amdgcn_readfirstlane(tid >> 6), q16 = lane & 15, g4 = lane >> 4;
    const LAS float* tabh = tab + h * RPB_N;
    for (int unit = bid; unit < BATCH * 64; unit += G) {
        const int b = unit >> 6, r = unit & 63; const int rs = r < 4 ? 0 : (r > 60 ? 56 : r - 4);
        const size_t tok0 = (size_t)b * SEQ + r * 64;
#pragma unroll 1
        for (int j = 0; j < 4; ++j) {
            const int cb = (j == 0) ? 0 : (j == 1) ? 8 : (j == 2) ? 24 : 32;
            const int qc = 16 * j + q16; const int cs = qc < 8 ? 0 : (qc > 56 ? 48 : qc - 8);
            const bf16_t* qp = Qb + (tok0 + qc) * AW + h * 64 + g4 * 8;
            const bf16x8 q0 = *(const bf16x8*)qp, q1 = *(const bf16x8*)(qp + 32);
            bf16x8 kf[8][2][2];
            const bf16_t* kbase = Kb + ((size_t)b * SEQ + rs * 64 + cb + (q16 >> 2) * 8 + (q16 & 3)) * AW + h * 64 + g4 * 8;
#pragma unroll
            for (int i = 0; i < 8; ++i)
#pragma unroll
                for (int hh = 0; hh < 2; ++hh) { const bf16_t* kp = kbase + (size_t)(i * 64 + hh * 4) * AW; kf[i][hh][0] = *(const bf16x8*)kp; kf[i][hh][1] = *(const bf16x8*)(kp + 32); }
            __builtin_amdgcn_sched_barrier(0);
            f32x4 s[8][2];
            float mx = -1e30f;
#pragma unroll
            for (int i = 0; i < 8; ++i)
#pragma unroll
                for (int hh = 0; hh < 2; ++hh) {
                    f32x4 acc = (f32x4){0.f, 0.f, 0.f, 0.f};
                    acc = __builtin_amdgcn_mfma_f32_16x16x32_bf16(kf[i][hh][0], q0, acc, 0, 0, 0);
                    acc = __builtin_amdgcn_mfma_f32_16x16x32_bf16(kf[i][hh][1], q1, acc, 0, 0, 0);
                    const LAS float* trow = tabh + (rs + i - r + 7) * RPB_W;
#pragma unroll
                    for (int jj = 0; jj < 4; ++jj) {
                        const int kc = cb + g4 * 8 + hh * 4 + jj; const bool valid = (kc >= cs) && (kc < cs + 16);
                        int bi = kc - qc + 15; bi = bi < 0 ? 0 : (bi > 30 ? 30 : bi);
                        const float sv = valid ? acc[jj] + trow[bi] : -1e30f;
                        acc[jj] = sv; mx = fmaxf(mx, sv);
                    }
                    s[i][hh] = acc;
                }
            bf16x8 vf[8][4];
            const bf16_t* vbase = Vt + ((size_t)(b * 512 + h * 64 + q16)) * SEQ + rs * 64 + cb + g4 * 8;
#pragma unroll
            for (int i = 0; i < 8; ++i)
#pragma unroll
                for (int db = 0; db < 4; ++db) vf[i][db] = *(const bf16x8*)(vbase + (size_t)(db * 16) * SEQ + i * 64);
            __builtin_amdgcn_sched_barrier(0);
            mx = fmaxf(mx, __shfl_xor(mx, 16)); mx = fmaxf(mx, __shfl_xor(mx, 32));
            float sum = 0.f;
            u32x4 pw[8];
#pragma unroll
            for (int i = 0; i < 8; ++i) {
#pragma unroll
                for (int hh = 0; hh < 2; ++hh)
#pragma unroll
                    for (int jj = 0; jj < 4; ++jj) { const float p = __builtin_amdgcn_exp2f(s[i][hh][jj] - mx); s[i][hh][jj] = p; sum += p; }
                pw[i].x = pg8::cvt_pk_bf16(s[i][0][0], s[i][0][1]); pw[i].y = pg8::cvt_pk_bf16(s[i][0][2], s[i][0][3]); pw[i].z = pg8::cvt_pk_bf16(s[i][1][0], s[i][1][1]); pw[i].w = pg8::cvt_pk_bf16(s[i][1][2], s[i][1][3]);
            }
            sum += __shfl_xor(sum, 16); sum += __shfl_xor(sum, 32);
            f32x4 o[4];
#pragma unroll
            for (int db = 0; db < 4; ++db) o[db] = (f32x4){0.f, 0.f, 0.f, 0.f};
#pragma unroll
            for (int i = 0; i < 8; ++i) {
                const bf16x8 pf = __builtin_bit_cast(bf16x8, pw[i]);
#pragma unroll
                for (int db = 0; db < 4; ++db) o[db] = __builtin_amdgcn_mfma_f32_16x16x32_bf16(vf[i][db], pf, o[db], 0, 0, 0);
            }
            const float inv = 1.0f / sum;
            bf16_t* op = cat + (tok0 + qc) * D + h * 64 + g4 * 4;
#pragma unroll
            for (int db = 0; db < 4; ++db) { u32x2 w; w.x = pg8::cvt_pk_bf16(o[db][0] * inv, o[db][1] * inv); w.y = pg8::cvt_pk_bf16(o[db][2] * inv, o[db][3] * inv); *(u32x2*)(op + db * 16) = w; }
        }
        {
            const int gidx = h & 3, hfl = h >> 2; const int T0 = r * 64 + hfl * 32 + g4 * 8; const int chan = gidx * 128 + q16 * 8;
            const bf16_t* Ubc = Ub + (size_t)b * SEQ * AW + chan; bf16_t* catc = cat + (size_t)b * SEQ * D + 512 + chan;
            if (gidx == 0) pool_lane<2>(Ubc, catc, T0); else if (gidx == 1) pool_lane<4>(Ubc, catc, T0); else if (gidx == 2) pool_lane<8>(Ubc, catc, T0); else pool_lane<16>(Ubc, catc, T0);
        }
    }
}

constexpr int N_PHASES = 2 + 7 * DEPTH;
__global__ void __launch_bounds__(512, 2) fwd_megakernel(Args a) {
    extern __shared__ __attribute__((aligned(16))) unsigned char lds_raw[];
    LAS unsigned char* lds = (LAS unsigned char*)lds_raw;
    cg::grid_group grid = cg::this_grid();
    const int tid = threadIdx.x, bid = blockIdx.x, G = gridDim.x;
    unsigned char* ws = a.ws;
    bf16_t* H = (bf16_t*)(ws + WS_H); bf16_t* F = (bf16_t*)(ws + WS_F);
    bf16_t* Qb = (bf16_t*)(ws + WS_Q); bf16_t* Kb = (bf16_t*)(ws + WS_K); bf16_t* Vt = (bf16_t*)(ws + WS_VT); bf16_t* Ub = (bf16_t*)(ws + WS_U); bf16_t* CAT = (bf16_t*)(ws + WS_CAT);
    const float* mod = (const float*)(ws + WS_MOD);
    const int lo = a.ph_lo, hi = a.ph_hi;
#define IN(k) (lo <= (k) && (k) < hi)
#define SEAM(k) do { if (IN(k) && IN((k) + 1)) grid.sync(); } while (0)

    if (IN(0)) { for (int rep = 0; rep <= PROBE_P0; ++rep) { p0_prologue(a, lds, G, bid, tid); if (rep < PROBE_P0) grid.sync(); } }
    SEAM(0);
    if (IN(1)) { ln_phase<false, false>(a.x, nullptr, H, a.ln_in_g, a.ln_in_b, mod + 1 * D, mod + 0 * D, G, bid, tid); }
    SEAM(1);
#pragma unroll 1
    for (int l = 0; l < DEPTH; ++l) {
        const int p = 2 + 7 * l;
        const float* modl = mod + (size_t)l * BATCH * NMOD;
        if (IN(p + 0)) {
            pg8::Gemm g{H, (const bf16_t*)(ws + WS_WIN) + (size_t)l * PROJ * D, M, PROJ, D}; pg8::StaticOrder S; S.init(M, PROJ, G, bid);
            pg8::EpiProj E{Qb, Kb, Vt, Ub};
            pg8::gemm_phase<pg8::EpiProj, true>(lds, g, S, E);
        }
        SEAM(p + 0);
        if (IN(p + 1)) { for (int rep = 0; rep <= PROBE_ATT; ++rep) { attn_pool_phase(lds, Qb, Kb, Vt, Ub, CAT, a.rpb + (size_t)l * NHEAD * RPB_N, G, bid, tid); if (rep < PROBE_ATT) grid.sync(); } }
        SEAM(p + 1);
        if (IN(p + 2)) {
            pg8::Gemm g{CAT, (const bf16_t*)(ws + WS_WOUT) + (size_t)l * D * D, M, D, D}; pg8::StaticOrder S; S.init(M, D, G, bid);
            pg8::EpiRes E{H, modl, 0 * D, 1 * D, 2 * D};
            pg8::gemm_phase<pg8::EpiRes, true>(lds, g, S, E);
        }
        SEAM(p + 2);
        if (IN(p + 3)) { ln_phase<true, false>(H, nullptr, H, a.ln1_g + l * D, a.ln1_b + l * D, modl + 4 * D, modl + 3 * D, G, bid, tid); }
        SEAM(p + 3);
        if (IN(p + 4)) {
            pg8::Gemm g{H, (const bf16_t*)(ws + WS_W1) + (size_t)l * FF * D, M, FF, D}; pg8::StaticOrder S; S.init(M, FF, G, bid);
            pg8::EpiRelu2 E{F, FF};
            pg8::gemm_phase<pg8::EpiRelu2, true>(lds, g, S, E);
        }
        SEAM(p + 4);
        if (IN(p + 5)) {
            pg8::Gemm g{F, (const bf16_t*)(ws + WS_W2) + (size_t)l * D * FF, M, D, FF}; pg8::StaticOrder S; S.init(M, D, G, bid);
            pg8::EpiRes E{H, modl, 3 * D, 4 * D, 5 * D};
            pg8::gemm_phase<pg8::EpiRes, true>(lds, g, S, E);
        }
        SEAM(p + 5);
        if (IN(p + 6)) {
            const bool lastl = (l == DEPTH - 1);
            const float* modn = mod + (size_t)(lastl ? l : l + 1) * BATCH * NMOD;
            if (lastl) ln_phase<true, true>(H, a.out, nullptr, a.ln2_g + l * D, a.ln2_b + l * D, modn, modn, G, bid, tid);
            else ln_phase<true, false>(H, nullptr, H, a.ln2_g + l * D, a.ln2_b + l * D, modn + 1 * D, modn + 0 * D, G, bid, tid);
        }
        SEAM(p + 6);
    }
#undef IN
#undef SEAM
}

extern "C" void kernel_launch(void* const* d_in, const int* in_sizes, int n_in, void* d_out, int out_size, void* d_ws, size_t ws_size, hipStream_t stream) {
    static int grid = 0;
    if (grid == 0) {
        if (n_in != 17 || in_sizes[0] != M * D || out_size != M * D || ws_size < WS_END) { fprintf(stderr, "kernel_launch: unexpected shapes / workspace (n_in %d, in0 %d, out %d, ws %zu)\n", n_in, n_in > 0 ? in_sizes[0] : -1, out_size, ws_size); grid = -1; return; }
        int dev = 0, cus = 0, per_cu = 0;
        hipGetDevice(&dev); hipDeviceGetAttribute(&cus, hipDeviceAttributeMultiprocessorCount, dev);
        if (hipFuncSetAttribute((const void*)fwd_megakernel, hipFuncAttributeMaxDynamicSharedMemorySize, LDS_BYTES) != hipSuccess) { fprintf(stderr, "kernel_launch: hipFuncSetAttribute failed\n"); grid = -1; return; }
        if (hipOccupancyMaxActiveBlocksPerMultiprocessor(&per_cu, (const void*)fwd_megakernel, 512, LDS_BYTES) != hipSuccess || per_cu < 1) { per_cu = 1; (void)hipGetLastError(); }
        grid = (cus > 0 ? cus : 256) * per_cu;
    }
    if (grid < 0) return;
    Args a{};
    a.x = (const float*)d_in[0]; a.c = (const float*)d_in[1]; a.ln_in_g = (const float*)d_in[2]; a.ln_in_b = (const float*)d_in[3]; a.w_ada = (const float*)d_in[4]; a.b_ada = (const float*)d_in[5];
    a.w_in = (const float*)d_in[6]; a.rpb = (const float*)d_in[7]; a.w_pool = (const float*)d_in[8]; a.pool_scale = (const float*)d_in[9]; a.w_out = (const float*)d_in[10];
    a.ln1_g = (const float*)d_in[11]; a.ln1_b = (const float*)d_in[12]; a.w_mlp1 = (const float*)d_in[13]; a.w_mlp2 = (const float*)d_in[14]; a.ln2_g = (const float*)d_in[15]; a.ln2_b = (const float*)d_in[16];
    a.out = (float*)d_out; a.ws = (unsigned char*)d_ws;
#if MK_MULTI
    for (int p = 0; p < N_PHASES; ++p) { a.ph_lo = p; a.ph_hi = p + 1; hipLaunchKernelGGL(fwd_megakernel, dim3(grid), dim3(512), LDS_BYTES, stream, a); }
#else
    a.ph_lo = 0; a.ph_hi = N_PHASES;
    void* args[] = {&a};
    hipError_t e = hipLaunchCooperativeKernel((const void*)fwd_megakernel, dim3(grid), dim3(512), args, LDS_BYTES, stream);
    if (e != hipSuccess) fprintf(stderr, "kernel_launch: cooperative launch failed: %s (grid %d)\n", hipGetErrorString(e), grid);
#endif
}
```

```cpp
#include <hip/hip_runtime.h>
#include <hip/hip_cooperative_groups.h>
#include <cstdio>
#include <cstdint>
namespace cg = cooperative_groups;

#define LAS __attribute__((address_space(3)))
typedef unsigned short bf16_t;
typedef short bf16x8 __attribute__((ext_vector_type(8)));
typedef float f32x4 __attribute__((ext_vector_type(4)));
typedef float f32x2 __attribute__((ext_vector_type(2)));
typedef unsigned u32x4 __attribute__((ext_vector_type(4)));
typedef unsigned u32x2 __attribute__((ext_vector_type(2)));

#ifndef PROBE_ATT
#define PROBE_ATT 0
#endif
#ifndef PROBE_P0
#define PROBE_P0 0
#endif
#ifndef PROBE_SYNC
#define PROBE_SYNC 0
#endif
#ifndef MK_MULTI
#define MK_MULTI 0
#endif

constexpr int BATCH = 16, SEQ = 4096, D = 1024, DEPTH = 2, M = BATCH * SEQ;
constexpr int PROJ = 2048, FF = 4096, NMOD = 6 * D, AW = 512;
constexpr int NHEAD = 8;
constexpr float LN_EPS = 1e-5f;
constexpr float DN_ALPHA = 1.41421356237309515f;
constexpr float LOG2E = 1.44269504088896341f;
constexpr float QSCALE = 0.125f * LOG2E;
constexpr int RPB_H = 15, RPB_W = 31, RPB_N = RPB_H * RPB_W;

constexpr size_t MiB = (size_t)1 << 20;
constexpr size_t WS_WIN = 0 * MiB;
constexpr size_t WS_WOUT = 8 * MiB;
constexpr size_t WS_W1 = 12 * MiB;
constexpr size_t WS_W2 = 28 * MiB;
constexpr size_t WS_MOD = 44 * MiB;
constexpr size_t WS_CTL = 46 * MiB;
constexpr size_t WS_X = 48 * MiB;
constexpr size_t WS_H = 304 * MiB;
constexpr size_t WS_F = 432 * MiB;
constexpr size_t WS_Q = 432 * MiB;
constexpr size_t WS_K = 496 * MiB;
constexpr size_t WS_VT = 560 * MiB;
constexpr size_t WS_U = 624 * MiB;
constexpr size_t WS_CAT = 688 * MiB;
constexpr size_t WS_END = 944 * MiB;

constexpr int LDS_BYTES = 147456;

namespace pg8 {
constexpr int BM = 256, BK = 64, HALF = 128, HTB = HALF * BK * 2, STAGE_BYTES = 8 * HTB, NXCD = 8, WGM = 8;
__host__ __device__ __forceinline__ int lds_byte(int r, int c) { const int st = (r >> 4) * 2 + (c >> 5), rr = r & 15, cc = c & 31, ob = rr * 64 + cc * 2; return st * 1024 + (ob ^ (((ob >> 9) & 1) << 5)); }
__host__ __device__ __forceinline__ void stage_rc(int b, int& R, int& C) { const int st = b / 1024, sb = b % 1024, swz = sb ^ (((sb >> 9) & 1) << 5); R = (st >> 1) * 16 + swz / 64; C = (st & 1) * 32 + (swz % 64) / 2; }
__host__ __device__ __forceinline__ int perm32(int rho) { const int n = rho >> 4, i = rho & 15; return 8 * (i >> 2) + 4 * n + (i & 3); }

struct Unit { int pm, pn; };
struct Gemm { const bf16_t* A; const bf16_t* Bt; int M, N, K; };

struct StaticOrder {
    int nM, nN, nwg, G, c;
    __device__ void init(int M_, int N_, int G_, int c_) { nM = M_ / BM; nN = N_ / BM; nwg = nM * nN; G = G_; c = c_; }
    __device__ bool next(int i, Unit& u) const {
        const long L = (long)i * G + c; if (L >= nwg) return false;
        int wgid = (int)L; { const int q = nwg / NXCD, r = nwg % NXCD, xcd = wgid % NXCD, off = wgid / NXCD; wgid = (xcd < r ? xcd * (q + 1) : r * (q + 1) + (xcd - r) * q) + off; }
        const int nig = WGM * nN, gid = wgid / nig, fm = gid * WGM, gsz = (nM - fm) < WGM ? (nM - fm) : WGM;
        u.pm = fm + ((wgid % nig) % gsz); u.pn = (wgid % nig) / gsz; return true;
    }
};

__device__ __forceinline__ unsigned cvt_pk_bf16(float lo, float hi) { unsigned r; asm volatile("v_cvt_pk_bf16_f32 %0, %1, %2" : "=v"(r) : "v"(lo), "v"(hi)); return r; }

struct EpiProj {
    static constexpr bool PERM = true, VSWAP = true;
    bf16_t* Q; bf16_t* Kb; bf16_t* Vt; bf16_t* U;
    __device__ __forceinline__ void operator()(const f32x4 (&acc)[2][2][4][2], const Unit& u, int wr, int wc, int fr, int fq) const {
        const int t = u.pn >> 1;
        if (t == 2) {
            const int dg0 = (u.pn & 1) * 256 + wr * 64 + fr; const int b = u.pm >> 4; const int s0 = (u.pm & 15) * 256 + wc * 32 + 8 * fq;
#pragma unroll
            for (int ai = 0; ai < 2; ++ai)
#pragma unroll
                for (int m = 0; m < 4; ++m) { bf16_t* rowp = Vt + (size_t)(b * 512 + dg0 + ai * HALF + m * 16) * SEQ + s0;
#pragma unroll
                    for (int bj = 0; bj < 2; ++bj) { const f32x4 v0 = acc[ai][bj][m][0], v1 = acc[ai][bj][m][1];
                        u32x4 w; w.x = cvt_pk_bf16(v0[0], v0[1]); w.y = cvt_pk_bf16(v0[2], v0[3]); w.z = cvt_pk_bf16(v1[0], v1[1]); w.w = cvt_pk_bf16(v1[2], v1[3]);
                        *(u32x4*)(rowp + bj * HALF) = w; } }
        } else {
            bf16_t* base = Q + (size_t)t * ((size_t)M * AW); const float sc = t == 0 ? QSCALE : 1.0f;
            const int row0 = u.pm * BM + wr * 64 + fr, col0 = (u.pn & 1) * 256 + wc * 32 + 8 * fq;
#pragma unroll
            for (int ai = 0; ai < 2; ++ai)
#pragma unroll
                for (int m = 0; m < 4; ++m) { bf16_t* rowp = base + (size_t)(row0 + ai * HALF + m * 16) * AW + col0;
#pragma unroll
                    for (int bj = 0; bj < 2; ++bj) { const f32x4 v0 = acc[ai][bj][m][0] * sc, v1 = acc[ai][bj][m][1] * sc;
                        u32x4 w; w.x = cvt_pk_bf16(v0[0], v0[1]); w.y = cvt_pk_bf16(v0[2], v0[3]); w.z = cvt_pk_bf16(v1[0], v1[1]); w.w = cvt_pk_bf16(v1[2], v1[3]);
                        *(u32x4*)(rowp + bj * HALF) = w; } }
        }
    }
};
struct EpiRelu2 {
    static constexpr bool PERM = true, VSWAP = false;
    bf16_t* O; int ldc;
    __device__ __forceinline__ void operator()(const f32x4 (&acc)[2][2][4][2], const Unit& u, int wr, int wc, int fr, int fq) const {
        const int row0 = u.pm * BM + wr * 64 + fr, col0 = u.pn * BM + wc * 32 + 8 * fq;
#pragma unroll
        for (int ai = 0; ai < 2; ++ai)
#pragma unroll
            for (int m = 0; m < 4; ++m) { bf16_t* rowp = O + (size_t)(row0 + ai * HALF + m * 16) * ldc + col0;
#pragma unroll
                for (int bj = 0; bj < 2; ++bj) { f32x4 v0 = acc[ai][bj][m][0], v1 = acc[ai][bj][m][1];
#pragma unroll
                    for (int j = 0; j < 4; ++j) { const float a = fmaxf(v0[j], 0.f), b = fmaxf(v1[j], 0.f); v0[j] = a * a; v1[j] = b * b; }
                    u32x4 w; w.x = cvt_pk_bf16(v0[0], v0[1]); w.y = cvt_pk_bf16(v0[2], v0[3]); w.z = cvt_pk_bf16(v1[0], v1[1]); w.w = cvt_pk_bf16(v1[2], v1[3]);
                    *(u32x4*)(rowp + bj * HALF) = w; } }
    }
};
struct EpiRes {
    static constexpr bool PERM = true, VSWAP = false;
    bf16_t* H; const float* mod; int sh_off, sc_off, g_off;
    __device__ __forceinline__ void operator()(const f32x4 (&acc)[2][2][4][2], const Unit& u, int wr, int wc, int fr, int fq) const {
        const int row0 = u.pm * BM + wr * 64 + fr, col0 = u.pn * BM + wc * 32 + 8 * fq; const int b = u.pm >> 4;
        const float* mb = mod + (size_t)b * NMOD + col0;
        f32x4 shv[2][2], aiv[2][2], g1v[2][2];
#pragma unroll
        for (int bj = 0; bj < 2; ++bj)
#pragma unroll
            for (int n = 0; n < 2; ++n) { shv[bj][n] = *(const f32x4*)(mb + sh_off + bj * HALF + 4 * n); const f32x4 s1 = *(const f32x4*)(mb + sc_off + bj * HALF + 4 * n) + 1.0f;
                aiv[bj][n] = (f32x4){DN_ALPHA / s1.x, DN_ALPHA / s1.y, DN_ALPHA / s1.z, DN_ALPHA / s1.w}; g1v[bj][n] = *(const f32x4*)(mb + g_off + bj * HALF + 4 * n) + 1.0f; }
#pragma unroll
        for (int ai = 0; ai < 2; ++ai)
#pragma unroll
            for (int m = 0; m < 4; ++m) { bf16_t* rowp = H + (size_t)(row0 + ai * HALF + m * 16) * D + col0;
#pragma unroll
                for (int bj = 0; bj < 2; ++bj) { const u32x4 hw = *(const u32x4*)(rowp + bj * HALF);
                    f32x4 h0, h1; h0.x = __builtin_bit_cast(float, hw.x << 16); h0.y = __builtin_bit_cast(float, hw.x & 0xffff0000u); h0.z = __builtin_bit_cast(float, hw.y << 16); h0.w = __builtin_bit_cast(float, hw.y & 0xffff0000u);
                    h1.x = __builtin_bit_cast(float, hw.z << 16); h1.y = __builtin_bit_cast(float, hw.z & 0xffff0000u); h1.z = __builtin_bit_cast(float, hw.w << 16); h1.w = __builtin_bit_cast(float, hw.w & 0xffff0000u);
                    const f32x4 z0 = (h0 - shv[bj][0]) * aiv[bj][0] + g1v[bj][0] * acc[ai][bj][m][0], z1 = (h1 - shv[bj][1]) * aiv[bj][1] + g1v[bj][1] * acc[ai][bj][m][1];
                    u32x4 w; w.x = cvt_pk_bf16(z0[0], z0[1]); w.y = cvt_pk_bf16(z0[2], z0[3]); w.z = cvt_pk_bf16(z1[0], z1[1]); w.w = cvt_pk_bf16(z1[2], z1[3]);
                    *(u32x4*)(rowp + bj * HALF) = w; }
                asm volatile("" ::: "memory"); }
    }
};

template <class Epi, bool ALIGN_EPI>
__device__ __forceinline__ void gemm_phase(LAS unsigned char* lds, const Gemm g, const StaticOrder& S, const Epi& E) {
    int tid = threadIdx.x; asm volatile("" : "+v"(tid));
    const int wid = __builtin_amdgcn_readfirstlane(tid >> 6), lane = tid & 63, wr = wid >> 2, wc = wid & 3, fr = lane & 15, fq = lane >> 4;
    const int K = g.K, nt = K / BK;
    unsigned voffA[2], voffB[2];
#pragma unroll
    for (int i = 0; i < 2; ++i) { int R, C; stage_rc(tid * 16 + i * 8192, R, C); const int Rb = Epi::PERM ? ((R & ~31) + perm32(R & 31)) : R;
        voffA[i] = (unsigned)(R * K + C) * 2u; voffB[i] = (unsigned)(Rb * K + C) * 2u; }
    const size_t kstep = (size_t)(BK * 2);
    const size_t hstep = (size_t)HALF * K * 2;
    const size_t tstep = 2 * hstep;
    const unsigned ldsw = (unsigned)wid * 1024u;
    const int aoff = lds_byte(wr * 64 + fr, fq * 8), boff = lds_byte(wc * 32 + fr, fq * 8);
#define PG8_SA(b, h) (((b) * 2 + (h)) * HTB)
#define PG8_SB(b, h) ((4 + (b) * 2 + (h)) * HTB)
#define PG8_STAGE(bufoff, gbase, voff) do { _Pragma("unroll") for (int _i = 0; _i < 2; ++_i) \
        __builtin_amdgcn_global_load_lds((const unsigned*)((const char*)(gbase) + (voff)[_i]), (LAS unsigned*)(lds + (bufoff) + ldsw + _i * 8192), 16, 0, 0); } while (0)
#define PG8_LDA(dst, b, h) do { _Pragma("unroll") for (int m = 0; m < 4; ++m) _Pragma("unroll") for (int k = 0; k < 2; ++k) dst[m][k] = *(const LAS bf16x8*)(lds + PG8_SA(b, h) + aoff + m * 2048 + k * 1024); } while (0)
#define PG8_LDB(dst, b, h) do { _Pragma("unroll") for (int n = 0; n < 2; ++n) _Pragma("unroll") for (int k = 0; k < 2; ++k) dst[n][k] = *(const LAS bf16x8*)(lds + PG8_SB(b, h) + boff + n * 2048 + k * 1024); } while (0)
#define PG8_MMA(ai, bj, At, Bt) do { __builtin_amdgcn_s_setprio(1); _Pragma("unroll") for (int m = 0; m < 4; ++m) _Pragma("unroll") for (int n = 0; n < 2; ++n) _Pragma("unroll") for (int k = 0; k < 2; ++k) \
        acc[ai][bj][m][n] = __builtin_amdgcn_mfma_f32_16x16x32_bf16(Bt[n][k], At[m][k], acc[ai][bj][m][n], 0, 0, 0); __builtin_amdgcn_s_setprio(0); } while (0)
#define PG8_WAIT_V(n) asm volatile("s_waitcnt vmcnt(" #n ")" ::: "memory")
#define PG8_WAIT_L(n) asm volatile("s_waitcnt lgkmcnt(" #n ")" ::: "memory")
#define PG8_BAR __builtin_amdgcn_s_barrier()
#define PG8_SCHED __builtin_amdgcn_sched_barrier(0)
#define PG8_PTRS(u, pa, pb) do { const bool _sw = Epi::VSWAP && (((u).pn >> 1) == 2); const char* _a = (const char*)g.A + (size_t)(u).pm * tstep; const char* _b = (const char*)g.Bt + (size_t)(u).pn * tstep; pa = _sw ? _b : _a; pb = _sw ? _a : _b; } while (0)
    Unit cur, nxt; int ui = 0;
    if (!S.next(0, cur)) return;
    f32x4 acc[2][2][4][2];
#pragma unroll
    for (int a = 0; a < 2; ++a)
#pragma unroll
        for (int b = 0; b < 2; ++b)
#pragma unroll
            for (int m = 0; m < 4; ++m)
#pragma unroll
                for (int n = 0; n < 2; ++n) acc[a][b][m][n] = (f32x4){0.f, 0.f, 0.f, 0.f};
    bf16x8 At[4][2], B0[2][2], B1[2][2];
    const char* cA; const char* cB; PG8_PTRS(cur, cA, cB);
    PG8_STAGE(PG8_SB(0, 0), cB, voffB); PG8_STAGE(PG8_SB(0, 1), cB + hstep, voffB); PG8_STAGE(PG8_SA(0, 0), cA, voffA); PG8_STAGE(PG8_SA(0, 1), cA + hstep, voffA);
    if (wr == 1) PG8_BAR;
    PG8_WAIT_V(2); PG8_BAR;
    PG8_STAGE(PG8_SB(1, 0), cB + kstep, voffB); PG8_STAGE(PG8_SA(1, 0), cA + kstep, voffA); PG8_STAGE(PG8_SB(1, 1), cB + hstep + kstep, voffB);
    PG8_WAIT_V(6); PG8_BAR;
    for (;;) {
        const bool has_next = S.next(ui + 1, nxt);
        const char* nA = cA; const char* nB = cB; if (has_next) { PG8_PTRS(nxt, nA, nB); }
        for (int t = 0; t < nt; t += 2) {
            const bool last = (t == nt - 2);
            const char* a1 = cA + (size_t)(t + 1) * kstep;
            const char* a2 = last ? nA : cA + (size_t)(t + 2) * kstep; const char* b2 = last ? nB : cB + (size_t)(t + 2) * kstep;
            const char* a3 = a2 + kstep; const char* b3 = b2 + kstep;
            PG8_LDB(B0, 0, 0); PG8_LDB(B1, 0, 1); PG8_SCHED; PG8_LDA(At, 0, 0); PG8_STAGE(PG8_SA(1, 1), a1 + hstep, voffA);
            PG8_WAIT_V(8); PG8_WAIT_L(0); PG8_BAR; PG8_MMA(0, 0, At, B0); PG8_MMA(0, 1, At, B1); PG8_BAR; PG8_SCHED;
            PG8_LDA(At, 0, 1); PG8_STAGE(PG8_SB(0, 0), b2, voffB); PG8_STAGE(PG8_SB(0, 1), b2 + hstep, voffB); PG8_STAGE(PG8_SA(0, 0), a2, voffA);
            PG8_WAIT_V(8); PG8_WAIT_L(0); PG8_BAR; PG8_MMA(1, 0, At, B0); PG8_MMA(1, 1, At, B1); PG8_BAR; PG8_SCHED;
            PG8_LDB(B0, 1, 0); PG8_LDB(B1, 1, 1); PG8_SCHED; PG8_LDA(At, 1, 0); PG8_STAGE(PG8_SA(0, 1), a2 + hstep, voffA);
            PG8_WAIT_V(8); PG8_WAIT_L(0); PG8_BAR; PG8_MMA(0, 0, At, B0); PG8_MMA(0, 1, At, B1); PG8_BAR; PG8_SCHED;
            PG8_LDA(At, 1, 1); PG8_STAGE(PG8_SB(1, 0), b3, voffB); PG8_STAGE(PG8_SB(1, 1), b3 + hstep, voffB); PG8_STAGE(PG8_SA(1, 0), a3, voffA);
            PG8_WAIT_V(8); PG8_WAIT_L(0); PG8_BAR; PG8_MMA(1, 0, At, B0); PG8_MMA(1, 1, At, B1); PG8_BAR; PG8_SCHED;
        }
        if constexpr (ALIGN_EPI) { if (wr == 0) PG8_BAR; }
        E(acc, cur, wr, wc, fr, fq);
        if (!has_next) break;
#pragma unroll
        for (int a = 0; a < 2; ++a)
#pragma unroll
            for (int b = 0; b < 2; ++b)
#pragma unroll
                for (int m = 0; m < 4; ++m)
#pragma unroll
                    for (int n = 0; n < 2; ++n) acc[a][b][m][n] = (f32x4){0.f, 0.f, 0.f, 0.f};
        cur = nxt; cA = nA; cB = nB; ++ui;
        if constexpr (ALIGN_EPI) { if (wr == 1) PG8_BAR; }
    }
    PG8_WAIT_V(0);
    if constexpr (!ALIGN_EPI) { if (wr == 0) PG8_BAR; }
    PG8_BAR;
#undef PG8_SA
#undef PG8_SB
#undef PG8_STAGE
#undef PG8_LDA
#undef PG8_LDB
#undef PG8_MMA
#undef PG8_WAIT_V
#undef PG8_WAIT_L
#undef PG8_BAR
#undef PG8_SCHED
#undef PG8_PTRS
}
}

#define XB_TMO      128
#define XB_XCNT(j)  (256  + 64 * (j))
#define XB_XSUB(j)  (1280 + 64 * (j))
#define XB_XGEN(j)  (2304 + 64 * (j))
#define XB_TOP      3328
#define XB_TOPGEN   3392
#define XCD_BAR_WORDS 3456
#define XB_SPIN_CAP (1u << 18)
__device__ __forceinline__ unsigned xb_ld(unsigned* p)              { return __hip_atomic_load(p, __ATOMIC_RELAXED, __HIP_MEMORY_SCOPE_AGENT); }
__device__ __forceinline__ unsigned xb_add(unsigned* p, unsigned v) { return __hip_atomic_fetch_add(p, v, __ATOMIC_RELAXED, __HIP_MEMORY_SCOPE_AGENT); }
__device__ __forceinline__ unsigned xb_xcc_id() { return (unsigned)__builtin_amdgcn_s_getreg((3 << 11) | 20) & 0xFu; }
#define XB_SPIN(cond, bar) do { unsigned _sp = 0; while (cond) { __builtin_amdgcn_s_sleep(1); \
    if ((++_sp & 255u) == 0u) { if (xb_ld(&(bar)[XB_TMO])) break; if (_sp > XB_SPIN_CAP) { atomicAdd(&(bar)[XB_TMO], 1u); break; } } } } while (0)
struct XcdBarrier { unsigned* bar; unsigned x; volatile LAS unsigned* st; };
__device__ __forceinline__ XcdBarrier xcd_barrier_post(unsigned* bar, volatile LAS unsigned* st) {
    XcdBarrier b; b.bar = bar; b.x = xb_xcc_id(); b.st = st;
    if (threadIdx.x == 0) (void)xb_add(&bar[XB_XCNT(b.x)], 1u);
    return b;
}
__device__ __forceinline__ void xcd_barrier_complete(unsigned* bar, unsigned x, unsigned& nloc, unsigned& nx) {
    const unsigned G = gridDim.x * gridDim.y * gridDim.z;
    unsigned sum, cnt, mine, sp = 0u;
    for (;;) {
        sum = 0u; cnt = 0u; mine = 0u;
#pragma unroll
        for (unsigned j = 0; j < 16; ++j) { const unsigned c = xb_ld(&bar[XB_XCNT(j)]); sum += c; cnt += (c > 0u) ? 1u : 0u; mine = (j == x) ? c : mine; }
        if (sum == G) break;
        __builtin_amdgcn_s_sleep(1);
        if ((++sp & 255u) == 0u) { if (xb_ld(&bar[XB_TMO])) break; if (sp > XB_SPIN_CAP) { atomicAdd(&bar[XB_TMO], 1u); break; } }
    }
    nloc = mine > 0u ? mine : 1u; nx = cnt > 0u ? cnt : 1u;
}
__device__ __forceinline__ void xcd_barrier(const XcdBarrier& b) {
    asm volatile("s_waitcnt vmcnt(0)" ::: "memory");
    __syncthreads();
    if (threadIdx.x == 0) {
        unsigned* bar = b.bar;
        __builtin_amdgcn_s_waitcnt(0);
        unsigned nloc = b.st[0], nx = b.st[1];
        if (nloc == 0u) { xcd_barrier_complete(bar, b.x, nloc, nx); b.st[0] = nloc; b.st[1] = nx; }
        const unsigned old = xb_add(&bar[XB_XSUB(b.x)], 1u);
        const unsigned gen = old / nloc;
        if (old + 1u == (gen + 1u) * nloc) {
            __builtin_amdgcn_fence(__ATOMIC_RELEASE, "agent");
            asm volatile("s_waitcnt vmcnt(0)" ::: "memory");
            const unsigned og = xb_add(&bar[XB_TOP], 1u);
            const unsigned tg = og / nx;
            if (og + 1u == (tg + 1u) * nx) xb_add(&bar[XB_TOPGEN], 1u);
            else XB_SPIN(xb_ld(&bar[XB_TOPGEN]) == tg, bar);
            __builtin_amdgcn_fence(__ATOMIC_ACQUIRE, "agent");
            xb_add(&bar[XB_XGEN(b.x)], 1u);
            asm volatile("s_waitcnt vmcnt(0)" ::: "memory");
        } else {
            XB_SPIN(xb_ld(&bar[XB_XGEN(b.x)]) == gen, bar);
            __builtin_amdgcn_fence(__ATOMIC_ACQUIRE, "agent");
            asm volatile("s_waitcnt vmcnt(0)" ::: "memory");
        }
    }
    __syncthreads();
}

__device__ __forceinline__ unsigned f2bf(float f) { unsigned u = __builtin_bit_cast(unsigned, f); return (u + 0x7fffu + ((u >> 16) & 1u)) >> 16; }
__device__ __forceinline__ unsigned pk2(float lo, float hi) { return f2bf(lo) | (f2bf(hi) << 16); }
__device__ __forceinline__ float bflo(unsigned w) { return __builtin_bit_cast(float, w << 16); }
__device__ __forceinline__ float bfhi(unsigned w) { return __builtin_bit_cast(float, w & 0xffff0000u); }
__device__ __forceinline__ float wave_sum(float v) {
#pragma unroll
    for (int o = 1; o < 64; o <<= 1) v += __shfl_xor(v, o);
    return v;
}

__device__ __forceinline__ void transpose_item(const float* W, int N, bf16_t* WT, int ldw, LAS float* scr, int kb, int nb, int lane) {
    const int k0 = 64 * kb, n0 = 32 * nb;
#pragma unroll 8
    for (int i = 0; i < 32; ++i) { const int kk = 2 * i + (lane >> 5); scr[kk * 33 + (lane & 31)] = W[(size_t)(k0 + kk) * N + n0 + (lane & 31)]; }
    asm volatile("s_waitcnt lgkmcnt(0)" ::: "memory");
    const int c = lane & 7;
#pragma unroll
    for (int j = 0; j < 4; ++j) { const int n = (lane >> 3) + 8 * j; const LAS float* s = scr + (8 * c) * 33 + n;
        u32x4 o; o.x = pk2(s[0 * 33], s[1 * 33]); o.y = pk2(s[2 * 33], s[3 * 33]); o.z = pk2(s[4 * 33], s[5 * 33]); o.w = pk2(s[6 * 33], s[7 * 33]);
        *(u32x4*)(WT + (size_t)(n0 + n) * ldw + k0 + 8 * c) = o; }
    asm volatile("s_waitcnt lgkmcnt(0)" ::: "memory");
}

struct Args {
    const float *x, *c, *ln_in_g, *ln_in_b, *w_ada, *b_ada, *w_in, *rpb, *w_pool, *pool_scale, *w_out, *ln1_g, *ln1_b, *w_mlp1, *w_mlp2, *ln2_g, *ln2_b;
    float* out; unsigned char* ws; int ph_lo, ph_hi;
};

__device__ __forceinline__ void p0_prologue(const Args& a, LAS unsigned char* lds, int G, int bid, int tid) {
    asm volatile("" : "+v"(tid));
    const int lane = tid & 63, wave = tid >> 6;
    unsigned char* ws = a.ws;
    float* mod = (float*)(ws + WS_MOD);
    for (int item = bid; item < 2 * (NMOD / 64); item += G) {
        const int l = item / (NMOD / 64), n0 = (item % (NMOD / 64)) * 64;
        LAS float* cact = (LAS float*)lds;
        LAS float* red = (LAS float*)(lds + 65536);
        for (int i = tid; i < BATCH * D; i += 512) { const int b = i >> 10, k = i & 1023; const float v = a.c[i]; cact[k * 16 + b] = v / (1.0f + expf(-v)); }
        __syncthreads();
        const int ks = tid >> 6, col = tid & 63;
        float acc[16];
#pragma unroll
        for (int b = 0; b < 16; ++b) acc[b] = 0.f;
        const float* wp = a.w_ada + (size_t)l * D * NMOD + (size_t)(ks * 128) * NMOD + n0 + col;
#pragma unroll 4
        for (int kk = 0; kk < 128; ++kk) {
            const float w = wp[(size_t)kk * NMOD];
            const LAS f32x4* cp = (const LAS f32x4*)(cact + (ks * 128 + kk) * 16);
#pragma unroll
            for (int q = 0; q < 4; ++q) { const f32x4 cv = cp[q]; acc[4 * q + 0] += cv.x * w; acc[4 * q + 1] += cv.y * w; acc[4 * q + 2] += cv.z * w; acc[4 * q + 3] += cv.w * w; }
        }
#pragma unroll
        for (int b = 0; b < 16; ++b) red[(ks * 16 + b) * 64 + col] = acc[b];
        __syncthreads();
        for (int o = tid; o < 1024; o += 512) { const int b = o >> 6, cc = o & 63; float s = 0.f;
#pragma unroll
            for (int k8 = 0; k8 < 8; ++k8) s += red[(k8 * 16 + b) * 64 + cc];
            mod[(size_t)(l * 16 + b) * NMOD + n0 + cc] = s + a.b_ada[l * NMOD + n0 + cc]; }
        __syncthreads();
    }
    for (int idx = bid * 512 + tid; idx < 2 * 4 * 16 * 1024; idx += G * 512) {
        const int l = idx >> 16, g = (idx >> 14) & 3, cch = (idx >> 10) & 15, n = idx & 1023;
        const float* wo = a.w_out + (size_t)l * D * D + (size_t)(512 + g * 128) * D + n;
        const float* wpl = a.w_pool + ((size_t)(l * 4 + g) * 128 + cch * 8) * 128;
        const float* ps = a.pool_scale + l * 512 + g * 128;
        float acc[8];
#pragma unroll
        for (int i = 0; i < 8; ++i) acc[i] = 0.f;
#pragma unroll 4
        for (int d = 0; d < 128; ++d) { const float v = wo[(size_t)d * D] * ps[d];
#pragma unroll
            for (int i = 0; i < 8; ++i) acc[i] += wpl[i * 128 + d] * v; }
        u32x4 o; o.x = pk2(acc[0], acc[1]); o.y = pk2(acc[2], acc[3]); o.z = pk2(acc[4], acc[5]); o.w = pk2(acc[6], acc[7]);
        *(u32x4*)((bf16_t*)(ws + WS_WOUT) + (size_t)l * D * D + (size_t)n * D + 512 + g * 128 + cch * 8) = o;
    }
    {
        LAS float* scr = (LAS float*)(lds + wave * 16384);
        const int gw = bid * 8 + wave, NGW = G * 8;
        constexpr int I_IN = 16 * 64, I_OUT = 8 * 32, I_1 = 16 * 128, I_2 = 64 * 32, I_L = I_IN + I_OUT + I_1 + I_2;
        for (int it = gw; it < 2 * I_L; it += NGW) {
            const int l = it / I_L; int r = it % I_L;
            if (r < I_IN) { transpose_item(a.w_in + (size_t)l * D * PROJ, PROJ, (bf16_t*)(ws + WS_WIN) + (size_t)l * PROJ * D, D, scr, r / 64, r % 64, lane); continue; } r -= I_IN;
            if (r < I_OUT) { transpose_item(a.w_out + (size_t)l * D * D, D, (bf16_t*)(ws + WS_WOUT) + (size_t)l * D * D, D, scr, r / 32, r % 32, lane); continue; } r -= I_OUT;
            if (r < I_1) { transpose_item(a.w_mlp1 + (size_t)l * D * FF, FF, (bf16_t*)(ws + WS_W1) + (size_t)l * FF * D, D, scr, r / 128, r % 128, lane); continue; } r -= I_1;
            transpose_item(a.w_mlp2 + (size_t)l * FF * D, D, (bf16_t*)(ws + WS_W2) + (size_t)l * D * FF, FF, scr, r / 32, r % 32, lane);
        }
    }
}

template <bool SRC_BF16, bool OUT_F32>
__device__ __forceinline__ void ln_phase(const void* srcv, float* dstF, bf16_t* dstH, const float* g, const float* bt, const float* sc, const float* sh, int G, int bid, int tid) {
    asm volatile("" : "+v"(tid));
    const int lane = tid & 63, wave = tid >> 6;
    const int gw = bid * 8 + wave, NGW = G * 8;
    const int rpw = (M + NGW - 1) / NGW;
    const int r0 = gw * rpw, r1 = (r0 + rpw < M) ? r0 + rpw : M;
    if (r0 >= M) return;
    const int c0 = 8 * lane;
    f32x4 gv[4], bv[4], scv[4], shv[4];
#pragma unroll
    for (int j = 0; j < 4; ++j) { const int cj = c0 + (j >> 1) * 512 + (j & 1) * 4; gv[j] = *(const f32x4*)(g + cj); bv[j] = *(const f32x4*)(bt + cj); scv[j] = (f32x4){1.f, 1.f, 1.f, 1.f}; shv[j] = (f32x4){0.f, 0.f, 0.f, 0.f}; }
    int curb = -1;
    f32x4 v[4]; f32x4 nf[4]; u32x4 nb[2];
    if (SRC_BF16) { const bf16_t* p = (const bf16_t*)srcv + (size_t)r0 * D + c0; nb[0] = *(const u32x4*)p; nb[1] = *(const u32x4*)(p + 512); }
    else { const float* p = (const float*)srcv + (size_t)r0 * D + c0; nf[0] = *(const f32x4*)p; nf[1] = *(const f32x4*)(p + 4); nf[2] = *(const f32x4*)(p + 512); nf[3] = *(const f32x4*)(p + 516); }
    for (int r = r0; r < r1; ++r) {
        if (SRC_BF16) {
#pragma unroll
            for (int q = 0; q < 2; ++q) { v[2 * q].x = bflo(nb[q].x); v[2 * q].y = bfhi(nb[q].x); v[2 * q].z = bflo(nb[q].y); v[2 * q].w = bfhi(nb[q].y); v[2 * q + 1].x = bflo(nb[q].z); v[2 * q + 1].y = bfhi(nb[q].z); v[2 * q + 1].z = bflo(nb[q].w); v[2 * q + 1].w = bfhi(nb[q].w); }
        } else {
#pragma unroll
            for (int j = 0; j < 4; ++j) v[j] = nf[j];
        }
        if (r + 1 < r1) {
            if (SRC_BF16) { const bf16_t* p = (const bf16_t*)srcv + (size_t)(r + 1) * D + c0; nb[0] = *(const u32x4*)p; nb[1] = *(const u32x4*)(p + 512); }
            else { const float* p = (const float*)srcv + (size_t)(r + 1) * D + c0; nf[0] = *(const f32x4*)p; nf[1] = *(const f32x4*)(p + 4); nf[2] = *(const f32x4*)(p + 512); nf[3] = *(const f32x4*)(p + 516); }
        }
        const int b = r >> 12;
        if (!OUT_F32 && b != curb) { curb = b;
#pragma unroll
            for (int j = 0; j < 4; ++j) { const int cj = c0 + (j >> 1) * 512 + (j & 1) * 4; scv[j] = *(const f32x4*)(sc + (size_t)b * NMOD + cj) + 1.0f; shv[j] = *(const f32x4*)(sh + (size_t)b * NMOD + cj); } }
        float s = 0.f;
#pragma unroll
        for (int j = 0; j < 4; ++j) s += (v[j].x + v[j].y) + (v[j].z + v[j].w);
        const float mean = wave_sum(s) * (1.f / D); float s2 = 0.f;
#pragma unroll
        for (int j = 0; j < 4; ++j) { v[j] = v[j] - mean; s2 += (v[j].x * v[j].x + v[j].y * v[j].y) + (v[j].z * v[j].z + v[j].w * v[j].w); }
        const float rstd = 1.f / sqrtf(wave_sum(s2) * (1.f / D) + LN_EPS);
#pragma unroll
        for (int j = 0; j < 4; ++j) v[j] = v[j] * rstd * gv[j] + bv[j];
        if (OUT_F32) { float* p = dstF + (size_t)r * D + c0; *(f32x4*)p = v[0]; *(f32x4*)(p + 4) = v[1]; *(f32x4*)(p + 512) = v[2]; *(f32x4*)(p + 516) = v[3]; }
        else {
#pragma unroll
            for (int j = 0; j < 4; ++j) v[j] = v[j] * scv[j] + shv[j];
            bf16_t* p = dstH + (size_t)r * D + c0;
            u32x4 w0, w1; w0.x = pk2(v[0].x, v[0].y); w0.y = pk2(v[0].z, v[0].w); w0.z = pk2(v[1].x, v[1].y); w0.w = pk2(v[1].z, v[1].w);
            w1.x = pk2(v[2].x, v[2].y); w1.y = pk2(v[2].z, v[2].w); w1.z = pk2(v[3].x, v[3].y); w1.w = pk2(v[3].z, v[3].w);
            *(u32x4*)p = w0; *(u32x4*)(p + 512) = w1;
        }
    }
}

__device__ __forceinline__ void add8(float (&s)[8], const u32x4 w) { s[0] += bflo(w.x); s[1] += bfhi(w.x); s[2] += bflo(w.y); s[3] += bfhi(w.y); s[4] += bflo(w.z); s[5] += bfhi(w.z); s[6] += bflo(w.w); s[7] += bfhi(w.w); }
__device__ __forceinline__ void sub8(float (&s)[8], const u32x4 w) { s[0] -= bflo(w.x); s[1] -= bfhi(w.x); s[2] -= bflo(w.y); s[3] -= bfhi(w.y); s[4] -= bflo(w.z); s[5] -= bfhi(w.z); s[6] -= bflo(w.w); s[7] -= bfhi(w.w); }
template <int W>
__device__ __forceinline__ void pool_lane(const bf16_t* Ubc  , bf16_t* catc  , int T0) {
    constexpr int HW = W / 2, NL = 8 + W - 1;
    u32x4 raw[NL];
#pragma unroll
    for (int k = 0; k < NL; ++k) { const int tk = T0 - HW + k; const int tc = tk < 0 ? 0 : (tk > SEQ - 1 ? SEQ - 1 : tk); u32x4 v = *(const u32x4*)(Ubc + (size_t)tc * AW);
        if (tk != tc) v = (u32x4){0u, 0u, 0u, 0u}; raw[k] = v; }
    float sm[8];
#pragma unroll
    for (int e = 0; e < 8; ++e) sm[e] = 0.f;
#pragma unroll
    for (int k = 0; k < W; ++k) add8(sm, raw[k]);
#pragma unroll
    for (int o = 0; o < 8; ++o) {
        int lo = T0 + o - HW, hi = lo + W; lo = lo < 0 ? 0 : lo; hi = hi > SEQ ? SEQ : hi; const float ic = 1.0f / (float)(hi - lo);
        const u32x4 c = raw[o + HW];
        u32x4 w; w.x = pk2(sm[0] * ic - bflo(c.x), sm[1] * ic - bfhi(c.x)); w.y = pk2(sm[2] * ic - bflo(c.y), sm[3] * ic - bfhi(c.y));
        w.z = pk2(sm[4] * ic - bflo(c.z), sm[5] * ic - bfhi(c.z)); w.w = pk2(sm[6] * ic - bflo(c.w), sm[7] * ic - bfhi(c.w));
        *(u32x4*)(catc + (size_t)(T0 + o) * D) = w;
        if (o < 7) { add8(sm, raw[o + W]); sub8(sm, raw[o]); }
    }
}
__device__ __forceinline__ void attn_pool_phase(LAS unsigned char* lds, const bf16_t* Qb, const bf16_t* Kb, const bf16_t* Vt, const bf16_t* Ub, bf16_t* cat, const float* rpb_l, int G, int bid, int tid) {
    asm volatile("" : "+v"(tid));
    LAS float* tab = (LAS float*)lds;
    for (int i = tid; i < NHEAD * RPB_N; i += 512) tab[i] = rpb_l[i] * LOG2E;
    __syncthreads();
    const int lane = tid & 63, h = __builtin_amdgcn_readfirstlane(tid >> 6), q16 = lane & 15, g4 = lane >> 4;
    const LAS float* tabh = tab + h * RPB_N;
    const bool xl = (G == 256); const int nun = xl ? 4 : (BATCH * 64 + G - 1) / G;
    for (int k = 0; k < nun; ++k) {
        const int unit = xl ? ((bid & 7) * 128 + k * 32 + (bid >> 3)) : (bid + k * G);
        if (unit >= BATCH * 64) break;
        const int b = unit >> 6, r = unit & 63; const int rs = r < 4 ? 0 : (r > 60 ? 56 : r - 4);
        const size_t tok0 = (size_t)b * SEQ + r * 64;
#pragma unroll 1
        for (int j = 0; j < 4; ++j) {
            const int cb = (j == 0) ? 0 : (j == 1) ? 8 : (j == 2) ? 24 : 32;
            const int qc = 16 * j + q16; const int cs = qc < 8 ? 0 : (qc > 56 ? 48 : qc - 8);
            const bf16_t* qp = Qb + (tok0 + qc) * AW + h * 64 + g4 * 8;
            const bf16x8 q0 = *(const bf16x8*)qp, q1 = *(const bf16x8*)(qp + 32);
            bf16x8 kf[8][2][2];
            const bf16_t* kbase = Kb + ((size_t)b * SEQ + rs * 64 + cb + (q16 >> 2) * 8 + (q16 & 3)) * AW + h * 64 + g4 * 8;
#pragma unroll
            for (int i = 0; i < 8; ++i)
#pragma unroll
                for (int hh = 0; hh < 2; ++hh) { const bf16_t* kp = kbase + (size_t)(i * 64 + hh * 4) * AW; kf[i][hh][0] = *(const bf16x8*)kp; kf[i][hh][1] = *(const bf16x8*)(kp + 32); }
            __builtin_amdgcn_sched_barrier(0);
            f32x4 s[8][2];
            float mx = -1e30f;
#pragma unroll
            for (int i = 0; i < 8; ++i)
#pragma unroll
                for (int hh = 0; hh < 2; ++hh) {
                    f32x4 acc = (f32x4){0.f, 0.f, 0.f, 0.f};
                    acc = __builtin_amdgcn_mfma_f32_16x16x32_bf16(kf[i][hh][0], q0, acc, 0, 0, 0);
                    acc = __builtin_amdgcn_mfma_f32_16x16x32_bf16(kf[i][hh][1], q1, acc, 0, 0, 0);
                    const LAS float* trow = tabh + (rs + i - r + 7) * RPB_W;
#pragma unroll
                    for (int jj = 0; jj < 4; ++jj) {
                        const int kc = cb + g4 * 8 + hh * 4 + jj; const bool valid = (kc >= cs) && (kc < cs + 16);
                        int bi = kc - qc + 15; bi = bi < 0 ? 0 : (bi > 30 ? 30 : bi);
                        const float sv = valid ? acc[jj] + trow[bi] : -1e30f;
                        acc[jj] = sv; mx = fmaxf(mx, sv);
                    }
                    s[i][hh] = acc;
                }
            bf16x8 vf[8][4];
            const bf16_t* vbase = Vt + ((size_t)(b * 512 + h * 64 + q16)) * SEQ + rs * 64 + cb + g4 * 8;
#pragma unroll
            for (int i = 0; i < 8; ++i)
#pragma unroll
                for (int db = 0; db < 4; ++db) vf[i][db] = *(const bf16x8*)(vbase + (size_t)(db * 16) * SEQ + i * 64);
            __builtin_amdgcn_sched_barrier(0);
            mx = fmaxf(mx, __shfl_xor(mx, 16)); mx = fmaxf(mx, __shfl_xor(mx, 32));
            float sum = 0.f;
            u32x4 pw[8];
#pragma unroll
            for (int i = 0; i < 8; ++i) {
#pragma unroll
                for (int hh = 0; hh < 2; ++hh)
#pragma unroll
                    for (int jj = 0; jj < 4; ++jj) { const float p = __builtin_amdgcn_exp2f(s[i][hh][jj] - mx); s[i][hh][jj] = p; sum += p; }
                pw[i].x = pg8::cvt_pk_bf16(s[i][0][0], s[i][0][1]); pw[i].y = pg8::cvt_pk_bf16(s[i][0][2], s[i][0][3]); pw[i].z = pg8::cvt_pk_bf16(s[i][1][0], s[i][1][1]); pw[i].w = pg8::cvt_pk_bf16(s[i][1][2], s[i][1][3]);
            }
            sum += __shfl_xor(sum, 16); sum += __shfl_xor(sum, 32);
            f32x4 o[4];
#pragma unroll
            for (int db = 0; db < 4; ++db) o[db] = (f32x4){0.f, 0.f, 0.f, 0.f};
#pragma unroll
            for (int i = 0; i < 8; ++i) {
                const bf16x8 pf = __builtin_bit_cast(bf16x8, pw[i]);
#pragma unroll
                for (int db = 0; db < 4; ++db) o[db] = __builtin_amdgcn_mfma_f32_16x16x32_bf16(vf[i][db], pf, o[db], 0, 0, 0);
            }
            const float inv = 1.0f / sum;
            bf16_t* op = cat + (tok0 + qc) * D + h * 64 + g4 * 4;
#pragma unroll
            for (int db = 0; db < 4; ++db) { u32x2 w; w.x = pg8::cvt_pk_bf16(o[db][0] * inv, o[db][1] * inv); w.y = pg8::cvt_pk_bf16(o[db][2] * inv, o[db][3] * inv); *(u32x2*)(op + db * 16) = w; }
        }
        {
            const int gidx = h & 3, hfl = h >> 2; const int T0 = r * 64 + hfl * 32 + g4 * 8; const int chan = gidx * 128 + q16 * 8;
            const bf16_t* Ubc = Ub + (size_t)b * SEQ * AW + chan; bf16_t* catc = cat + (size_t)b * SEQ * D + 512 + chan;
            if (gidx == 0) pool_lane<2>(Ubc, catc, T0); else if (gidx == 1) pool_lane<4>(Ubc, catc, T0); else if (gidx == 2) pool_lane<8>(Ubc, catc, T0); else pool_lane<16>(Ubc, catc, T0);
        }
    }
}

constexpr int N_PHASES = 2 + 7 * DEPTH;
__global__ void __launch_bounds__(512, 2) fwd_megakernel(Args a) {
    extern __shared__ __attribute__((aligned(16))) unsigned char lds_raw[];
    LAS unsigned char* lds = (LAS unsigned char*)lds_raw;
    cg::grid_group grid = cg::this_grid();
    const int tid = threadIdx.x, bid = blockIdx.x, G = gridDim.x;
    unsigned char* ws = a.ws;
    bf16_t* H = (bf16_t*)(ws + WS_H); bf16_t* F = (bf16_t*)(ws + WS_F);
    bf16_t* Qb = (bf16_t*)(ws + WS_Q); bf16_t* Kb = (bf16_t*)(ws + WS_K); bf16_t* Vt = (bf16_t*)(ws + WS_VT); bf16_t* Ub = (bf16_t*)(ws + WS_U); bf16_t* CAT = (bf16_t*)(ws + WS_CAT);
    const float* mod = (const float*)(ws + WS_MOD);
    const int lo = a.ph_lo, hi = a.ph_hi;
#define IN(k) (lo <= (k) && (k) < hi)
    unsigned* barw = (unsigned*)(ws + WS_CTL);
    volatile LAS unsigned* misc = (volatile LAS unsigned*)(lds + 131072 + 1024);
    if (bid == 0) { for (int i = tid; i < XCD_BAR_WORDS; i += 512) barw[i] = 0u; }
    if (tid < 2) misc[tid] = 0u;
    __syncthreads();
    XcdBarrier xbar; xbar.bar = barw; xbar.x = 0; xbar.st = misc;
#define SEAM(k) do { if (IN(k) && IN((k) + 1)) { if ((k) == 0) { grid.sync(); xbar = xcd_barrier_post(barw, misc); } else xcd_barrier(xbar); } } while (0)

    if (IN(0)) { for (int rep = 0; rep <= PROBE_P0; ++rep) { p0_prologue(a, lds, G, bid, tid); if (rep < PROBE_P0) __syncthreads(); } }
    SEAM(0);
    if (IN(1)) { ln_phase<false, false>(a.x, nullptr, H, a.ln_in_g, a.ln_in_b, mod + 1 * D, mod + 0 * D, G, bid, tid); }
    SEAM(1);
#pragma unroll 1
    for (int l = 0; l < DEPTH; ++l) {
        const int p = 2 + 7 * l;
        const float* modl = mod + (size_t)l * BATCH * NMOD;
        if (IN(p + 0)) {
            pg8::Gemm g{H, (const bf16_t*)(ws + WS_WIN) + (size_t)l * PROJ * D, M, PROJ, D}; pg8::StaticOrder S; S.init(M, PROJ, G, bid);
            pg8::EpiProj E{Qb, Kb, Vt, Ub};
            pg8::gemm_phase<pg8::EpiProj, true>(lds, g, S, E);
        }
        SEAM(p + 0);
        if (IN(p + 1)) { for (int rep = 0; rep <= PROBE_ATT; ++rep) { attn_pool_phase(lds, Qb, Kb, Vt, Ub, CAT, a.rpb + (size_t)l * NHEAD * RPB_N, G, bid, tid); if (rep < PROBE_ATT) xcd_barrier(xbar); } }
        SEAM(p + 1);
        if (IN(p + 2)) {
            pg8::Gemm g{CAT, (const bf16_t*)(ws + WS_WOUT) + (size_t)l * D * D, M, D, D}; pg8::StaticOrder S; S.init(M, D, G, bid);
            pg8::EpiRes E{H, modl, 0 * D, 1 * D, 2 * D};
            pg8::gemm_phase<pg8::EpiRes, true>(lds, g, S, E);
        }
        SEAM(p + 2);
        if (IN(p + 3)) { ln_phase<true, false>(H, nullptr, H, a.ln1_g + l * D, a.ln1_b + l * D, modl + 4 * D, modl + 3 * D, G, bid, tid); }
        SEAM(p + 3);
        if (IN(p + 4)) {
            pg8::Gemm g{H, (const bf16_t*)(ws + WS_W1) + (size_t)l * FF * D, M, FF, D}; pg8::StaticOrder S; S.init(M, FF, G, bid);
            pg8::EpiRelu2 E{F, FF};
            pg8::gemm_phase<pg8::EpiRelu2, true>(lds, g, S, E);
        }
        SEAM(p + 4);
        if (IN(p + 5)) {
            pg8::Gemm g{F, (const bf16_t*)(ws + WS_W2) + (size_t)l * D * FF, M, D, FF}; pg8::StaticOrder S; S.init(M, D, G, bid);
            pg8::EpiRes E{H, modl, 3 * D, 4 * D, 5 * D};
            pg8::gemm_phase<pg8::EpiRes, true>(lds, g, S, E);
        }
        SEAM(p + 5);
        if (IN(p + 6)) {
            const bool lastl = (l == DEPTH - 1);
            const float* modn = mod + (size_t)(lastl ? l : l + 1) * BATCH * NMOD;
            if (lastl) ln_phase<true, true>(H, a.out, nullptr, a.ln2_g + l * D, a.ln2_b + l * D, modn, modn, G, bid, tid);
            else ln_phase<true, false>(H, nullptr, H, a.ln2_g + l * D, a.ln2_b + l * D, modn + 1 * D, modn + 0 * D, G, bid, tid);
        }
        SEAM(p + 6);
    }
    for (int rep = 0; rep < PROBE_SYNC; ++rep) xcd_barrier(xbar);
#undef IN
#undef SEAM
}

extern "C" void kernel_launch(void* const* d_in, const int* in_sizes, int n_in, void* d_out, int out_size, void* d_ws, size_t ws_size, hipStream_t stream) {
    static int grid = 0;
    if (grid == 0) {
        if (n_in != 17 || in_sizes[0] != M * D || out_size != M * D || ws_size < WS_END) { fprintf(stderr, "kernel_launch: unexpected shapes / workspace (n_in %d, in0 %d, out %d, ws %zu)\n", n_in, n_in > 0 ? in_sizes[0] : -1, out_size, ws_size); grid = -1; return; }
        int dev = 0, cus = 0, per_cu = 0;
        hipGetDevice(&dev); hipDeviceGetAttribute(&cus, hipDeviceAttributeMultiprocessorCount, dev);
        if (hipFuncSetAttribute((const void*)fwd_megakernel, hipFuncAttributeMaxDynamicSharedMemorySize, LDS_BYTES) != hipSuccess) { fprintf(stderr, "kernel_launch: hipFuncSetAttribute failed\n"); grid = -1; return; }
        if (hipOccupancyMaxActiveBlocksPerMultiprocessor(&per_cu, (const void*)fwd_megakernel, 512, LDS_BYTES) != hipSuccess || per_cu < 1) { per_cu = 1; (void)hipGetLastError(); }
        grid = (cus > 0 ? cus : 256) * per_cu;
    }
    if (grid < 0) return;
    Args a{};
    a.x = (const float*)d_in[0]; a.c = (const float*)d_in[1]; a.ln_in_g = (const float*)d_in[2]; a.ln_in_b = (const float*)d_in[3]; a.w_ada = (const float*)d_in[4]; a.b_ada = (const float*)d_in[5];
    a.w_in = (const float*)d_in[6]; a.rpb = (const float*)d_in[7]; a.w_pool = (const float*)d_in[8]; a.pool_scale = (const float*)d_in[9]; a.w_out = (const float*)d_in[10];
    a.ln1_g = (const float*)d_in[11]; a.ln1_b = (const float*)d_in[12]; a.w_mlp1 = (const float*)d_in[13]; a.w_mlp2 = (const float*)d_in[14]; a.ln2_g = (const float*)d_in[15]; a.ln2_b = (const float*)d_in[16];
    a.out = (float*)d_out; a.ws = (unsigned char*)d_ws;
#if MK_MULTI
    for (int p = 0; p < N_PHASES; ++p) { a.ph_lo = p; a.ph_hi = p + 1; hipLaunchKernelGGL(fwd_megakernel, dim3(grid), dim3(512), LDS_BYTES, stream, a); }
#else
    a.ph_lo = 0; a.ph_hi = N_PHASES;
    void* args[] = {&a};
    hipError_t e = hipLaunchCooperativeKernel((const void*)fwd_megakernel, dim3(grid), dim3(512), args, LDS_BYTES, stream);
    if (e != hipSuccess) fprintf(stderr, "kernel_launch: cooperative launch failed: %s (grid %d)\n", hipGetErrorString(e), grid);
#endif
}
```

```cpp
#include <hip/hip_runtime.h>
#include <hip/hip_cooperative_groups.h>
#include <cstdio>
#include <cstdint>
namespace cg = cooperative_groups;

#define LAS __attribute__((address_space(3)))
typedef unsigned short bf16_t;
typedef short bf16x8 __attribute__((ext_vector_type(8)));
typedef float f32x4 __attribute__((ext_vector_type(4)));
typedef float f32x2 __attribute__((ext_vector_type(2)));
typedef unsigned u32x4 __attribute__((ext_vector_type(4)));
typedef unsigned u32x2 __attribute__((ext_vector_type(2)));

#ifndef PROBE_ATT
#define PROBE_ATT 0
#endif
#ifndef PROBE_P0
#define PROBE_P0 0
#endif
#ifndef PROBE_MODE
#define PROBE_MODE 0
#endif
#ifndef PROBE_SYNC
#define PROBE_SYNC 0
#endif
#ifndef MK_MULTI
#define MK_MULTI 0
#endif

constexpr int BATCH = 16, SEQ = 4096, D = 1024, DEPTH = 2, M = BATCH * SEQ;
constexpr int PROJ = 2048, FF = 4096, NMOD = 6 * D, AW = 512;
constexpr int NHEAD = 8;
constexpr float LN_EPS = 1e-5f;
constexpr float DN_ALPHA = 1.41421356237309515f;
constexpr float LOG2E = 1.44269504088896341f;
constexpr float QSCALE = 0.125f * LOG2E;
constexpr int RPB_H = 15, RPB_W = 31, RPB_N = RPB_H * RPB_W;

constexpr size_t MiB = (size_t)1 << 20;
constexpr size_t WS_WIN = 0 * MiB;
constexpr size_t WS_WOUT = 8 * MiB;
constexpr size_t WS_W1 = 12 * MiB;
constexpr size_t WS_W2 = 28 * MiB;
constexpr size_t WS_MOD = 44 * MiB;
constexpr size_t WS_CTL = 46 * MiB;
constexpr size_t WS_X = 48 * MiB;
constexpr size_t WS_H = 304 * MiB;
constexpr size_t WS_F = 432 * MiB;
constexpr size_t WS_Q = 432 * MiB;
constexpr size_t WS_K = 496 * MiB;
constexpr size_t WS_VT = 560 * MiB;
constexpr size_t WS_U = 624 * MiB;
constexpr size_t WS_CAT = 688 * MiB;
constexpr size_t WS_END = 944 * MiB;

constexpr int LDS_BYTES = 147456;

namespace pg8 {
constexpr int BM = 256, BK = 64, HALF = 128, HTB = HALF * BK * 2, STAGE_BYTES = 8 * HTB, NXCD = 8, WGM = 8;
__host__ __device__ __forceinline__ int lds_byte(int r, int c) { const int st = (r >> 4) * 2 + (c >> 5), rr = r & 15, cc = c & 31, ob = rr * 64 + cc * 2; return st * 1024 + (ob ^ (((ob >> 9) & 1) << 5)); }
__host__ __device__ __forceinline__ void stage_rc(int b, int& R, int& C) { const int st = b / 1024, sb = b % 1024, swz = sb ^ (((sb >> 9) & 1) << 5); R = (st >> 1) * 16 + swz / 64; C = (st & 1) * 32 + (swz % 64) / 2; }
__host__ __device__ __forceinline__ int perm32(int rho) { const int n = rho >> 4, i = rho & 15; return 8 * (i >> 2) + 4 * n + (i & 3); }

struct Unit { int pm, pn; };
struct Gemm { const bf16_t* A; const bf16_t* Bt; int M, N, K; };

struct StaticOrder {
    int nM, nN, nwg, G, c;
    __device__ void init(int M_, int N_, int G_, int c_) { nM = M_ / BM; nN = N_ / BM; nwg = nM * nN; G = G_; c = c_; }
    __device__ bool next(int i, Unit& u) const {
        const long L = (long)i * G + c; if (L >= nwg) return false;
        int wgid = (int)L; { const int q = nwg / NXCD, r = nwg % NXCD, xcd = wgid % NXCD, off = wgid / NXCD; wgid = (xcd < r ? xcd * (q + 1) : r * (q + 1) + (xcd - r) * q) + off; }
        const int nig = WGM * nN, gid = wgid / nig, fm = gid * WGM, gsz = (nM - fm) < WGM ? (nM - fm) : WGM;
        u.pm = fm + ((wgid % nig) % gsz); u.pn = (wgid % nig) / gsz; return true;
    }
};

__device__ __forceinline__ unsigned cvt_pk_bf16(float lo, float hi) { unsigned r; asm volatile("v_cvt_pk_bf16_f32 %0, %1, %2" : "=v"(r) : "v"(lo), "v"(hi)); return r; }

struct EpiProj {
    static constexpr bool PERM = true, VSWAP = true;
    bf16_t* Q; bf16_t* Kb; bf16_t* Vt; bf16_t* U;
    __device__ __forceinline__ void operator()(const f32x4 (&acc)[2][2][4][2], const Unit& u, int wr, int wc, int fr, int fq) const {
        const int t = u.pn >> 1;
        if (t == 2) {
            const int dg0 = (u.pn & 1) * 256 + wr * 64 + fr; const int b = u.pm >> 4; const int s0 = (u.pm & 15) * 256 + wc * 32 + 8 * fq;
#pragma unroll
            for (int ai = 0; ai < 2; ++ai)
#pragma unroll
                for (int m = 0; m < 4; ++m) { const int dg = dg0 + ai * HALF + m * 16;
                    bf16_t* rowp = Vt + ((size_t)(b * 8 + (dg >> 6)) * (SEQ / 8) + (s0 >> 3)) * 512 + (dg & 63) * 8;
#pragma unroll
                    for (int bj = 0; bj < 2; ++bj) { const f32x4 v0 = acc[ai][bj][m][0], v1 = acc[ai][bj][m][1];
                        u32x4 w; w.x = cvt_pk_bf16(v0[0], v0[1]); w.y = cvt_pk_bf16(v0[2], v0[3]); w.z = cvt_pk_bf16(v1[0], v1[1]); w.w = cvt_pk_bf16(v1[2], v1[3]);
                        *(u32x4*)(rowp + (size_t)bj * (HALF / 8) * 512) = w; } }
        } else {
            bf16_t* base = Q + (size_t)t * ((size_t)M * AW); const float sc = t == 0 ? QSCALE : 1.0f;
            const int row0 = u.pm * BM + wr * 64 + fr, col0 = (u.pn & 1) * 256 + wc * 32 + 8 * fq;
            const bool cm = t < 2; const int bq = u.pm >> 4;
#pragma unroll
            for (int ai = 0; ai < 2; ++ai)
#pragma unroll
                for (int m = 0; m < 4; ++m) { const int row = row0 + ai * HALF + m * 16;
                    bf16_t* rowp = cm ? base + ((size_t)(bq * 64 + (col0 >> 3)) * SEQ + (row & (SEQ - 1))) * 8 : base + (size_t)row * AW + col0;
                    const size_t bjs = cm ? (size_t)(HALF / 8) * SEQ * 8 : (size_t)HALF;
#pragma unroll
                    for (int bj = 0; bj < 2; ++bj) { const f32x4 v0 = acc[ai][bj][m][0] * sc, v1 = acc[ai][bj][m][1] * sc;
                        u32x4 w; w.x = cvt_pk_bf16(v0[0], v0[1]); w.y = cvt_pk_bf16(v0[2], v0[3]); w.z = cvt_pk_bf16(v1[0], v1[1]); w.w = cvt_pk_bf16(v1[2], v1[3]);
                        *(u32x4*)(rowp + bj * bjs) = w; } }
        }
    }
};
struct EpiRelu2 {
    static constexpr bool PERM = true, VSWAP = false;
    bf16_t* O; int ldc;
    __device__ __forceinline__ void operator()(const f32x4 (&acc)[2][2][4][2], const Unit& u, int wr, int wc, int fr, int fq) const {
        const int row0 = u.pm * BM + wr * 64 + fr, col0 = u.pn * BM + wc * 32 + 8 * fq;
#pragma unroll
        for (int ai = 0; ai < 2; ++ai)
#pragma unroll
            for (int m = 0; m < 4; ++m) { bf16_t* rowp = O + (size_t)(row0 + ai * HALF + m * 16) * ldc + col0;
#pragma unroll
                for (int bj = 0; bj < 2; ++bj) { f32x4 v0 = acc[ai][bj][m][0], v1 = acc[ai][bj][m][1];
#pragma unroll
                    for (int j = 0; j < 4; ++j) { const float a = fmaxf(v0[j], 0.f), b = fmaxf(v1[j], 0.f); v0[j] = a * a; v1[j] = b * b; }
                    u32x4 w; w.x = cvt_pk_bf16(v0[0], v0[1]); w.y = cvt_pk_bf16(v0[2], v0[3]); w.z = cvt_pk_bf16(v1[0], v1[1]); w.w = cvt_pk_bf16(v1[2], v1[3]);
                    *(u32x4*)(rowp + bj * HALF) = w; } }
    }
};
struct EpiRes {
    static constexpr bool PERM = true, VSWAP = false;
    bf16_t* H; const float* mod; int sh_off, sc_off, g_off;
    __device__ __forceinline__ void operator()(const f32x4 (&acc)[2][2][4][2], const Unit& u, int wr, int wc, int fr, int fq) const {
        const int row0 = u.pm * BM + wr * 64 + fr, col0 = u.pn * BM + wc * 32 + 8 * fq; const int b = u.pm >> 4;
        const float* mb = mod + (size_t)b * NMOD + col0;
        f32x4 shv[2][2], aiv[2][2], g1v[2][2];
#pragma unroll
        for (int bj = 0; bj < 2; ++bj)
#pragma unroll
            for (int n = 0; n < 2; ++n) { shv[bj][n] = *(const f32x4*)(mb + sh_off + bj * HALF + 4 * n); const f32x4 s1 = *(const f32x4*)(mb + sc_off + bj * HALF + 4 * n) + 1.0f;
                aiv[bj][n] = (f32x4){DN_ALPHA / s1.x, DN_ALPHA / s1.y, DN_ALPHA / s1.z, DN_ALPHA / s1.w}; g1v[bj][n] = *(const f32x4*)(mb + g_off + bj * HALF + 4 * n) + 1.0f; }
#pragma unroll
        for (int ai = 0; ai < 2; ++ai)
#pragma unroll
            for (int m = 0; m < 4; ++m) { bf16_t* rowp = H + (size_t)(row0 + ai * HALF + m * 16) * D + col0;
#pragma unroll
                for (int bj = 0; bj < 2; ++bj) { const u32x4 hw = *(const u32x4*)(rowp + bj * HALF);
                    f32x4 h0, h1; h0.x = __builtin_bit_cast(float, hw.x << 16); h0.y = __builtin_bit_cast(float, hw.x & 0xffff0000u); h0.z = __builtin_bit_cast(float, hw.y << 16); h0.w = __builtin_bit_cast(float, hw.y & 0xffff0000u);
                    h1.x = __builtin_bit_cast(float, hw.z << 16); h1.y = __builtin_bit_cast(float, hw.z & 0xffff0000u); h1.z = __builtin_bit_cast(float, hw.w << 16); h1.w = __builtin_bit_cast(float, hw.w & 0xffff0000u);
                    const f32x4 z0 = (h0 - shv[bj][0]) * aiv[bj][0] + g1v[bj][0] * acc[ai][bj][m][0], z1 = (h1 - shv[bj][1]) * aiv[bj][1] + g1v[bj][1] * acc[ai][bj][m][1];
                    u32x4 w; w.x = cvt_pk_bf16(z0[0], z0[1]); w.y = cvt_pk_bf16(z0[2], z0[3]); w.z = cvt_pk_bf16(z1[0], z1[1]); w.w = cvt_pk_bf16(z1[2], z1[3]);
                    *(u32x4*)(rowp + bj * HALF) = w; }
                asm volatile("" ::: "memory"); }
    }
};

template <class Epi, bool ALIGN_EPI>
__device__ __forceinline__ void gemm_phase(LAS unsigned char* lds, const Gemm g, const StaticOrder& S, const Epi& E) {
    int tid = threadIdx.x; asm volatile("" : "+v"(tid));
    const int wid = __builtin_amdgcn_readfirstlane(tid >> 6), lane = tid & 63, wr = wid >> 2, wc = wid & 3, fr = lane & 15, fq = lane >> 4;
    const int K = g.K, nt = K / BK;
    unsigned voffA[2], voffB[2];
#pragma unroll
    for (int i = 0; i < 2; ++i) { int R, C; stage_rc(tid * 16 + i * 8192, R, C); const int Rb = Epi::PERM ? ((R & ~31) + perm32(R & 31)) : R;
        voffA[i] = (unsigned)(R * K + C) * 2u; voffB[i] = (unsigned)(Rb * K + C) * 2u; }
    const size_t kstep = (size_t)(BK * 2);
    const size_t hstep = (size_t)HALF * K * 2;
    const size_t tstep = 2 * hstep;
    const unsigned ldsw = (unsigned)wid * 1024u;
    const int aoff = lds_byte(wr * 64 + fr, fq * 8), boff = lds_byte(wc * 32 + fr, fq * 8);
#define PG8_SA(b, h) (((b) * 2 + (h)) * HTB)
#define PG8_SB(b, h) ((4 + (b) * 2 + (h)) * HTB)
#define PG8_STAGE(bufoff, gbase, voff) do { _Pragma("unroll") for (int _i = 0; _i < 2; ++_i) \
        __builtin_amdgcn_global_load_lds((const unsigned*)((const char*)(gbase) + (voff)[_i]), (LAS unsigned*)(lds + (bufoff) + ldsw + _i * 8192), 16, 0, 0); } while (0)
#define PG8_LDA(dst, b, h) do { _Pragma("unroll") for (int m = 0; m < 4; ++m) _Pragma("unroll") for (int k = 0; k < 2; ++k) dst[m][k] = *(const LAS bf16x8*)(lds + PG8_SA(b, h) + aoff + m * 2048 + k * 1024); } while (0)
#define PG8_LDB(dst, b, h) do { _Pragma("unroll") for (int n = 0; n < 2; ++n) _Pragma("unroll") for (int k = 0; k < 2; ++k) dst[n][k] = *(const LAS bf16x8*)(lds + PG8_SB(b, h) + boff + n * 2048 + k * 1024); } while (0)
#define PG8_MMA(ai, bj, At, Bt) do { __builtin_amdgcn_s_setprio(1); _Pragma("unroll") for (int m = 0; m < 4; ++m) _Pragma("unroll") for (int n = 0; n < 2; ++n) _Pragma("unroll") for (int k = 0; k < 2; ++k) \
        acc[ai][bj][m][n] = __builtin_amdgcn_mfma_f32_16x16x32_bf16(Bt[n][k], At[m][k], acc[ai][bj][m][n], 0, 0, 0); __builtin_amdgcn_s_setprio(0); } while (0)
#define PG8_WAIT_V(n) asm volatile("s_waitcnt vmcnt(" #n ")" ::: "memory")
#define PG8_WAIT_L(n) asm volatile("s_waitcnt lgkmcnt(" #n ")" ::: "memory")
#define PG8_BAR __builtin_amdgcn_s_barrier()
#define PG8_SCHED __builtin_amdgcn_sched_barrier(0)
#define PG8_PTRS(u, pa, pb) do { const bool _sw = Epi::VSWAP && (((u).pn >> 1) == 2); const char* _a = (const char*)g.A + (size_t)(u).pm * tstep; const char* _b = (const char*)g.Bt + (size_t)(u).pn * tstep; pa = _sw ? _b : _a; pb = _sw ? _a : _b; } while (0)
    Unit cur, nxt; int ui = 0;
    if (!S.next(0, cur)) return;
    f32x4 acc[2][2][4][2];
#pragma unroll
    for (int a = 0; a < 2; ++a)
#pragma unroll
        for (int b = 0; b < 2; ++b)
#pragma unroll
            for (int m = 0; m < 4; ++m)
#pragma unroll
                for (int n = 0; n < 2; ++n) acc[a][b][m][n] = (f32x4){0.f, 0.f, 0.f, 0.f};
    bf16x8 At[4][2], B0[2][2], B1[2][2];
    const char* cA; const char* cB; PG8_PTRS(cur, cA, cB);
    PG8_STAGE(PG8_SB(0, 0), cB, voffB); PG8_STAGE(PG8_SB(0, 1), cB + hstep, voffB); PG8_STAGE(PG8_SA(0, 0), cA, voffA); PG8_STAGE(PG8_SA(0, 1), cA + hstep, voffA);
    if (wr == 1) PG8_BAR;
    PG8_WAIT_V(2); PG8_BAR;
    PG8_STAGE(PG8_SB(1, 0), cB + kstep, voffB); PG8_STAGE(PG8_SA(1, 0), cA + kstep, voffA); PG8_STAGE(PG8_SB(1, 1), cB + hstep + kstep, voffB);
    PG8_WAIT_V(6); PG8_BAR;
    for (;;) {
        const bool has_next = S.next(ui + 1, nxt);
        const char* nA = cA; const char* nB = cB; if (has_next) { PG8_PTRS(nxt, nA, nB); }
        for (int t = 0; t < nt; t += 2) {
            const bool last = (t == nt - 2);
            const char* a1 = cA + (size_t)(t + 1) * kstep;
            const char* a2 = last ? nA : cA + (size_t)(t + 2) * kstep; const char* b2 = last ? nB : cB + (size_t)(t + 2) * kstep;
            const char* a3 = a2 + kstep; const char* b3 = b2 + kstep;
            PG8_LDB(B0, 0, 0); PG8_LDB(B1, 0, 1); PG8_SCHED; PG8_LDA(At, 0, 0); PG8_STAGE(PG8_SA(1, 1), a1 + hstep, voffA);
            PG8_WAIT_V(8); PG8_WAIT_L(0); PG8_BAR; PG8_MMA(0, 0, At, B0); PG8_MMA(0, 1, At, B1); PG8_BAR; PG8_SCHED;
            PG8_LDA(At, 0, 1); PG8_STAGE(PG8_SB(0, 0), b2, voffB); PG8_STAGE(PG8_SB(0, 1), b2 + hstep, voffB); PG8_STAGE(PG8_SA(0, 0), a2, voffA);
            PG8_WAIT_V(8); PG8_WAIT_L(0); PG8_BAR; PG8_MMA(1, 0, At, B0); PG8_MMA(1, 1, At, B1); PG8_BAR; PG8_SCHED;
            PG8_LDB(B0, 1, 0); PG8_LDB(B1, 1, 1); PG8_SCHED; PG8_LDA(At, 1, 0); PG8_STAGE(PG8_SA(0, 1), a2 + hstep, voffA);
            PG8_WAIT_V(8); PG8_WAIT_L(0); PG8_BAR; PG8_MMA(0, 0, At, B0); PG8_MMA(0, 1, At, B1); PG8_BAR; PG8_SCHED;
            PG8_LDA(At, 1, 1); PG8_STAGE(PG8_SB(1, 0), b3, voffB); PG8_STAGE(PG8_SB(1, 1), b3 + hstep, voffB); PG8_STAGE(PG8_SA(1, 0), a3, voffA);
            PG8_WAIT_V(8); PG8_WAIT_L(0); PG8_BAR; PG8_MMA(1, 0, At, B0); PG8_MMA(1, 1, At, B1); PG8_BAR; PG8_SCHED;
        }
        if constexpr (ALIGN_EPI) { if (wr == 0) PG8_BAR; }
        E(acc, cur, wr, wc, fr, fq);
        if (!has_next) break;
#pragma unroll
        for (int a = 0; a < 2; ++a)
#pragma unroll
            for (int b = 0; b < 2; ++b)
#pragma unroll
                for (int m = 0; m < 4; ++m)
#pragma unroll
                    for (int n = 0; n < 2; ++n) acc[a][b][m][n] = (f32x4){0.f, 0.f, 0.f, 0.f};
        cur = nxt; cA = nA; cB = nB; ++ui;
        if constexpr (ALIGN_EPI) { if (wr == 1) PG8_BAR; }
    }
    PG8_WAIT_V(0);
    if constexpr (!ALIGN_EPI) { if (wr == 0) PG8_BAR; }
    PG8_BAR;
#undef PG8_SA
#undef PG8_SB
#undef PG8_STAGE
#undef PG8_LDA
#undef PG8_LDB
#undef PG8_MMA
#undef PG8_WAIT_V
#undef PG8_WAIT_L
#undef PG8_BAR
#undef PG8_SCHED
#undef PG8_PTRS
}
}

#define XB_TMO      128
#define XB_XCNT(j)  (256  + 64 * (j))
#define XB_XSUB(j)  (1280 + 64 * (j))
#define XB_XGEN(j)  (2304 + 64 * (j))
#define XB_TOP      3328
#define XB_TOPGEN   3392
#define XCD_BAR_WORDS 3456
#define XB_SPIN_CAP (1u << 18)
__device__ __forceinline__ unsigned xb_ld(unsigned* p)              { return __hip_atomic_load(p, __ATOMIC_RELAXED, __HIP_MEMORY_SCOPE_AGENT); }
__device__ __forceinline__ unsigned xb_add(unsigned* p, unsigned v) { return __hip_atomic_fetch_add(p, v, __ATOMIC_RELAXED, __HIP_MEMORY_SCOPE_AGENT); }
__device__ __forceinline__ unsigned xb_xcc_id() { return (unsigned)__builtin_amdgcn_s_getreg((3 << 11) | 20) & 0xFu; }
#define XB_SPIN(cond, bar) do { unsigned _sp = 0; while (cond) { __builtin_amdgcn_s_sleep(1); \
    if ((++_sp & 255u) == 0u) { if (xb_ld(&(bar)[XB_TMO])) break; if (_sp > XB_SPIN_CAP) { atomicAdd(&(bar)[XB_TMO], 1u); break; } } } } while (0)
struct XcdBarrier { unsigned* bar; unsigned x; volatile LAS unsigned* st; };
__device__ __forceinline__ XcdBarrier xcd_barrier_post(unsigned* bar, volatile LAS unsigned* st) {
    XcdBarrier b; b.bar = bar; b.x = xb_xcc_id(); b.st = st;
    if (threadIdx.x == 0) (void)xb_add(&bar[XB_XCNT(b.x)], 1u);
    return b;
}
__device__ __forceinline__ void xcd_barrier_complete(unsigned* bar, unsigned x, unsigned& nloc, unsigned& nx) {
    const unsigned G = gridDim.x * gridDim.y * gridDim.z;
    unsigned sum, cnt, mine, sp = 0u;
    for (;;) {
        sum = 0u; cnt = 0u; mine = 0u;
#pragma unroll
        for (unsigned j = 0; j < 16; ++j) { const unsigned c = xb_ld(&bar[XB_XCNT(j)]); sum += c; cnt += (c > 0u) ? 1u : 0u; mine = (j == x) ? c : mine; }
        if (sum == G) break;
        __builtin_amdgcn_s_sleep(1);
        if ((++sp & 255u) == 0u) { if (xb_ld(&bar[XB_TMO])) break; if (sp > XB_SPIN_CAP) { atomicAdd(&bar[XB_TMO], 1u); break; } }
    }
    nloc = mine > 0u ? mine : 1u; nx = cnt > 0u ? cnt : 1u;
}
__device__ __forceinline__ void xcd_barrier(const XcdBarrier& b) {
    asm volatile("s_waitcnt vmcnt(0)" ::: "memory");
    __syncthreads();
    if (threadIdx.x == 0) {
        unsigned* bar = b.bar;
        __builtin_amdgcn_s_waitcnt(0);
        unsigned nloc = b.st[0], nx = b.st[1];
        if (nloc == 0u) { xcd_barrier_complete(bar, b.x, nloc, nx); b.st[0] = nloc; b.st[1] = nx; }
        const unsigned old = xb_add(&bar[XB_XSUB(b.x)], 1u);
        const unsigned gen = old / nloc;
        if (old + 1u == (gen + 1u) * nloc) {
            __builtin_amdgcn_fence(__ATOMIC_RELEASE, "agent");
            asm volatile("s_waitcnt vmcnt(0)" ::: "memory");
            const unsigned og = xb_add(&bar[XB_TOP], 1u);
            const unsigned tg = og / nx;
            if (og + 1u == (tg + 1u) * nx) xb_add(&bar[XB_TOPGEN], 1u);
            else XB_SPIN(xb_ld(&bar[XB_TOPGEN]) == tg, bar);
            __builtin_amdgcn_fence(__ATOMIC_ACQUIRE, "agent");
            xb_add(&bar[XB_XGEN(b.x)], 1u);
            asm volatile("s_waitcnt vmcnt(0)" ::: "memory");
        } else {
            XB_SPIN(xb_ld(&bar[XB_XGEN(b.x)]) == gen, bar);
            __builtin_amdgcn_fence(__ATOMIC_ACQUIRE, "agent");
            asm volatile("s_waitcnt vmcnt(0)" ::: "memory");
        }
    }
    __syncthreads();
}

__device__ __forceinline__ unsigned f2bf(float f) { unsigned u = __builtin_bit_cast(unsigned, f); return (u + 0x7fffu + ((u >> 16) & 1u)) >> 16; }
__device__ __forceinline__ unsigned pk2(float lo, float hi) { return f2bf(lo) | (f2bf(hi) << 16); }
__device__ __forceinline__ float bflo(unsigned w) { return __builtin_bit_cast(float, w << 16); }
__device__ __forceinline__ float bfhi(unsigned w) { return __builtin_bit_cast(float, w & 0xffff0000u); }
__device__ __forceinline__ float wave_sum(float v) {
#pragma unroll
    for (int o = 1; o < 64; o <<= 1) v += __shfl_xor(v, o);
    return v;
}

__device__ __forceinline__ void transpose_item(const float* W, int N, bf16_t* WT, int ldw, LAS float* scr, int kb, int nb, int lane) {
    const int k0 = 64 * kb, n0 = 32 * nb;
#pragma unroll 8
    for (int i = 0; i < 32; ++i) { const int kk = 2 * i + (lane >> 5); scr[kk * 33 + (lane & 31)] = W[(size_t)(k0 + kk) * N + n0 + (lane & 31)]; }
    asm volatile("s_waitcnt lgkmcnt(0)" ::: "memory");
    const int c = lane & 7;
#pragma unroll
    for (int j = 0; j < 4; ++j) { const int n = (lane >> 3) + 8 * j; const LAS float* s = scr + (8 * c) * 33 + n;
        u32x4 o; o.x = pk2(s[0 * 33], s[1 * 33]); o.y = pk2(s[2 * 33], s[3 * 33]); o.z = pk2(s[4 * 33], s[5 * 33]); o.w = pk2(s[6 * 33], s[7 * 33]);
        *(u32x4*)(WT + (size_t)(n0 + n) * ldw + k0 + 8 * c) = o; }
    asm volatile("s_waitcnt lgkmcnt(0)" ::: "memory");
}

struct Args {
    const float *x, *c, *ln_in_g, *ln_in_b, *w_ada, *b_ada, *w_in, *rpb, *w_pool, *pool_scale, *w_out, *ln1_g, *ln1_b, *w_mlp1, *w_mlp2, *ln2_g, *ln2_b;
    float* out; unsigned char* ws; int ph_lo, ph_hi;
};

__device__ __forceinline__ void p0_prologue(const Args& a, LAS unsigned char* lds, int G, int bid, int tid) {
    asm volatile("" : "+v"(tid));
    const int lane = tid & 63, wave = tid >> 6;
    unsigned char* ws = a.ws;
    float* mod = (float*)(ws + WS_MOD);
    for (int item = bid; item < 2 * (NMOD / 64); item += G) {
        const int l = item / (NMOD / 64), n0 = (item % (NMOD / 64)) * 64;
        LAS float* cact = (LAS float*)lds;
        LAS float* red = (LAS float*)(lds + 65536);
        for (int i = tid; i < BATCH * D; i += 512) { const int b = i >> 10, k = i & 1023; const float v = a.c[i]; cact[k * 16 + b] = v / (1.0f + expf(-v)); }
        __syncthreads();
        const int ks = tid >> 6, col = tid & 63;
        float acc[16];
#pragma unroll
        for (int b = 0; b < 16; ++b) acc[b] = 0.f;
        const float* wp = a.w_ada + (size_t)l * D * NMOD + (size_t)(ks * 128) * NMOD + n0 + col;
#pragma unroll 4
        for (int kk = 0; kk < 128; ++kk) {
            const float w = wp[(size_t)kk * NMOD];
            const LAS f32x4* cp = (const LAS f32x4*)(cact + (ks * 128 + kk) * 16);
#pragma unroll
            for (int q = 0; q < 4; ++q) { const f32x4 cv = cp[q]; acc[4 * q + 0] += cv.x * w; acc[4 * q + 1] += cv.y * w; acc[4 * q + 2] += cv.z * w; acc[4 * q + 3] += cv.w * w; }
        }
#pragma unroll
        for (int b = 0; b < 16; ++b) red[(ks * 16 + b) * 64 + col] = acc[b];
        __syncthreads();
        for (int o = tid; o < 1024; o += 512) { const int b = o >> 6, cc = o & 63; float s = 0.f;
#pragma unroll
            for (int k8 = 0; k8 < 8; ++k8) s += red[(k8 * 16 + b) * 64 + cc];
            mod[(size_t)(l * 16 + b) * NMOD + n0 + cc] = s + a.b_ada[l * NMOD + n0 + cc]; }
        __syncthreads();
    }
    for (int idx = bid * 512 + tid; idx < 2 * 4 * 16 * 1024; idx += G * 512) {
        const int l = idx >> 16, g = (idx >> 14) & 3, cch = (idx >> 10) & 15, n = idx & 1023;
        const float* wo = a.w_out + (size_t)l * D * D + (size_t)(512 + g * 128) * D + n;
        const float* wpl = a.w_pool + ((size_t)(l * 4 + g) * 128 + cch * 8) * 128;
        const float* ps = a.pool_scale + l * 512 + g * 128;
        float acc[8];
#pragma unroll
        for (int i = 0; i < 8; ++i) acc[i] = 0.f;
#pragma unroll 4
        for (int d = 0; d < 128; ++d) { const float v = wo[(size_t)d * D] * ps[d];
#pragma unroll
            for (int i = 0; i < 8; ++i) acc[i] += wpl[i * 128 + d] * v; }
        u32x4 o; o.x = pk2(acc[0], acc[1]); o.y = pk2(acc[2], acc[3]); o.z = pk2(acc[4], acc[5]); o.w = pk2(acc[6], acc[7]);
        *(u32x4*)((bf16_t*)(ws + WS_WOUT) + (size_t)l * D * D + (size_t)n * D + 512 + g * 128 + cch * 8) = o;
    }
    {
        LAS float* scr = (LAS float*)(lds + wave * 16384);
        const int gw = bid * 8 + wave, NGW = G * 8;
        constexpr int I_IN = 16 * 64, I_OUT = 8 * 32, I_1 = 16 * 128, I_2 = 64 * 32, I_L = I_IN + I_OUT + I_1 + I_2;
        for (int it = gw; it < 2 * I_L; it += NGW) {
            const int l = it / I_L; int r = it % I_L;
            if (r < I_IN) { transpose_item(a.w_in + (size_t)l * D * PROJ, PROJ, (bf16_t*)(ws + WS_WIN) + (size_t)l * PROJ * D, D, scr, r / 64, r % 64, lane); continue; } r -= I_IN;
            if (r < I_OUT) { transpose_item(a.w_out + (size_t)l * D * D, D, (bf16_t*)(ws + WS_WOUT) + (size_t)l * D * D, D, scr, r / 32, r % 32, lane); continue; } r -= I_OUT;
            if (r < I_1) { transpose_item(a.w_mlp1 + (size_t)l * D * FF, FF, (bf16_t*)(ws + WS_W1) + (size_t)l * FF * D, D, scr, r / 128, r % 128, lane); continue; } r -= I_1;
            transpose_item(a.w_mlp2 + (size_t)l * FF * D, D, (bf16_t*)(ws + WS_W2) + (size_t)l * D * FF, FF, scr, r / 32, r % 32, lane);
        }
    }
}

template <bool SRC_BF16, bool OUT_F32>
__device__ __forceinline__ void ln_phase(const void* srcv, float* dstF, bf16_t* dstH, const float* g, const float* bt, const float* sc, const float* sh, int G, int bid, int tid) {
    asm volatile("" : "+v"(tid));
    const int lane = tid & 63, wave = tid >> 6;
    const int gw = bid * 8 + wave, NGW = G * 8;
    const int rpw = (M + NGW - 1) / NGW;
    const int r0 = gw * rpw, r1 = (r0 + rpw < M) ? r0 + rpw : M;
    if (r0 >= M) return;
    const int c0 = 8 * lane;
    f32x4 gv[4], bv[4], scv[4], shv[4];
#pragma unroll
    for (int j = 0; j < 4; ++j) { const int cj = c0 + (j >> 1) * 512 + (j & 1) * 4; gv[j] = *(const f32x4*)(g + cj); bv[j] = *(const f32x4*)(bt + cj); scv[j] = (f32x4){1.f, 1.f, 1.f, 1.f}; shv[j] = (f32x4){0.f, 0.f, 0.f, 0.f}; }
    int curb = -1;
    f32x4 v[4]; f32x4 nf[4]; u32x4 nb[2];
    if (SRC_BF16) { const bf16_t* p = (const bf16_t*)srcv + (size_t)r0 * D + c0; nb[0] = *(const u32x4*)p; nb[1] = *(const u32x4*)(p + 512); }
    else { const float* p = (const float*)srcv + (size_t)r0 * D + c0; nf[0] = *(const f32x4*)p; nf[1] = *(const f32x4*)(p + 4); nf[2] = *(const f32x4*)(p + 512); nf[3] = *(const f32x4*)(p + 516); }
    for (int r = r0; r < r1; ++r) {
        if (SRC_BF16) {
#pragma unroll
            for (int q = 0; q < 2; ++q) { v[2 * q].x = bflo(nb[q].x); v[2 * q].y = bfhi(nb[q].x); v[2 * q].z = bflo(nb[q].y); v[2 * q].w = bfhi(nb[q].y); v[2 * q + 1].x = bflo(nb[q].z); v[2 * q + 1].y = bfhi(nb[q].z); v[2 * q + 1].z = bflo(nb[q].w); v[2 * q + 1].w = bfhi(nb[q].w); }
        } else {
#pragma unroll
            for (int j = 0; j < 4; ++j) v[j] = nf[j];
        }
        if (r + 1 < r1) {
            if (SRC_BF16) { const bf16_t* p = (const bf16_t*)srcv + (size_t)(r + 1) * D + c0; nb[0] = *(const u32x4*)p; nb[1] = *(const u32x4*)(p + 512); }
            else { const float* p = (const float*)srcv + (size_t)(r + 1) * D + c0; nf[0] = *(const f32x4*)p; nf[1] = *(const f32x4*)(p + 4); nf[2] = *(const f32x4*)(p + 512); nf[3] = *(const f32x4*)(p + 516); }
        }
        const int b = r >> 12;
        if (!OUT_F32 && b != curb) { curb = b;
#pragma unroll
            for (int j = 0; j < 4; ++j) { const int cj = c0 + (j >> 1) * 512 + (j & 1) * 4; scv[j] = *(const f32x4*)(sc + (size_t)b * NMOD + cj) + 1.0f; shv[j] = *(const f32x4*)(sh + (size_t)b * NMOD + cj); } }
        float s = 0.f;
#pragma unroll
        for (int j = 0; j < 4; ++j) s += (v[j].x + v[j].y) + (v[j].z + v[j].w);
        const float mean = wave_sum(s) * (1.f / D); float s2 = 0.f;
#pragma unroll
        for (int j = 0; j < 4; ++j) { v[j] = v[j] - mean; s2 += (v[j].x * v[j].x + v[j].y * v[j].y) + (v[j].z * v[j].z + v[j].w * v[j].w); }
        const float rstd = 1.f / sqrtf(wave_sum(s2) * (1.f / D) + LN_EPS);
#pragma unroll
        for (int j = 0; j < 4; ++j) v[j] = v[j] * rstd * gv[j] + bv[j];
        if (OUT_F32) { float* p = dstF + (size_t)r * D + c0; *(f32x4*)p = v[0]; *(f32x4*)(p + 4) = v[1]; *(f32x4*)(p + 512) = v[2]; *(f32x4*)(p + 516) = v[3]; }
        else {
#pragma unroll
            for (int j = 0; j < 4; ++j) v[j] = v[j] * scv[j] + shv[j];
            bf16_t* p = dstH + (size_t)r * D + c0;
            u32x4 w0, w1; w0.x = pk2(v[0].x, v[0].y); w0.y = pk2(v[0].z, v[0].w); w0.z = pk2(v[1].x, v[1].y); w0.w = pk2(v[1].z, v[1].w);
            w1.x = pk2(v[2].x, v[2].y); w1.y = pk2(v[2].z, v[2].w); w1.z = pk2(v[3].x, v[3].y); w1.w = pk2(v[3].z, v[3].w);
            *(u32x4*)p = w0; *(u32x4*)(p + 512) = w1;
        }
    }
}

__device__ __forceinline__ void add8(float (&s)[8], const u32x4 w) { s[0] += bflo(w.x); s[1] += bfhi(w.x); s[2] += bflo(w.y); s[3] += bfhi(w.y); s[4] += bflo(w.z); s[5] += bfhi(w.z); s[6] += bflo(w.w); s[7] += bfhi(w.w); }
__device__ __forceinline__ void sub8(float (&s)[8], const u32x4 w) { s[0] -= bflo(w.x); s[1] -= bfhi(w.x); s[2] -= bflo(w.y); s[3] -= bfhi(w.y); s[4] -= bflo(w.z); s[5] -= bfhi(w.z); s[6] -= bflo(w.w); s[7] -= bfhi(w.w); }
template <int W>
__device__ __forceinline__ void pool_lane(const bf16_t* Ubc  , bf16_t* catc  , int T0) {
    constexpr int HW = W / 2, NL = 8 + W - 1;
    u32x4 raw[NL];
#pragma unroll
    for (int k = 0; k < NL; ++k) { const int tk = T0 - HW + k; const int tc = tk < 0 ? 0 : (tk > SEQ - 1 ? SEQ - 1 : tk); u32x4 v = *(const u32x4*)(Ubc + (size_t)tc * AW);
        if (tk != tc) v = (u32x4){0u, 0u, 0u, 0u}; raw[k] = v; }
    float sm[8];
#pragma unroll
    for (int e = 0; e < 8; ++e) sm[e] = 0.f;
#pragma unroll
    for (int k = 0; k < W; ++k) add8(sm, raw[k]);
#pragma unroll
    for (int o = 0; o < 8; ++o) {
        int lo = T0 + o - HW, hi = lo + W; lo = lo < 0 ? 0 : lo; hi = hi > SEQ ? SEQ : hi; const float ic = 1.0f / (float)(hi - lo);
        const u32x4 c = raw[o + HW];
        u32x4 w; w.x = pk2(sm[0] * ic - bflo(c.x), sm[1] * ic - bfhi(c.x)); w.y = pk2(sm[2] * ic - bflo(c.y), sm[3] * ic - bfhi(c.y));
        w.z = pk2(sm[4] * ic - bflo(c.z), sm[5] * ic - bfhi(c.z)); w.w = pk2(sm[6] * ic - bflo(c.w), sm[7] * ic - bfhi(c.w));
        *(u32x4*)(catc + (size_t)(T0 + o) * D) = w;
        if (o < 7) { add8(sm, raw[o + W]); sub8(sm, raw[o]); }
    }
}
__device__ __forceinline__ void attn_pool_phase(LAS unsigned char* lds, const bf16_t* Qb, const bf16_t* Kb, const bf16_t* Vt, const bf16_t* Ub, bf16_t* cat, const float* rpb_l, int G, int bid, int tid, int mode = 0) {
    asm volatile("" : "+v"(tid));
    LAS float* tab = (LAS float*)lds;
    for (int i = tid; i < NHEAD * RPB_H * 64; i += 512) { const int c = (i & 63) - 16, hr = i >> 6; tab[i] = (c >= 0 && c < RPB_W) ? rpb_l[hr * RPB_W + c] * LOG2E : 0.f; }
    __syncthreads();
    const int lane = tid & 63, h = __builtin_amdgcn_readfirstlane(tid >> 6), q16 = lane & 15, g4 = lane >> 4;
    const LAS float* tabh = tab + h * (RPB_H * 64) + 16;
    const bool xl = (G == 256); const int nun = xl ? 4 : (BATCH * 64 + G - 1) / G;
    for (int k = 0; k < nun; ++k) {
        const int unit = xl ? ((bid & 7) * 128 + k * 32 + (bid >> 3)) : (bid + k * G);
        if (unit >= BATCH * 64) break;
        const int b = unit >> 6, r = unit & 63; const int rs = r < 4 ? 0 : (r > 60 ? 56 : r - 4);
        const size_t tok0 = (size_t)b * SEQ + r * 64;
#pragma unroll 1
        for (int j = 0; j < ((mode & 2) ? 0 : 4); ++j) {
            const int cb = (j == 0) ? 0 : (j == 1) ? 8 : (j == 2) ? 24 : 32;
            const int qc = 16 * j + q16; const int cs = qc < 8 ? 0 : (qc > 56 ? 48 : qc - 8);
            const int tb0 = cb + g4 * 8 - qc + 15;
            const int vlo = cs - (cb + g4 * 8);
            const size_t cbase = ((size_t)(b * 8 + h) * 8 + g4) * SEQ;
            const bf16_t* qp = Qb + (cbase + r * 64 + qc) * 8;
            const bf16x8 q0 = *(const bf16x8*)qp, q1 = *(const bf16x8*)(qp + (size_t)4 * SEQ * 8);
            bf16x8 kf[8][2][2];
            const bf16_t* kbase = Kb + (cbase + rs * 64 + cb + (q16 >> 2) * 8 + (q16 & 3)) * 8;
#pragma unroll
            for (int i = 0; i < 8; ++i)
#pragma unroll
                for (int hh = 0; hh < 2; ++hh) { const bf16_t* kp = kbase + (size_t)(i * 64 + hh * 4) * 8; kf[i][hh][0] = *(const bf16x8*)kp; kf[i][hh][1] = *(const bf16x8*)(kp + (size_t)4 * SEQ * 8); }
            __builtin_amdgcn_sched_barrier(0);
            f32x4 s[8][2];
            float mx = -1e30f;
#pragma unroll
            for (int i = 0; i < 8; ++i)
#pragma unroll
                for (int hh = 0; hh < 2; ++hh) {
                    f32x4 acc = (f32x4){0.f, 0.f, 0.f, 0.f};
                    acc = __builtin_amdgcn_mfma_f32_16x16x32_bf16(kf[i][hh][0], q0, acc, 0, 0, 0);
                    acc = __builtin_amdgcn_mfma_f32_16x16x32_bf16(kf[i][hh][1], q1, acc, 0, 0, 0);
                    const LAS float* trow = tabh + (rs + i - r + 7) * 64 + tb0 + hh * 4;
#pragma unroll
                    for (int jj = 0; jj < 4; ++jj) {
                        const float bv = trow[jj];
                        const bool valid = (unsigned)(hh * 4 + jj - vlo) < 16u;
                        const float sv = valid ? acc[jj] + bv : -1e30f;
                        acc[jj] = sv; mx = fmaxf(mx, sv);
                    }
                    s[i][hh] = acc;
                }
            bf16x8 vf[8][4];
            const bf16_t* vbase = Vt + (((size_t)(b * 8 + h) * (SEQ / 8) + (rs * 64 + cb) / 8 + g4) * 64 + q16) * 8;
#pragma unroll
            for (int i = 0; i < 8; ++i)
#pragma unroll
                for (int db = 0; db < 4; ++db) vf[i][db] = *(const bf16x8*)(vbase + (size_t)i * 8 * 512 + db * 128);
            __builtin_amdgcn_sched_barrier(0);
            mx = fmaxf(mx, __shfl_xor(mx, 16)); mx = fmaxf(mx, __shfl_xor(mx, 32));
            float sum = 0.f;
            u32x4 pw[8];
#pragma unroll
            for (int i = 0; i < 8; ++i) {
#pragma unroll
                for (int hh = 0; hh < 2; ++hh)
#pragma unroll
                    for (int jj = 0; jj < 4; ++jj) { const float p = __builtin_amdgcn_exp2f(s[i][hh][jj] - mx); s[i][hh][jj] = p; sum += p; }
                pw[i].x = pg8::cvt_pk_bf16(s[i][0][0], s[i][0][1]); pw[i].y = pg8::cvt_pk_bf16(s[i][0][2], s[i][0][3]); pw[i].z = pg8::cvt_pk_bf16(s[i][1][0], s[i][1][1]); pw[i].w = pg8::cvt_pk_bf16(s[i][1][2], s[i][1][3]);
            }
            sum += __shfl_xor(sum, 16); sum += __shfl_xor(sum, 32);
            f32x4 o[4];
#pragma unroll
            for (int db = 0; db < 4; ++db) o[db] = (f32x4){0.f, 0.f, 0.f, 0.f};
#pragma unroll
            for (int i = 0; i < 8; ++i) {
                const bf16x8 pf = __builtin_bit_cast(bf16x8, pw[i]);
#pragma unroll
                for (int db = 0; db < 4; ++db) o[db] = __builtin_amdgcn_mfma_f32_16x16x32_bf16(vf[i][db], pf, o[db], 0, 0, 0);
            }
            const float inv = 1.0f / sum;
            bf16_t* op = cat + (tok0 + qc) * D + h * 64 + g4 * 4;
#pragma unroll
            for (int db = 0; db < 4; ++db) { u32x2 w; w.x = pg8::cvt_pk_bf16(o[db][0] * inv, o[db][1] * inv); w.y = pg8::cvt_pk_bf16(o[db][2] * inv, o[db][3] * inv); *(u32x2*)(op + db * 16) = w; }
        }
        if (!(mode & 1)) {
            const int gidx = h & 3, hfl = h >> 2; const int T0 = r * 64 + hfl * 32 + g4 * 8; const int chan = gidx * 128 + q16 * 8;
            const bf16_t* Ubc = Ub + (size_t)b * SEQ * AW + chan; bf16_t* catc = cat + (size_t)b * SEQ * D + 512 + chan;
            if (gidx == 0) pool_lane<2>(Ubc, catc, T0); else if (gidx == 1) pool_lane<4>(Ubc, catc, T0); else if (gidx == 2) pool_lane<8>(Ubc, catc, T0); else pool_lane<16>(Ubc, catc, T0);
        }
    }
}

constexpr int N_PHASES = 2 + 7 * DEPTH;
__global__ void __launch_bounds__(512, 2) fwd_megakernel(Args a) {
    extern __shared__ __attribute__((aligned(16))) unsigned char lds_raw[];
    LAS unsigned char* lds = (LAS unsigned char*)lds_raw;
    cg::grid_group grid = cg::this_grid();
    const int tid = threadIdx.x, bid = blockIdx.x, G = gridDim.x;
    unsigned char* ws = a.ws;
    bf16_t* H = (bf16_t*)(ws + WS_H); bf16_t* F = (bf16_t*)(ws + WS_F);
    bf16_t* Qb = (bf16_t*)(ws + WS_Q); bf16_t* Kb = (bf16_t*)(ws + WS_K); bf16_t* Vt = (bf16_t*)(ws + WS_VT); bf16_t* Ub = (bf16_t*)(ws + WS_U); bf16_t* CAT = (bf16_t*)(ws + WS_CAT);
    const float* mod = (const float*)(ws + WS_MOD);
    const int lo = a.ph_lo, hi = a.ph_hi;
#define IN(k) (lo <= (k) && (k) < hi)
    unsigned* barw = (unsigned*)(ws + WS_CTL);
    volatile LAS unsigned* misc = (volatile LAS unsigned*)(lds + 131072 + 1024);
    if (bid == 0) { for (int i = tid; i < 4608; i += 512) barw[i] = 0u; }
    if (tid < 8) misc[tid] = 0u;
    __syncthreads();
    XcdBarrier xbar; xbar.bar = barw; xbar.x = 0; xbar.st = misc;
    int vb = bid;
#define SEAM(k) do { if (IN(k) && IN((k) + 1)) { if ((k) == 0) { grid.sync(); xbar = xcd_barrier_post(barw, misc); if (tid == 0) misc[2] = xb_add(&barw[3456 + 64 * xbar.x], 1u); } \
        else { xcd_barrier(xbar); if ((k) == 1) { \
            if (tid == 0) { bool ok = (G % 8 == 0) && xbar.x < 8u; for (int j = 0; j < 8; ++j) ok = ok && (xb_ld(&barw[3456 + 64 * j]) == (unsigned)(G / 8)); misc[3] = ok ? 1u : 0u; } \
            __syncthreads(); if (misc[3]) vb = (int)(misc[2] * 8u + xbar.x); } } } } while (0)

    if (IN(0)) { for (int rep = 0; rep <= PROBE_P0; ++rep) { p0_prologue(a, lds, G, bid, tid); if (rep < PROBE_P0) __syncthreads(); } }
    SEAM(0);
    if (IN(1)) { ln_phase<false, false>(a.x, nullptr, H, a.ln_in_g, a.ln_in_b, mod + 1 * D, mod + 0 * D, G, bid, tid); }
    SEAM(1);
#pragma unroll 1
    for (int l = 0; l < DEPTH; ++l) {
        const int p = 2 + 7 * l;
        const float* modl = mod + (size_t)l * BATCH * NMOD;
        if (IN(p + 0)) {
            pg8::Gemm g{H, (const bf16_t*)(ws + WS_WIN) + (size_t)l * PROJ * D, M, PROJ, D}; pg8::StaticOrder S; S.init(M, PROJ, G, vb);
            pg8::EpiProj E{Qb, Kb, Vt, Ub};
            pg8::gemm_phase<pg8::EpiProj, true>(lds, g, S, E);
        }
        SEAM(p + 0);
        if (IN(p + 1)) { for (int rep = 0; rep <= PROBE_ATT; ++rep) { attn_pool_phase(lds, Qb, Kb, Vt, Ub, CAT, a.rpb + (size_t)l * NHEAD * RPB_N, G, vb, tid, rep == 0 ? 0 : PROBE_MODE); if (rep < PROBE_ATT) xcd_barrier(xbar); } }
        SEAM(p + 1);
        if (IN(p + 2)) {
            pg8::Gemm g{CAT, (const bf16_t*)(ws + WS_WOUT) + (size_t)l * D * D, M, D, D}; pg8::StaticOrder S; S.init(M, D, G, vb);
            pg8::EpiRes E{H, modl, 0 * D, 1 * D, 2 * D};
            pg8::gemm_phase<pg8::EpiRes, true>(lds, g, S, E);
        }
        SEAM(p + 2);
        if (IN(p + 3)) { ln_phase<true, false>(H, nullptr, H, a.ln1_g + l * D, a.ln1_b + l * D, modl + 4 * D, modl + 3 * D, G, bid, tid); }
        SEAM(p + 3);
        if (IN(p + 4)) {
            pg8::Gemm g{H, (const bf16_t*)(ws + WS_W1) + (size_t)l * FF * D, M, FF, D}; pg8::StaticOrder S; S.init(M, FF, G, vb);
            pg8::EpiRelu2 E{F, FF};
            pg8::gemm_phase<pg8::EpiRelu2, true>(lds, g, S, E);
        }
        SEAM(p + 4);
        if (IN(p + 5)) {
            pg8::Gemm g{F, (const bf16_t*)(ws + WS_W2) + (size_t)l * D * FF, M, D, FF}; pg8::StaticOrder S; S.init(M, D, G, vb);
            pg8::EpiRes E{H, modl, 3 * D, 4 * D, 5 * D};
            pg8::gemm_phase<pg8::EpiRes, true>(lds, g, S, E);
        }
        SEAM(p + 5);
        if (IN(p + 6)) {
            const bool lastl = (l == DEPTH - 1);
            const float* modn = mod + (size_t)(lastl ? l : l + 1) * BATCH * NMOD;
            if (lastl) ln_phase<true, true>(H, a.out, nullptr, a.ln2_g + l * D, a.ln2_b + l * D, modn, modn, G, bid, tid);
            else ln_phase<true, false>(H, nullptr, H, a.ln2_g + l * D, a.ln2_b + l * D, modn + 1 * D, modn + 0 * D, G, bid, tid);
        }
        SEAM(p + 6);
    }
    for (int rep = 0; rep < PROBE_SYNC; ++rep) xcd_barrier(xbar);
#undef IN
#undef SEAM
}

extern "C" void kernel_launch(void* const* d_in, const int* in_sizes, int n_in, void* d_out, int out_size, void* d_ws, size_t ws_size, hipStream_t stream) {
    static int grid = 0;
    if (grid == 0) {
        if (n_in != 17 || in_sizes[0] != M * D || out_size != M * D || ws_size < WS_END) { fprintf(stderr, "kernel_launch: unexpected shapes / workspace (n_in %d, in0 %d, out %d, ws %zu)\n", n_in, n_in > 0 ? in_sizes[0] : -1, out_size, ws_size); grid = -1; return; }
        int dev = 0, cus = 0, per_cu = 0;
        hipGetDevice(&dev); hipDeviceGetAttribute(&cus, hipDeviceAttributeMultiprocessorCount, dev);
        if (hipFuncSetAttribute((const void*)fwd_megakernel, hipFuncAttributeMaxDynamicSharedMemorySize, LDS_BYTES) != hipSuccess) { fprintf(stderr, "kernel_launch: hipFuncSetAttribute failed\n"); grid = -1; return; }
        if (hipOccupancyMaxActiveBlocksPerMultiprocessor(&per_cu, (const void*)fwd_megakernel, 512, LDS_BYTES) != hipSuccess || per_cu < 1) { per_cu = 1; (void)hipGetLastError(); }
        grid = (cus > 0 ? cus : 256) * per_cu;
    }
    if (grid < 0) return;
    Args a{};
    a.x = (const float*)d_in[0]; a.c = (const float*)d_in[1]; a.ln_in_g = (const float*)d_in[2]; a.ln_in_b = (const float*)d_in[3]; a.w_ada = (const float*)d_in[4]; a.b_ada = (const float*)d_in[5];
    a.w_in = (const float*)d_in[6]; a.rpb = (const float*)d_in[7]; a.w_pool = (const float*)d_in[8]; a.pool_scale = (const float*)d_in[9]; a.w_out = (const float*)d_in[10];
    a.ln1_g = (const float*)d_in[11]; a.ln1_b = (const float*)d_in[12]; a.w_mlp1 = (const float*)d_in[13]; a.w_mlp2 = (const float*)d_in[14]; a.ln2_g = (const float*)d_in[15]; a.ln2_b = (const float*)d_in[16];
    a.out = (float*)d_out; a.ws = (unsigned char*)d_ws;
#if MK_MULTI
    for (int p = 0; p < N_PHASES; ++p) { a.ph_lo = p; a.ph_hi = p + 1; hipLaunchKernelGGL(fwd_megakernel, dim3(grid), dim3(512), LDS_BYTES, stream, a); }
#else
    a.ph_lo = 0; a.ph_hi = N_PHASES;
    void* args[] = {&a};
    hipError_t e = hipLaunchCooperativeKernel((const void*)fwd_megakernel, dim3(grid), dim3(512), args, LDS_BYTES, stream);
    if (e != hipSuccess) fprintf(stderr, "kernel_launch: cooperative launch failed: %s (grid %d)\n", hipGetErrorString(e), grid);
#endif
}
```

```cpp
#include <hip/hip_runtime.h>
#include <hip/hip_cooperative_groups.h>
#include <cstdio>
#include <cstdint>
namespace cg = cooperative_groups;

#define LAS __attribute__((address_space(3)))
typedef unsigned short bf16_t;
typedef short bf16x8 __attribute__((ext_vector_type(8)));
typedef float f32x4 __attribute__((ext_vector_type(4)));
typedef float f32x2 __attribute__((ext_vector_type(2)));
typedef unsigned u32x4 __attribute__((ext_vector_type(4)));
typedef unsigned u32x2 __attribute__((ext_vector_type(2)));

#ifndef PROBE_ATT
#define PROBE_ATT 0
#endif
#ifndef PROBE_P0
#define PROBE_P0 0
#endif
#ifndef PROBE_MODE
#define PROBE_MODE 0
#endif
#ifndef PROBE_MLP1
#define PROBE_MLP1 0
#endif
#ifndef PROBE_MLP1_NOSTORE
#define PROBE_MLP1_NOSTORE 0
#endif
#ifndef PROBE_SYNC
#define PROBE_SYNC 0
#endif
#ifndef MK_MULTI
#define MK_MULTI 0
#endif

constexpr int BATCH = 16, SEQ = 4096, D = 1024, DEPTH = 2, M = BATCH * SEQ;
constexpr int PROJ = 2048, FF = 4096, NMOD = 6 * D, AW = 512;
constexpr int NHEAD = 8;
constexpr float LN_EPS = 1e-5f;
constexpr float DN_ALPHA = 1.41421356237309515f;
constexpr float LOG2E = 1.44269504088896341f;
constexpr float QSCALE = 0.125f * LOG2E;
constexpr int RPB_H = 15, RPB_W = 31, RPB_N = RPB_H * RPB_W;

constexpr size_t MiB = (size_t)1 << 20;
constexpr size_t WS_WIN = 0 * MiB;
constexpr size_t WS_WOUT = 8 * MiB;
constexpr size_t WS_W1 = 12 * MiB;
constexpr size_t WS_W2 = 28 * MiB;
constexpr size_t WS_MOD = 44 * MiB;
constexpr size_t WS_CTL = 46 * MiB;
constexpr size_t WS_X = 48 * MiB;
constexpr size_t WS_H = 304 * MiB;
constexpr size_t WS_F = 432 * MiB;
constexpr size_t WS_Q = 432 * MiB;
constexpr size_t WS_K = 496 * MiB;
constexpr size_t WS_VT = 560 * MiB;
constexpr size_t WS_U = 624 * MiB;
constexpr size_t WS_CAT = 688 * MiB;
constexpr size_t WS_END = 944 * MiB;

constexpr int LDS_BYTES = 147456;

namespace pg8 {
constexpr int BM = 256, BK = 64, HALF = 128, HTB = HALF * BK * 2, STAGE_BYTES = 8 * HTB, NXCD = 8, WGM = 8;
__host__ __device__ __forceinline__ int lds_byte(int r, int c) { const int st = (r >> 4) * 2 + (c >> 5), rr = r & 15, cc = c & 31, ob = rr * 64 + cc * 2; return st * 1024 + (ob ^ (((ob >> 9) & 1) << 5)); }
__host__ __device__ __forceinline__ void stage_rc(int b, int& R, int& C) { const int st = b / 1024, sb = b % 1024, swz = sb ^ (((sb >> 9) & 1) << 5); R = (st >> 1) * 16 + swz / 64; C = (st & 1) * 32 + (swz % 64) / 2; }
__host__ __device__ __forceinline__ int perm32(int rho) { const int n = rho >> 4, i = rho & 15; return 8 * (i >> 2) + 4 * n + (i & 3); }

struct Unit { int pm, pn; };
struct Gemm { const bf16_t* A; const bf16_t* Bt; int M, N, K; };

struct StaticOrder {
    int nM, nN, nwg, G, c;
    __device__ void init(int M_, int N_, int G_, int c_) { nM = M_ / BM; nN = N_ / BM; nwg = nM * nN; G = G_; c = c_; }
    __device__ bool next(int i, Unit& u) const {
        const long L = (long)i * G + c; if (L >= nwg) return false;
        int wgid = (int)L; { const int q = nwg / NXCD, r = nwg % NXCD, xcd = wgid % NXCD, off = wgid / NXCD; wgid = (xcd < r ? xcd * (q + 1) : r * (q + 1) + (xcd - r) * q) + off; }
        const int nig = WGM * nN, gid = wgid / nig, fm = gid * WGM, gsz = (nM - fm) < WGM ? (nM - fm) : WGM;
        u.pm = fm + ((wgid % nig) % gsz); u.pn = (wgid % nig) / gsz; return true;
    }
};

__device__ __forceinline__ unsigned cvt_pk_bf16(float lo, float hi) { unsigned r; asm volatile("v_cvt_pk_bf16_f32 %0, %1, %2" : "=v"(r) : "v"(lo), "v"(hi)); return r; }

struct EpiProj {
    static constexpr bool PERM = true, VSWAP = true;
    bf16_t* Q; bf16_t* Kb; bf16_t* Vt; bf16_t* U;
    __device__ __forceinline__ void operator()(const f32x4 (&acc)[2][2][4][2], const Unit& u, int wr, int wc, int fr, int fq) const {
        const int t = u.pn >> 1;
        if (t == 2) {
            const int dg0 = (u.pn & 1) * 256 + wr * 64 + fr; const int b = u.pm >> 4; const int s0 = (u.pm & 15) * 256 + wc * 32 + 8 * fq;
#pragma unroll
            for (int ai = 0; ai < 2; ++ai)
#pragma unroll
                for (int m = 0; m < 4; ++m) { const int dg = dg0 + ai * HALF + m * 16;
                    bf16_t* rowp = Vt + ((size_t)(b * 8 + (dg >> 6)) * (SEQ / 8) + (s0 >> 3)) * 512 + (dg & 63) * 8;
#pragma unroll
                    for (int bj = 0; bj < 2; ++bj) { const f32x4 v0 = acc[ai][bj][m][0], v1 = acc[ai][bj][m][1];
                        u32x4 w; w.x = cvt_pk_bf16(v0[0], v0[1]); w.y = cvt_pk_bf16(v0[2], v0[3]); w.z = cvt_pk_bf16(v1[0], v1[1]); w.w = cvt_pk_bf16(v1[2], v1[3]);
                        *(u32x4*)(rowp + (size_t)bj * (HALF / 8) * 512) = w; } }
        } else {
            bf16_t* base = Q + (size_t)t * ((size_t)M * AW); const float sc = t == 0 ? QSCALE : 1.0f;
            const int row0 = u.pm * BM + wr * 64 + fr, col0 = (u.pn & 1) * 256 + wc * 32 + 8 * fq;
            const bool cm = t < 2; const int bq = u.pm >> 4;
#pragma unroll
            for (int ai = 0; ai < 2; ++ai)
#pragma unroll
                for (int m = 0; m < 4; ++m) { const int row = row0 + ai * HALF + m * 16;
                    bf16_t* rowp = cm ? base + ((size_t)(bq * 64 + (col0 >> 3)) * SEQ + (row & (SEQ - 1))) * 8 : base + (size_t)row * AW + col0;
                    const size_t bjs = cm ? (size_t)(HALF / 8) * SEQ * 8 : (size_t)HALF;
#pragma unroll
                    for (int bj = 0; bj < 2; ++bj) { const f32x4 v0 = acc[ai][bj][m][0] * sc, v1 = acc[ai][bj][m][1] * sc;
                        u32x4 w; w.x = cvt_pk_bf16(v0[0], v0[1]); w.y = cvt_pk_bf16(v0[2], v0[3]); w.z = cvt_pk_bf16(v1[0], v1[1]); w.w = cvt_pk_bf16(v1[2], v1[3]);
                        *(u32x4*)(rowp + bj * bjs) = w; } }
        }
    }
};
struct EpiRelu2 {
    static constexpr bool PERM = true, VSWAP = false;
    bf16_t* O; int ldc; int nostore;
    __device__ __forceinline__ void operator()(const f32x4 (&acc)[2][2][4][2], const Unit& u, int wr, int wc, int fr, int fq) const {
        if (nostore) return;
        const int row0 = u.pm * BM + wr * 64 + fr, col0 = u.pn * BM + wc * 32 + 8 * fq;
#pragma unroll
        for (int ai = 0; ai < 2; ++ai)
#pragma unroll
            for (int m = 0; m < 4; ++m) { bf16_t* rowp = O + (size_t)(row0 + ai * HALF + m * 16) * ldc + col0;
#pragma unroll
                for (int bj = 0; bj < 2; ++bj) { f32x4 v0 = acc[ai][bj][m][0], v1 = acc[ai][bj][m][1];
#pragma unroll
                    for (int j = 0; j < 4; ++j) { const float a = fmaxf(v0[j], 0.f), b = fmaxf(v1[j], 0.f); v0[j] = a * a; v1[j] = b * b; }
                    u32x4 w; w.x = cvt_pk_bf16(v0[0], v0[1]); w.y = cvt_pk_bf16(v0[2], v0[3]); w.z = cvt_pk_bf16(v1[0], v1[1]); w.w = cvt_pk_bf16(v1[2], v1[3]);
                    *(u32x4*)(rowp + bj * HALF) = w; } }
    }
};
struct EpiRes {
    static constexpr bool PERM = true, VSWAP = false;
    bf16_t* H; const float* mod; int sh_off, sc_off, g_off;
    __device__ __forceinline__ void operator()(const f32x4 (&acc)[2][2][4][2], const Unit& u, int wr, int wc, int fr, int fq) const {
        const int row0 = u.pm * BM + wr * 64 + fr, col0 = u.pn * BM + wc * 32 + 8 * fq; const int b = u.pm >> 4;
        const float* mb = mod + (size_t)b * NMOD + col0;
#pragma unroll
        for (int bj = 0; bj < 2; ++bj) {
            f32x4 shv[2], aiv[2], g1v[2];
#pragma unroll
            for (int n = 0; n < 2; ++n) { shv[n] = *(const f32x4*)(mb + sh_off + bj * HALF + 4 * n); const f32x4 s1 = *(const f32x4*)(mb + sc_off + bj * HALF + 4 * n) + 1.0f;
                aiv[n] = (f32x4){DN_ALPHA / s1.x, DN_ALPHA / s1.y, DN_ALPHA / s1.z, DN_ALPHA / s1.w}; g1v[n] = *(const f32x4*)(mb + g_off + bj * HALF + 4 * n) + 1.0f; }
#pragma unroll
            for (int ai = 0; ai < 2; ++ai) {
                u32x4 hw[4];
#pragma unroll
                for (int m = 0; m < 4; ++m) hw[m] = *(const u32x4*)(H + (size_t)(row0 + ai * HALF + m * 16) * D + col0 + bj * HALF);
#pragma unroll
                for (int m = 0; m < 4; ++m) { const u32x4 w0 = hw[m];
                    f32x4 h0, h1; h0.x = __builtin_bit_cast(float, w0.x << 16); h0.y = __builtin_bit_cast(float, w0.x & 0xffff0000u); h0.z = __builtin_bit_cast(float, w0.y << 16); h0.w = __builtin_bit_cast(float, w0.y & 0xffff0000u);
                    h1.x = __builtin_bit_cast(float, w0.z << 16); h1.y = __builtin_bit_cast(float, w0.z & 0xffff0000u); h1.z = __builtin_bit_cast(float, w0.w << 16); h1.w = __builtin_bit_cast(float, w0.w & 0xffff0000u);
                    const f32x4 z0 = (h0 - shv[0]) * aiv[0] + g1v[0] * acc[ai][bj][m][0], z1 = (h1 - shv[1]) * aiv[1] + g1v[1] * acc[ai][bj][m][1];
                    u32x4 w; w.x = cvt_pk_bf16(z0[0], z0[1]); w.y = cvt_pk_bf16(z0[2], z0[3]); w.z = cvt_pk_bf16(z1[0], z1[1]); w.w = cvt_pk_bf16(z1[2], z1[3]);
                    *(u32x4*)(H + (size_t)(row0 + ai * HALF + m * 16) * D + col0 + bj * HALF) = w; }
                asm volatile("" ::: "memory"); }
        }
    }
};

template <class Epi, bool ALIGN_EPI>
__device__ __forceinline__ void gemm_phase(LAS unsigned char* lds, const Gemm g, const StaticOrder& S, const Epi& E) {
    int tid = threadIdx.x; asm volatile("" : "+v"(tid));
    const int wid = __builtin_amdgcn_readfirstlane(tid >> 6), lane = tid & 63, wr = wid >> 2, wc = wid & 3, fr = lane & 15, fq = lane >> 4;
    const int K = g.K, nt = K / BK;
    unsigned voffA[2], voffB[2];
#pragma unroll
    for (int i = 0; i < 2; ++i) { int R, C; stage_rc(tid * 16 + i * 8192, R, C); const int Rb = Epi::PERM ? ((R & ~31) + perm32(R & 31)) : R;
        voffA[i] = (unsigned)(R * K + C) * 2u; voffB[i] = (unsigned)(Rb * K + C) * 2u; }
    const size_t kstep = (size_t)(BK * 2);
    const size_t hstep = (size_t)HALF * K * 2;
    const size_t tstep = 2 * hstep;
    const unsigned ldsw = (unsigned)wid * 1024u;
    const int aoff = lds_byte(wr * 64 + fr, fq * 8), boff = lds_byte(wc * 32 + fr, fq * 8);
#define PG8_SA(b, h) (((b) * 2 + (h)) * HTB)
#define PG8_SB(b, h) ((4 + (b) * 2 + (h)) * HTB)
#define PG8_STAGE(bufoff, gbase, voff) do { _Pragma("unroll") for (int _i = 0; _i < 2; ++_i) \
        __builtin_amdgcn_global_load_lds((const unsigned*)((const char*)(gbase) + (voff)[_i]), (LAS unsigned*)(lds + (bufoff) + ldsw + _i * 8192), 16, 0, 0); } while (0)
#define PG8_LDA(dst, b, h) do { _Pragma("unroll") for (int m = 0; m < 4; ++m) _Pragma("unroll") for (int k = 0; k < 2; ++k) dst[m][k] = *(const LAS bf16x8*)(lds + PG8_SA(b, h) + aoff + m * 2048 + k * 1024); } while (0)
#define PG8_LDB(dst, b, h) do { _Pragma("unroll") for (int n = 0; n < 2; ++n) _Pragma("unroll") for (int k = 0; k < 2; ++k) dst[n][k] = *(const LAS bf16x8*)(lds + PG8_SB(b, h) + boff + n * 2048 + k * 1024); } while (0)
#define PG8_MMA(ai, bj, At, Bt) do { __builtin_amdgcn_s_setprio(1); _Pragma("unroll") for (int m = 0; m < 4; ++m) _Pragma("unroll") for (int n = 0; n < 2; ++n) _Pragma("unroll") for (int k = 0; k < 2; ++k) \
        acc[ai][bj][m][n] = __builtin_amdgcn_mfma_f32_16x16x32_bf16(Bt[n][k], At[m][k], acc[ai][bj][m][n], 0, 0, 0); __builtin_amdgcn_s_setprio(0); } while (0)
#define PG8_WAIT_V(n) asm volatile("s_waitcnt vmcnt(" #n ")" ::: "memory")
#define PG8_WAIT_L(n) asm volatile("s_waitcnt lgkmcnt(" #n ")" ::: "memory")
#define PG8_BAR __builtin_amdgcn_s_barrier()
#define PG8_SCHED __builtin_amdgcn_sched_barrier(0)
#define PG8_PTRS(u, pa, pb) do { const bool _sw = Epi::VSWAP && (((u).pn >> 1) == 2); const char* _a = (const char*)g.A + (size_t)(u).pm * tstep; const char* _b = (const char*)g.Bt + (size_t)(u).pn * tstep; pa = _sw ? _b : _a; pb = _sw ? _a : _b; } while (0)
    Unit cur, nxt; int ui = 0;
    if (!S.next(0, cur)) return;
    f32x4 acc[2][2][4][2];
#pragma unroll
    for (int a = 0; a < 2; ++a)
#pragma unroll
        for (int b = 0; b < 2; ++b)
#pragma unroll
            for (int m = 0; m < 4; ++m)
#pragma unroll
                for (int n = 0; n < 2; ++n) acc[a][b][m][n] = (f32x4){0.f, 0.f, 0.f, 0.f};
    bf16x8 At[4][2], B0[2][2], B1[2][2];
    const char* cA; const char* cB; PG8_PTRS(cur, cA, cB);
    PG8_STAGE(PG8_SB(0, 0), cB, voffB); PG8_STAGE(PG8_SB(0, 1), cB + hstep, voffB); PG8_STAGE(PG8_SA(0, 0), cA, voffA); PG8_STAGE(PG8_SA(0, 1), cA + hstep, voffA);
    if (wr == 1) PG8_BAR;
    PG8_WAIT_V(2); PG8_BAR;
    PG8_STAGE(PG8_SB(1, 0), cB + kstep, voffB); PG8_STAGE(PG8_SA(1, 0), cA + kstep, voffA); PG8_STAGE(PG8_SB(1, 1), cB + hstep + kstep, voffB);
    PG8_WAIT_V(6); PG8_BAR;
    for (;;) {
        const bool has_next = S.next(ui + 1, nxt);
        const char* nA = cA; const char* nB = cB; if (has_next) { PG8_PTRS(nxt, nA, nB); }
        for (int t = 0; t < nt; t += 2) {
            const bool last = (t == nt - 2);
            const char* a1 = cA + (size_t)(t + 1) * kstep;
            const char* a2 = last ? nA : cA + (size_t)(t + 2) * kstep; const char* b2 = last ? nB : cB + (size_t)(t + 2) * kstep;
            const char* a3 = a2 + kstep; const char* b3 = b2 + kstep;
            PG8_LDB(B0, 0, 0); PG8_LDB(B1, 0, 1); PG8_SCHED; PG8_LDA(At, 0, 0); PG8_STAGE(PG8_SA(1, 1), a1 + hstep, voffA);
            PG8_WAIT_V(8); PG8_WAIT_L(0); PG8_BAR; PG8_MMA(0, 0, At, B0); PG8_MMA(0, 1, At, B1); PG8_BAR; PG8_SCHED;
            PG8_LDA(At, 0, 1); PG8_STAGE(PG8_SB(0, 0), b2, voffB); PG8_STAGE(PG8_SB(0, 1), b2 + hstep, voffB); PG8_STAGE(PG8_SA(0, 0), a2, voffA);
            PG8_WAIT_V(8); PG8_WAIT_L(0); PG8_BAR; PG8_MMA(1, 0, At, B0); PG8_MMA(1, 1, At, B1); PG8_BAR; PG8_SCHED;
            PG8_LDB(B0, 1, 0); PG8_LDB(B1, 1, 1); PG8_SCHED; PG8_LDA(At, 1, 0); PG8_STAGE(PG8_SA(0, 1), a2 + hstep, voffA);
            PG8_WAIT_V(8); PG8_WAIT_L(0); PG8_BAR; PG8_MMA(0, 0, At, B0); PG8_MMA(0, 1, At, B1); PG8_BAR; PG8_SCHED;
            PG8_LDA(At, 1, 1); PG8_STAGE(PG8_SB(1, 0), b3, voffB); PG8_STAGE(PG8_SB(1, 1), b3 + hstep, voffB); PG8_STAGE(PG8_SA(1, 0), a3, voffA);
            PG8_WAIT_V(8); PG8_WAIT_L(0); PG8_BAR; PG8_MMA(1, 0, At, B0); PG8_MMA(1, 1, At, B1); PG8_BAR; PG8_SCHED;
        }
        if constexpr (ALIGN_EPI) { if (wr == 0) PG8_BAR; }
        E(acc, cur, wr, wc, fr, fq);
        if (!has_next) break;
#pragma unroll
        for (int a = 0; a < 2; ++a)
#pragma unroll
            for (int b = 0; b < 2; ++b)
#pragma unroll
                for (int m = 0; m < 4; ++m)
#pragma unroll
                    for (int n = 0; n < 2; ++n) acc[a][b][m][n] = (f32x4){0.f, 0.f, 0.f, 0.f};
        cur = nxt; cA = nA; cB = nB; ++ui;
        if constexpr (ALIGN_EPI) { if (wr == 1) PG8_BAR; }
    }
    PG8_WAIT_V(0);
    if constexpr (!ALIGN_EPI) { if (wr == 0) PG8_BAR; }
    PG8_BAR;
#undef PG8_SA
#undef PG8_SB
#undef PG8_STAGE
#undef PG8_LDA
#undef PG8_LDB
#undef PG8_MMA
#undef PG8_WAIT_V
#undef PG8_WAIT_L
#undef PG8_BAR
#undef PG8_SCHED
#undef PG8_PTRS
}
}

#define XB_TMO      128
#define XB_XCNT(j)  (256  + 64 * (j))
#define XB_XSUB(j)  (1280 + 64 * (j))
#define XB_XGEN(j)  (2304 + 64 * (j))
#define XB_TOP      3328
#define XB_TOPGEN   3392
#define XCD_BAR_WORDS 3456
#define XB_SPIN_CAP (1u << 18)
__device__ __forceinline__ unsigned xb_ld(unsigned* p)              { return __hip_atomic_load(p, __ATOMIC_RELAXED, __HIP_MEMORY_SCOPE_AGENT); }
__device__ __forceinline__ unsigned xb_add(unsigned* p, unsigned v) { return __hip_atomic_fetch_add(p, v, __ATOMIC_RELAXED, __HIP_MEMORY_SCOPE_AGENT); }
__device__ __forceinline__ unsigned xb_xcc_id() { return (unsigned)__builtin_amdgcn_s_getreg((3 << 11) | 20) & 0xFu; }
#define XB_SPIN(cond, bar) do { unsigned _sp = 0; while (cond) { __builtin_amdgcn_s_sleep(1); \
    if ((++_sp & 255u) == 0u) { if (xb_ld(&(bar)[XB_TMO])) break; if (_sp > XB_SPIN_CAP) { atomicAdd(&(bar)[XB_TMO], 1u); break; } } } } while (0)
struct XcdBarrier { unsigned* bar; unsigned x; volatile LAS unsigned* st; };
__device__ __forceinline__ XcdBarrier xcd_barrier_post(unsigned* bar, volatile LAS unsigned* st) {
    XcdBarrier b; b.bar = bar; b.x = xb_xcc_id(); b.st = st;
    if (threadIdx.x == 0) (void)xb_add(&bar[XB_XCNT(b.x)], 1u);
    return b;
}
__device__ __forceinline__ void xcd_barrier_complete(unsigned* bar, unsigned x, unsigned& nloc, unsigned& nx) {
    const unsigned G = gridDim.x * gridDim.y * gridDim.z;
    unsigned sum, cnt, mine, sp = 0u;
    for (;;) {
        sum = 0u; cnt = 0u; mine = 0u;
#pragma unroll
        for (unsigned j = 0; j < 16; ++j) { const unsigned c = xb_ld(&bar[XB_XCNT(j)]); sum += c; cnt += (c > 0u) ? 1u : 0u; mine = (j == x) ? c : mine; }
        if (sum == G) break;
        __builtin_amdgcn_s_sleep(1);
        if ((++sp & 255u) == 0u) { if (xb_ld(&bar[XB_TMO])) break; if (sp > XB_SPIN_CAP) { atomicAdd(&bar[XB_TMO], 1u); break; } }
    }
    nloc = mine > 0u ? mine : 1u; nx = cnt > 0u ? cnt : 1u;
}
__device__ __forceinline__ void xcd_barrier(const XcdBarrier& b) {
    asm volatile("s_waitcnt vmcnt(0)" ::: "memory");
    __syncthreads();
    if (threadIdx.x == 0) {
        unsigned* bar = b.bar;
        __builtin_amdgcn_s_waitcnt(0);
        unsigned nloc = b.st[0], nx = b.st[1];
        if (nloc == 0u) { xcd_barrier_complete(bar, b.x, nloc, nx); b.st[0] = nloc; b.st[1] = nx; }
        const unsigned old = xb_add(&bar[XB_XSUB(b.x)], 1u);
        const unsigned gen = old / nloc;
        if (old + 1u == (gen + 1u) * nloc) {
            __builtin_amdgcn_fence(__ATOMIC_RELEASE, "agent");
            asm volatile("s_waitcnt vmcnt(0)" ::: "memory");
            const unsigned og = xb_add(&bar[XB_TOP], 1u);
            const unsigned tg = og / nx;
            if (og + 1u == (tg + 1u) * nx) xb_add(&bar[XB_TOPGEN], 1u);
            else XB_SPIN(xb_ld(&bar[XB_TOPGEN]) == tg, bar);
            __builtin_amdgcn_fence(__ATOMIC_ACQUIRE, "agent");
            xb_add(&bar[XB_XGEN(b.x)], 1u);
            asm volatile("s_waitcnt vmcnt(0)" ::: "memory");
        } else {
            XB_SPIN(xb_ld(&bar[XB_XGEN(b.x)]) == gen, bar);
            __builtin_amdgcn_fence(__ATOMIC_ACQUIRE, "agent");
            asm volatile("s_waitcnt vmcnt(0)" ::: "memory");
        }
    }
    __syncthreads();
}

__device__ __forceinline__ unsigned f2bf(float f) { unsigned u = __builtin_bit_cast(unsigned, f); return (u + 0x7fffu + ((u >> 16) & 1u)) >> 16; }
__device__ __forceinline__ unsigned pk2(float lo, float hi) { return f2bf(lo) | (f2bf(hi) << 16); }
__device__ __forceinline__ float bflo(unsigned w) { return __builtin_bit_cast(float, w << 16); }
__device__ __forceinline__ float bfhi(unsigned w) { return __builtin_bit_cast(float, w & 0xffff0000u); }
__device__ __forceinline__ float wave_sum(float v) {
#pragma unroll
    for (int o = 1; o < 64; o <<= 1) v += __shfl_xor(v, o);
    return v;
}

__device__ __forceinline__ void transpose_item(const float* W, int N, bf16_t* WT, int ldw, LAS float* scr, int kb, int nb, int lane) {
    const int k0 = 64 * kb, n0 = 32 * nb;
#pragma unroll 8
    for (int i = 0; i < 32; ++i) { const int kk = 2 * i + (lane >> 5); scr[kk * 33 + (lane & 31)] = W[(size_t)(k0 + kk) * N + n0 + (lane & 31)]; }
    asm volatile("s_waitcnt lgkmcnt(0)" ::: "memory");
    const int c = lane & 7;
#pragma unroll
    for (int j = 0; j < 4; ++j) { const int n = (lane >> 3) + 8 * j; const LAS float* s = scr + (8 * c) * 33 + n;
        u32x4 o; o.x = pk2(s[0 * 33], s[1 * 33]); o.y = pk2(s[2 * 33], s[3 * 33]); o.z = pk2(s[4 * 33], s[5 * 33]); o.w = pk2(s[6 * 33], s[7 * 33]);
        *(u32x4*)(WT + (size_t)(n0 + n) * ldw + k0 + 8 * c) = o; }
    asm volatile("s_waitcnt lgkmcnt(0)" ::: "memory");
}

struct Args {
    const float *x, *c, *ln_in_g, *ln_in_b, *w_ada, *b_ada, *w_in, *rpb, *w_pool, *pool_scale, *w_out, *ln1_g, *ln1_b, *w_mlp1, *w_mlp2, *ln2_g, *ln2_b;
    float* out; unsigned char* ws; int ph_lo, ph_hi;
};

__device__ __forceinline__ void p0_prologue(const Args& a, LAS unsigned char* lds, int G, int bid, int tid) {
    asm volatile("" : "+v"(tid));
    const int lane = tid & 63, wave = tid >> 6;
    unsigned char* ws = a.ws;
    float* mod = (float*)(ws + WS_MOD);
    for (int item = bid; item < 2 * (NMOD / 64); item += G) {
        const int l = item / (NMOD / 64), n0 = (item % (NMOD / 64)) * 64;
        LAS float* cact = (LAS float*)lds;
        LAS float* red = (LAS float*)(lds + 65536);
        for (int i = tid; i < BATCH * D; i += 512) { const int b = i >> 10, k = i & 1023; const float v = a.c[i]; cact[k * 16 + b] = v / (1.0f + expf(-v)); }
        __syncthreads();
        const int ks = tid >> 6, col = tid & 63;
        float acc[16];
#pragma unroll
        for (int b = 0; b < 16; ++b) acc[b] = 0.f;
        const float* wp = a.w_ada + (size_t)l * D * NMOD + (size_t)(ks * 128) * NMOD + n0 + col;
#pragma unroll 4
        for (int kk = 0; kk < 128; ++kk) {
            const float w = wp[(size_t)kk * NMOD];
            const LAS f32x4* cp = (const LAS f32x4*)(cact + (ks * 128 + kk) * 16);
#pragma unroll
            for (int q = 0; q < 4; ++q) { const f32x4 cv = cp[q]; acc[4 * q + 0] += cv.x * w; acc[4 * q + 1] += cv.y * w; acc[4 * q + 2] += cv.z * w; acc[4 * q + 3] += cv.w * w; }
        }
#pragma unroll
        for (int b = 0; b < 16; ++b) red[(ks * 16 + b) * 64 + col] = acc[b];
        __syncthreads();
        for (int o = tid; o < 1024; o += 512) { const int b = o >> 6, cc = o & 63; float s = 0.f;
#pragma unroll
            for (int k8 = 0; k8 < 8; ++k8) s += red[(k8 * 16 + b) * 64 + cc];
            mod[(size_t)(l * 16 + b) * NMOD + n0 + cc] = s + a.b_ada[l * NMOD + n0 + cc]; }
        __syncthreads();
    }
    for (int idx = bid * 512 + tid; idx < 2 * 4 * 16 * 1024; idx += G * 512) {
        const int l = idx >> 16, g = (idx >> 14) & 3, cch = (idx >> 10) & 15, n = idx & 1023;
        const float* wo = a.w_out + (size_t)l * D * D + (size_t)(512 + g * 128) * D + n;
        const float* wpl = a.w_pool + ((size_t)(l * 4 + g) * 128 + cch * 8) * 128;
        const float* ps = a.pool_scale + l * 512 + g * 128;
        float acc[8];
#pragma unroll
        for (int i = 0; i < 8; ++i) acc[i] = 0.f;
#pragma unroll 4
        for (int d = 0; d < 128; ++d) { const float v = wo[(size_t)d * D] * ps[d];
#pragma unroll
            for (int i = 0; i < 8; ++i) acc[i] += wpl[i * 128 + d] * v; }
        u32x4 o; o.x = pk2(acc[0], acc[1]); o.y = pk2(acc[2], acc[3]); o.z = pk2(acc[4], acc[5]); o.w = pk2(acc[6], acc[7]);
        *(u32x4*)((bf16_t*)(ws + WS_WOUT) + (size_t)l * D * D + (size_t)n * D + 512 + g * 128 + cch * 8) = o;
    }
    {
        LAS float* scr = (LAS float*)(lds + wave * 16384);
        const int gw = bid * 8 + wave, NGW = G * 8;
        constexpr int I_IN = 16 * 64, I_OUT = 8 * 32, I_1 = 16 * 128, I_2 = 64 * 32, I_L = I_IN + I_OUT + I_1 + I_2;
        for (int it = gw; it < 2 * I_L; it += NGW) {
            const int l = it / I_L; int r = it % I_L;
            if (r < I_IN) { transpose_item(a.w_in + (size_t)l * D * PROJ, PROJ, (bf16_t*)(ws + WS_WIN) + (size_t)l * PROJ * D, D, scr, r / 64, r % 64, lane); continue; } r -= I_IN;
            if (r < I_OUT) { transpose_item(a.w_out + (size_t)l * D * D, D, (bf16_t*)(ws + WS_WOUT) + (size_t)l * D * D, D, scr, r / 32, r % 32, lane); continue; } r -= I_OUT;
            if (r < I_1) { transpose_item(a.w_mlp1 + (size_t)l * D * FF, FF, (bf16_t*)(ws + WS_W1) + (size_t)l * FF * D, D, scr, r / 128, r % 128, lane); continue; } r -= I_1;
            transpose_item(a.w_mlp2 + (size_t)l * FF * D, D, (bf16_t*)(ws + WS_W2) + (size_t)l * D * FF, FF, scr, r / 32, r % 32, lane);
        }
    }
}

template <bool SRC_BF16, bool OUT_F32>
__device__ __forceinline__ void ln_phase(const void* srcv, float* dstF, bf16_t* dstH, const float* g, const float* bt, const float* sc, const float* sh, int G, int bid, int tid) {
    asm volatile("" : "+v"(tid));
    const int lane = tid & 63, wave = tid >> 6;
    const int gw = bid * 8 + wave, NGW = G * 8;
    const int rpw = (((M + NGW - 1) / NGW) + 3) & ~3;
    const int r0 = gw * rpw, r1 = (r0 + rpw < M) ? r0 + rpw : M;
    if (r0 >= M) return;
    const int c0 = 8 * lane;
    f32x4 gv[4], bv[4], scv[4], shv[4];
#pragma unroll
    for (int j = 0; j < 4; ++j) { const int cj = c0 + (j >> 1) * 512 + (j & 1) * 4; gv[j] = *(const f32x4*)(g + cj); bv[j] = *(const f32x4*)(bt + cj); scv[j] = (f32x4){1.f, 1.f, 1.f, 1.f}; shv[j] = (f32x4){0.f, 0.f, 0.f, 0.f}; }
    int curb = -1;
    for (int r = r0; r < r1; r += 4) {
        f32x4 nf[4][4]; u32x4 nb[4][2];
#pragma unroll
        for (int q = 0; q < 4; ++q) {
            if (SRC_BF16) { const bf16_t* p = (const bf16_t*)srcv + (size_t)(r + q) * D + c0; nb[q][0] = *(const u32x4*)p; nb[q][1] = *(const u32x4*)(p + 512); }
            else { const float* p = (const float*)srcv + (size_t)(r + q) * D + c0; nf[q][0] = *(const f32x4*)p; nf[q][1] = *(const f32x4*)(p + 4); nf[q][2] = *(const f32x4*)(p + 512); nf[q][3] = *(const f32x4*)(p + 516); }
        }
        const int b = r >> 12;
        if (!OUT_F32 && b != curb) { curb = b;
#pragma unroll
            for (int j = 0; j < 4; ++j) { const int cj = c0 + (j >> 1) * 512 + (j & 1) * 4; scv[j] = *(const f32x4*)(sc + (size_t)b * NMOD + cj) + 1.0f; shv[j] = *(const f32x4*)(sh + (size_t)b * NMOD + cj); } }
#pragma unroll
        for (int q = 0; q < 4; ++q) {
            f32x4 v[4];
            if (SRC_BF16) {
#pragma unroll
                for (int t = 0; t < 2; ++t) { const u32x4 w = nb[q][t]; v[2 * t].x = bflo(w.x); v[2 * t].y = bfhi(w.x); v[2 * t].z = bflo(w.y); v[2 * t].w = bfhi(w.y); v[2 * t + 1].x = bflo(w.z); v[2 * t + 1].y = bfhi(w.z); v[2 * t + 1].z = bflo(w.w); v[2 * t + 1].w = bfhi(w.w); }
            } else {
#pragma unroll
                for (int j = 0; j < 4; ++j) v[j] = nf[q][j];
            }
            float s = 0.f;
#pragma unroll
            for (int j = 0; j < 4; ++j) s += (v[j].x + v[j].y) + (v[j].z + v[j].w);
            const float mean = wave_sum(s) * (1.f / D); float s2 = 0.f;
#pragma unroll
            for (int j = 0; j < 4; ++j) { v[j] = v[j] - mean; s2 += (v[j].x * v[j].x + v[j].y * v[j].y) + (v[j].z * v[j].z + v[j].w * v[j].w); }
            const float rstd = 1.f / sqrtf(wave_sum(s2) * (1.f / D) + LN_EPS);
#pragma unroll
            for (int j = 0; j < 4; ++j) v[j] = v[j] * rstd * gv[j] + bv[j];
            if (OUT_F32) { float* p = dstF + (size_t)(r + q) * D + c0; *(f32x4*)p = v[0]; *(f32x4*)(p + 4) = v[1]; *(f32x4*)(p + 512) = v[2]; *(f32x4*)(p + 516) = v[3]; }
            else {
#pragma unroll
                for (int j = 0; j < 4; ++j) v[j] = v[j] * scv[j] + shv[j];
                bf16_t* p = dstH + (size_t)(r + q) * D + c0;
                u32x4 w0, w1; w0.x = pk2(v[0].x, v[0].y); w0.y = pk2(v[0].z, v[0].w); w0.z = pk2(v[1].x, v[1].y); w0.w = pk2(v[1].z, v[1].w);
                w1.x = pk2(v[2].x, v[2].y); w1.y = pk2(v[2].z, v[2].w); w1.z = pk2(v[3].x, v[3].y); w1.w = pk2(v[3].z, v[3].w);
                *(u32x4*)p = w0; *(u32x4*)(p + 512) = w1;
            }
        }
    }
}

__device__ __forceinline__ void add8(float (&s)[8], const u32x4 w) { s[0] += bflo(w.x); s[1] += bfhi(w.x); s[2] += bflo(w.y); s[3] += bfhi(w.y); s[4] += bflo(w.z); s[5] += bfhi(w.z); s[6] += bflo(w.w); s[7] += bfhi(w.w); }
__device__ __forceinline__ void sub8(float (&s)[8], const u32x4 w) { s[0] -= bflo(w.x); s[1] -= bfhi(w.x); s[2] -= bflo(w.y); s[3] -= bfhi(w.y); s[4] -= bflo(w.z); s[5] -= bfhi(w.z); s[6] -= bflo(w.w); s[7] -= bfhi(w.w); }
template <int W>
__device__ __forceinline__ void pool_lane(const bf16_t* Ubc  , bf16_t* catc  , int T0) {
    constexpr int HW = W / 2, NL = 8 + W - 1;
    u32x4 raw[NL];
#pragma unroll
    for (int k = 0; k < NL; ++k) { const int tk = T0 - HW + k; const int tc = tk < 0 ? 0 : (tk > SEQ - 1 ? SEQ - 1 : tk); u32x4 v = *(const u32x4*)(Ubc + (size_t)tc * AW);
        if (tk != tc) v = (u32x4){0u, 0u, 0u, 0u}; raw[k] = v; }
    float sm[8];
#pragma unroll
    for (int e = 0; e < 8; ++e) sm[e] = 0.f;
#pragma unroll
    for (int k = 0; k < W; ++k) add8(sm, raw[k]);
#pragma unroll
    for (int o = 0; o < 8; ++o) {
        int lo = T0 + o - HW, hi = lo + W; lo = lo < 0 ? 0 : lo; hi = hi > SEQ ? SEQ : hi; const float ic = 1.0f / (float)(hi - lo);
        const u32x4 c = raw[o + HW];
        u32x4 w; w.x = pk2(sm[0] * ic - bflo(c.x), sm[1] * ic - bfhi(c.x)); w.y = pk2(sm[2] * ic - bflo(c.y), sm[3] * ic - bfhi(c.y));
        w.z = pk2(sm[4] * ic - bflo(c.z), sm[5] * ic - bfhi(c.z)); w.w = pk2(sm[6] * ic - bflo(c.w), sm[7] * ic - bfhi(c.w));
        *(u32x4*)(catc + (size_t)(T0 + o) * D) = w;
        if (o < 7) { add8(sm, raw[o + W]); sub8(sm, raw[o]); }
    }
}
__device__ __forceinline__ void attn_pool_phase(LAS unsigned char* lds, const bf16_t* Qb, const bf16_t* Kb, const bf16_t* Vt, const bf16_t* Ub, bf16_t* cat, const float* rpb_l, int G, int bid, int tid, int mode = 0) {
    asm volatile("" : "+v"(tid));
    LAS float* tab = (LAS float*)lds;
    for (int i = tid; i < NHEAD * RPB_H * 64; i += 512) { const int c = (i & 63) - 16, hr = i >> 6; tab[i] = (c >= 0 && c < RPB_W) ? rpb_l[hr * RPB_W + c] * LOG2E : 0.f; }
    __syncthreads();
    const int lane = tid & 63, h = __builtin_amdgcn_readfirstlane(tid >> 6), q16 = lane & 15, g4 = lane >> 4;
    const LAS float* tabh = tab + h * (RPB_H * 64) + 16;
    const bool xl = (G == 256); const int nun = xl ? 4 : (BATCH * 64 + G - 1) / G;
    for (int k = 0; k < nun; ++k) {
        const int unit = xl ? ((bid & 7) * 128 + k * 32 + (bid >> 3)) : (bid + k * G);
        if (unit >= BATCH * 64) break;
        const int b = unit >> 6, r = unit & 63; const int rs = r < 4 ? 0 : (r > 60 ? 56 : r - 4);
        const size_t tok0 = (size_t)b * SEQ + r * 64;
#pragma unroll 1
        for (int j = 0; j < ((mode & 2) ? 0 : 4); ++j) {
            const int cb = (j == 0) ? 0 : (j == 1) ? 8 : (j == 2) ? 24 : 32;
            const int qc = 16 * j + q16; const int cs = qc < 8 ? 0 : (qc > 56 ? 48 : qc - 8);
            const int tb0 = cb + g4 * 8 - qc + 15;
            const int vlo = cs - (cb + g4 * 8);
            const size_t cbase = ((size_t)(b * 8 + h) * 8 + g4) * SEQ;
            const bf16_t* qp = Qb + (cbase + r * 64 + qc) * 8;
            const bf16x8 q0 = *(const bf16x8*)qp, q1 = *(const bf16x8*)(qp + (size_t)4 * SEQ * 8);
            bf16x8 kf[8][2][2];
            const bf16_t* kbase = Kb + (cbase + rs * 64 + cb + (q16 >> 2) * 8 + (q16 & 3)) * 8;
#pragma unroll
            for (int i = 0; i < 8; ++i)
#pragma unroll
                for (int hh = 0; hh < 2; ++hh) { const bf16_t* kp = kbase + (size_t)(i * 64 + hh * 4) * 8; kf[i][hh][0] = *(const bf16x8*)kp; kf[i][hh][1] = *(const bf16x8*)(kp + (size_t)4 * SEQ * 8); }
            __builtin_amdgcn_sched_barrier(0);
            f32x4 s[8][2];
            float mx = -1e30f;
#pragma unroll
            for (int i = 0; i < 8; ++i)
#pragma unroll
                for (int hh = 0; hh < 2; ++hh) {
                    f32x4 acc = (f32x4){0.f, 0.f, 0.f, 0.f};
                    acc = __builtin_amdgcn_mfma_f32_16x16x32_bf16(kf[i][hh][0], q0, acc, 0, 0, 0);
                    acc = __builtin_amdgcn_mfma_f32_16x16x32_bf16(kf[i][hh][1], q1, acc, 0, 0, 0);
                    const LAS float* trow = tabh + (rs + i - r + 7) * 64 + tb0 + hh * 4;
#pragma unroll
                    for (int jj = 0; jj < 4; ++jj) {
                        const float bv = trow[jj];
                        const bool valid = (unsigned)(hh * 4 + jj - vlo) < 16u;
                        const float sv = valid ? acc[jj] + bv : -1e30f;
                        acc[jj] = sv; mx = fmaxf(mx, sv);
                    }
                    s[i][hh] = acc;
                }
            bf16x8 vf[8][4];
            const bf16_t* vbase = Vt + (((size_t)(b * 8 + h) * (SEQ / 8) + (rs * 64 + cb) / 8 + g4) * 64 + q16) * 8;
#pragma unroll
            for (int i = 0; i < 8; ++i)
#pragma unroll
                for (int db = 0; db < 4; ++db) vf[i][db] = *(const bf16x8*)(vbase + (size_t)i * 8 * 512 + db * 128);
            __builtin_amdgcn_sched_barrier(0);
            mx = fmaxf(mx, __shfl_xor(mx, 16)); mx = fmaxf(mx, __shfl_xor(mx, 32));
            float sum = 0.f;
            u32x4 pw[8];
#pragma unroll
            for (int i = 0; i < 8; ++i) {
#pragma unroll
                for (int hh = 0; hh < 2; ++hh)
#pragma unroll
                    for (int jj = 0; jj < 4; ++jj) { const float p = __builtin_amdgcn_exp2f(s[i][hh][jj] - mx); s[i][hh][jj] = p; sum += p; }
                pw[i].x = pg8::cvt_pk_bf16(s[i][0][0], s[i][0][1]); pw[i].y = pg8::cvt_pk_bf16(s[i][0][2], s[i][0][3]); pw[i].z = pg8::cvt_pk_bf16(s[i][1][0], s[i][1][1]); pw[i].w = pg8::cvt_pk_bf16(s[i][1][2], s[i][1][3]);
            }
            sum += __shfl_xor(sum, 16); sum += __shfl_xor(sum, 32);
            f32x4 o[4];
#pragma unroll
            for (int db = 0; db < 4; ++db) o[db] = (f32x4){0.f, 0.f, 0.f, 0.f};
#pragma unroll
            for (int i = 0; i < 8; ++i) {
                const bf16x8 pf = __builtin_bit_cast(bf16x8, pw[i]);
#pragma unroll
                for (int db = 0; db < 4; ++db) o[db] = __builtin_amdgcn_mfma_f32_16x16x32_bf16(vf[i][db], pf, o[db], 0, 0, 0);
            }
            const float inv = 1.0f / sum;
            bf16_t* op = cat + (tok0 + qc) * D + h * 64 + g4 * 4;
#pragma unroll
            for (int db = 0; db < 4; ++db) { u32x2 w; w.x = pg8::cvt_pk_bf16(o[db][0] * inv, o[db][1] * inv); w.y = pg8::cvt_pk_bf16(o[db][2] * inv, o[db][3] * inv); *(u32x2*)(op + db * 16) = w; }
        }
        if (!(mode & 1)) {
            const int gidx = h & 3, hfl = h >> 2; const int T0 = r * 64 + hfl * 32 + g4 * 8; const int chan = gidx * 128 + q16 * 8;
            const bf16_t* Ubc = Ub + (size_t)b * SEQ * AW + chan; bf16_t* catc = cat + (size_t)b * SEQ * D + 512 + chan;
            if (gidx == 0) pool_lane<2>(Ubc, catc, T0); else if (gidx == 1) pool_lane<4>(Ubc, catc, T0); else if (gidx == 2) pool_lane<8>(Ubc, catc, T0); else pool_lane<16>(Ubc, catc, T0);
        }
    }
}

constexpr int N_PHASES = 2 + 7 * DEPTH;
__global__ void __launch_bounds__(512, 2) fwd_megakernel(Args a) {
    extern __shared__ __attribute__((aligned(16))) unsigned char lds_raw[];
    LAS unsigned char* lds = (LAS unsigned char*)lds_raw;
    cg::grid_group grid = cg::this_grid();
    const int tid = threadIdx.x, bid = blockIdx.x, G = gridDim.x;
    unsigned char* ws = a.ws;
    bf16_t* H = (bf16_t*)(ws + WS_H); bf16_t* F = (bf16_t*)(ws + WS_F);
    bf16_t* Qb = (bf16_t*)(ws + WS_Q); bf16_t* Kb = (bf16_t*)(ws + WS_K); bf16_t* Vt = (bf16_t*)(ws + WS_VT); bf16_t* Ub = (bf16_t*)(ws + WS_U); bf16_t* CAT = (bf16_t*)(ws + WS_CAT);
    const float* mod = (const float*)(ws + WS_MOD);
    const int lo = a.ph_lo, hi = a.ph_hi;
#define IN(k) (lo <= (k) && (k) < hi)
    unsigned* barw = (unsigned*)(ws + WS_CTL);
    volatile LAS unsigned* misc = (volatile LAS unsigned*)(lds + 131072 + 1024);
    if (bid == 0) { for (int i = tid; i < 4608; i += 512) barw[i] = 0u; }
    if (tid < 8) misc[tid] = 0u;
    __syncthreads();
    XcdBarrier xbar; xbar.bar = barw; xbar.x = 0; xbar.st = misc;
    int vb = bid;
#define SEAM(k) do { if (IN(k) && IN((k) + 1)) { if ((k) == 0) { grid.sync(); xbar = xcd_barrier_post(barw, misc); if (tid == 0) misc[2] = xb_add(&barw[3456 + 64 * xbar.x], 1u); } \
        else { xcd_barrier(xbar); if ((k) == 1) { \
            if (tid == 0) { bool ok = (G % 8 == 0) && xbar.x < 8u; for (int j = 0; j < 8; ++j) ok = ok && (xb_ld(&barw[3456 + 64 * j]) == (unsigned)(G / 8)); misc[3] = ok ? 1u : 0u; } \
            __syncthreads(); if (misc[3]) vb = (int)(misc[2] * 8u + xbar.x); } } } } while (0)

    if (IN(0)) { for (int rep = 0; rep <= PROBE_P0; ++rep) { p0_prologue(a, lds, G, bid, tid); if (rep < PROBE_P0) __syncthreads(); } }
    SEAM(0);
    if (IN(1)) { ln_phase<false, false>(a.x, nullptr, H, a.ln_in_g, a.ln_in_b, mod + 1 * D, mod + 0 * D, G, bid, tid); }
    SEAM(1);
#pragma unroll 1
    for (int l = 0; l < DEPTH; ++l) {
        const int p = 2 + 7 * l;
        const float* modl = mod + (size_t)l * BATCH * NMOD;
        if (IN(p + 0)) {
            pg8::Gemm g{H, (const bf16_t*)(ws + WS_WIN) + (size_t)l * PROJ * D, M, PROJ, D}; pg8::StaticOrder S; S.init(M, PROJ, G, vb);
            pg8::EpiProj E{Qb, Kb, Vt, Ub};
            pg8::gemm_phase<pg8::EpiProj, true>(lds, g, S, E);
        }
        SEAM(p + 0);
        if (IN(p + 1)) { for (int rep = 0; rep <= PROBE_ATT; ++rep) { attn_pool_phase(lds, Qb, Kb, Vt, Ub, CAT, a.rpb + (size_t)l * NHEAD * RPB_N, G, vb, tid, rep == 0 ? 0 : PROBE_MODE); if (rep < PROBE_ATT) xcd_barrier(xbar); } }
        SEAM(p + 1);
        if (IN(p + 2)) {
            pg8::Gemm g{CAT, (const bf16_t*)(ws + WS_WOUT) + (size_t)l * D * D, M, D, D}; pg8::StaticOrder S; S.init(M, D, G, vb);
            pg8::EpiRes E{H, modl, 0 * D, 1 * D, 2 * D};
            pg8::gemm_phase<pg8::EpiRes, true>(lds, g, S, E);
        }
        SEAM(p + 2);
        if (IN(p + 3)) { ln_phase<true, false>(H, nullptr, H, a.ln1_g + l * D, a.ln1_b + l * D, modl + 4 * D, modl + 3 * D, G, bid, tid); }
        SEAM(p + 3);
        if (IN(p + 4)) {
            pg8::Gemm g{H, (const bf16_t*)(ws + WS_W1) + (size_t)l * FF * D, M, FF, D}; pg8::StaticOrder S; S.init(M, FF, G, vb);
            for (int rep = 0; rep <= PROBE_MLP1; ++rep) { pg8::EpiRelu2 E{F, FF, (rep > 0 && PROBE_MLP1_NOSTORE) ? 1 : 0};
                pg8::gemm_phase<pg8::EpiRelu2, true>(lds, g, S, E); if (rep < PROBE_MLP1) xcd_barrier(xbar); }
        }
        SEAM(p + 4);
        if (IN(p + 5)) {
            pg8::Gemm g{F, (const bf16_t*)(ws + WS_W2) + (size_t)l * D * FF, M, D, FF}; pg8::StaticOrder S; S.init(M, D, G, vb);
            pg8::EpiRes E{H, modl, 3 * D, 4 * D, 5 * D};
            pg8::gemm_phase<pg8::EpiRes, true>(lds, g, S, E);
        }
        SEAM(p + 5);
        if (IN(p + 6)) {
            const bool lastl = (l == DEPTH - 1);
            const float* modn = mod + (size_t)(lastl ? l : l + 1) * BATCH * NMOD;
            if (lastl) ln_phase<true, true>(H, a.out, nullptr, a.ln2_g + l * D, a.ln2_b + l * D, modn, modn, G, bid, tid);
            else ln_phase<true, false>(H, nullptr, H, a.ln2_g + l * D, a.ln2_b + l * D, modn + 1 * D, modn + 0 * D, G, bid, tid);
        }
        SEAM(p + 6);
    }
    for (int rep = 0; rep < PROBE_SYNC; ++rep) xcd_barrier(xbar);
#undef IN
#undef SEAM
}

extern "C" void kernel_launch(void* const* d_in, const int* in_sizes, int n_in, void* d_out, int out_size, void* d_ws, size_t ws_size, hipStream_t stream) {
    static int grid = 0;
    if (grid == 0) {
        if (n_in != 17 || in_sizes[0] != M * D || out_size != M * D || ws_size < WS_END) { fprintf(stderr, "kernel_launch: unexpected shapes / workspace (n_in %d, in0 %d, out %d, ws %zu)\n", n_in, n_in > 0 ? in_sizes[0] : -1, out_size, ws_size); grid = -1; return; }
        int dev = 0, cus = 0, per_cu = 0;
        hipGetDevice(&dev); hipDeviceGetAttribute(&cus, hipDeviceAttributeMultiprocessorCount, dev);
        if (hipFuncSetAttribute((const void*)fwd_megakernel, hipFuncAttributeMaxDynamicSharedMemorySize, LDS_BYTES) != hipSuccess) { fprintf(stderr, "kernel_launch: hipFuncSetAttribute failed\n"); grid = -1; return; }
        if (hipOccupancyMaxActiveBlocksPerMultiprocessor(&per_cu, (const void*)fwd_megakernel, 512, LDS_BYTES) != hipSuccess || per_cu < 1) { per_cu = 1; (void)hipGetLastError(); }
        grid = (cus > 0 ? cus : 256) * per_cu;
    }
    if (grid < 0) return;
    Args a{};
    a.x = (const float*)d_in[0]; a.c = (const float*)d_in[1]; a.ln_in_g = (const float*)d_in[2]; a.ln_in_b = (const float*)d_in[3]; a.w_ada = (const float*)d_in[4]; a.b_ada = (const float*)d_in[5];
    a.w_in = (const float*)d_in[6]; a.rpb = (const float*)d_in[7]; a.w_pool = (const float*)d_in[8]; a.pool_scale = (const float*)d_in[9]; a.w_out = (const float*)d_in[10];
    a.ln1_g = (const float*)d_in[11]; a.ln1_b = (const float*)d_in[12]; a.w_mlp1 = (const float*)d_in[13]; a.w_mlp2 = (const float*)d_in[14]; a.ln2_g = (const float*)d_in[15]; a.ln2_b = (const float*)d_in[16];
    a.out = (float*)d_out; a.ws = (unsigned char*)d_ws;
#if MK_MULTI
    for (int p = 0; p < N_PHASES; ++p) { a.ph_lo = p; a.ph_hi = p + 1; hipLaunchKernelGGL(fwd_megakernel, dim3(grid), dim3(512), LDS_BYTES, stream, a); }
#else
    a.ph_lo = 0; a.ph_hi = N_PHASES;
    void* args[] = {&a};
    hipError_t e = hipLaunchCooperativeKernel((const void*)fwd_megakernel, dim3(grid), dim3(512), args, LDS_BYTES, stream);
    if (e != hipSuccess) fprintf(stderr, "kernel_launch: cooperative launch failed: %s (grid %d)\n", hipGetErrorString(e), grid);
#endif
}
```

```cpp
#include <hip/hip_runtime.h>
#include <hip/hip_cooperative_groups.h>
#include <cstdio>
#include <cstdint>
namespace cg = cooperative_groups;

#define LAS __attribute__((address_space(3)))
typedef unsigned short bf16_t;
typedef short bf16x8 __attribute__((ext_vector_type(8)));
typedef float f32x4 __attribute__((ext_vector_type(4)));
typedef float f32x2 __attribute__((ext_vector_type(2)));
typedef unsigned u32x4 __attribute__((ext_vector_type(4)));
typedef unsigned u32x2 __attribute__((ext_vector_type(2)));

#ifndef PROBE_ATT
#define PROBE_ATT 0
#endif
#ifndef PROBE_P0
#define PROBE_P0 0
#endif
#ifndef PROBE_MODE
#define PROBE_MODE 0
#endif
#ifndef PROBE_MLP1
#define PROBE_MLP1 0
#endif
#ifndef PROBE_MLP1_NOSTORE
#define PROBE_MLP1_NOSTORE 0
#endif
#ifndef PROBE_SYNC
#define PROBE_SYNC 0
#endif
#ifndef MK_MULTI
#define MK_MULTI 0
#endif

constexpr int BATCH = 16, SEQ = 4096, D = 1024, DEPTH = 2, M = BATCH * SEQ;
constexpr int PROJ = 2048, FF = 4096, NMOD = 6 * D, AW = 512;
constexpr int NHEAD = 8;
constexpr float LN_EPS = 1e-5f;
constexpr float DN_ALPHA = 1.41421356237309515f;
constexpr float LOG2E = 1.44269504088896341f;
constexpr float QSCALE = 0.125f * LOG2E;
constexpr int RPB_H = 15, RPB_W = 31, RPB_N = RPB_H * RPB_W;

constexpr size_t MiB = (size_t)1 << 20;
constexpr size_t WS_WIN = 0 * MiB;
constexpr size_t WS_WOUT = 8 * MiB;
constexpr size_t WS_W1 = 12 * MiB;
constexpr size_t WS_W2 = 28 * MiB;
constexpr size_t WS_MOD = 44 * MiB;
constexpr size_t WS_CTL = 46 * MiB;
constexpr size_t WS_X = 48 * MiB;
constexpr size_t WS_H = 304 * MiB;
constexpr size_t WS_F = 432 * MiB;
constexpr size_t WS_Q = 432 * MiB;
constexpr size_t WS_K = 496 * MiB;
constexpr size_t WS_VT = 560 * MiB;
constexpr size_t WS_U = 624 * MiB;
constexpr size_t WS_CAT = 688 * MiB;
constexpr size_t WS_END = 944 * MiB;

constexpr int LDS_BYTES = 147456;

namespace pg8 {
constexpr int BM = 256, BK = 64, HALF = 128, HTB = HALF * BK * 2, STAGE_BYTES = 8 * HTB, NXCD = 8, WGM = 8;
__host__ __device__ __forceinline__ int lds_byte(int r, int c) { const int st = (r >> 4) * 2 + (c >> 5), rr = r & 15, cc = c & 31, ob = rr * 64 + cc * 2; return st * 1024 + (ob ^ (((ob >> 9) & 1) << 5)); }
__host__ __device__ __forceinline__ void stage_rc(int b, int& R, int& C) { const int st = b / 1024, sb = b % 1024, swz = sb ^ (((sb >> 9) & 1) << 5); R = (st >> 1) * 16 + swz / 64; C = (st & 1) * 32 + (swz % 64) / 2; }
__host__ __device__ __forceinline__ int perm32(int rho) { const int n = rho >> 4, i = rho & 15; return 8 * (i >> 2) + 4 * n + (i & 3); }

struct Unit { int pm, pn; };
struct Gemm { const bf16_t* A; const bf16_t* Bt; int M, N, K; };

struct StaticOrder {
    int nM, nN, nwg, G, c;
    __device__ void init(int M_, int N_, int G_, int c_) { nM = M_ / BM; nN = N_ / BM; nwg = nM * nN; G = G_; c = c_; }
    __device__ bool next(int i, Unit& u) const {
        const long L = (long)i * G + c; if (L >= nwg) return false;
        int wgid = (int)L; { const int q = nwg / NXCD, r = nwg % NXCD, xcd = wgid % NXCD, off = wgid / NXCD; wgid = (xcd < r ? xcd * (q + 1) : r * (q + 1) + (xcd - r) * q) + off; }
        const int nig = WGM * nN, gid = wgid / nig, fm = gid * WGM, gsz = (nM - fm) < WGM ? (nM - fm) : WGM;
        u.pm = fm + ((wgid % nig) % gsz); u.pn = (wgid % nig) / gsz; return true;
    }
};

__device__ __forceinline__ unsigned cvt_pk_bf16(float lo, float hi) { unsigned r; asm volatile("v_cvt_pk_bf16_f32 %0, %1, %2" : "=v"(r) : "v"(lo), "v"(hi)); return r; }

struct EpiProj {
    static constexpr bool PERM = true, VSWAP = true, FUSED = false;
    bf16_t* Q; bf16_t* Kb; bf16_t* Vt; bf16_t* U;
    __device__ __forceinline__ void operator()(const f32x4 (&acc)[2][2][4][2], const Unit& u, int wr, int wc, int fr, int fq) const {
        const int t = u.pn >> 1;
        if (t == 2) {
            const int dg0 = (u.pn & 1) * 256 + wr * 64 + fr; const int b = u.pm >> 4; const int s0 = (u.pm & 15) * 256 + wc * 32 + 8 * fq;
#pragma unroll
            for (int ai = 0; ai < 2; ++ai)
#pragma unroll
                for (int m = 0; m < 4; ++m) { const int dg = dg0 + ai * HALF + m * 16;
                    bf16_t* rowp = Vt + ((size_t)(b * 8 + (dg >> 6)) * (SEQ / 8) + (s0 >> 3)) * 512 + (dg & 63) * 8;
#pragma unroll
                    for (int bj = 0; bj < 2; ++bj) { const f32x4 v0 = acc[ai][bj][m][0], v1 = acc[ai][bj][m][1];
                        u32x4 w; w.x = cvt_pk_bf16(v0[0], v0[1]); w.y = cvt_pk_bf16(v0[2], v0[3]); w.z = cvt_pk_bf16(v1[0], v1[1]); w.w = cvt_pk_bf16(v1[2], v1[3]);
                        *(u32x4*)(rowp + (size_t)bj * (HALF / 8) * 512) = w; } }
        } else {
            bf16_t* base = Q + (size_t)t * ((size_t)M * AW); const float sc = t == 0 ? QSCALE : 1.0f;
            const int row0 = u.pm * BM + wr * 64 + fr, col0 = (u.pn & 1) * 256 + wc * 32 + 8 * fq;
            const bool cm = t < 2; const int bq = u.pm >> 4;
#pragma unroll
            for (int ai = 0; ai < 2; ++ai)
#pragma unroll
                for (int m = 0; m < 4; ++m) { const int row = row0 + ai * HALF + m * 16;
                    bf16_t* rowp = cm ? base + ((size_t)(bq * 64 + (col0 >> 3)) * SEQ + (row & (SEQ - 1))) * 8 : base + (size_t)row * AW + col0;
                    const size_t bjs = cm ? (size_t)(HALF / 8) * SEQ * 8 : (size_t)HALF;
#pragma unroll
                    for (int bj = 0; bj < 2; ++bj) { const f32x4 v0 = acc[ai][bj][m][0] * sc, v1 = acc[ai][bj][m][1] * sc;
                        u32x4 w; w.x = cvt_pk_bf16(v0[0], v0[1]); w.y = cvt_pk_bf16(v0[2], v0[3]); w.z = cvt_pk_bf16(v1[0], v1[1]); w.w = cvt_pk_bf16(v1[2], v1[3]);
                        *(u32x4*)(rowp + bj * bjs) = w; } }
        }
    }
};
struct EpiRelu2 {
    static constexpr bool PERM = true, VSWAP = false, FUSED = false;
    bf16_t* O; int ldc; int nostore;
    __device__ __forceinline__ void operator()(const f32x4 (&acc)[2][2][4][2], const Unit& u, int wr, int wc, int fr, int fq) const {
        if (nostore) return;
        const int row0 = u.pm * BM + wr * 64 + fr, col0 = u.pn * BM + wc * 32 + 8 * fq;
#pragma unroll
        for (int ai = 0; ai < 2; ++ai)
#pragma unroll
            for (int m = 0; m < 4; ++m) { bf16_t* rowp = O + (size_t)(row0 + ai * HALF + m * 16) * ldc + col0;
#pragma unroll
                for (int bj = 0; bj < 2; ++bj) { f32x4 v0 = acc[ai][bj][m][0], v1 = acc[ai][bj][m][1];
#pragma unroll
                    for (int j = 0; j < 4; ++j) { const float a = fmaxf(v0[j], 0.f), b = fmaxf(v1[j], 0.f); v0[j] = a * a; v1[j] = b * b; }
                    u32x4 w; w.x = cvt_pk_bf16(v0[0], v0[1]); w.y = cvt_pk_bf16(v0[2], v0[3]); w.z = cvt_pk_bf16(v1[0], v1[1]); w.w = cvt_pk_bf16(v1[2], v1[3]);
                    *(u32x4*)(rowp + bj * HALF) = w; } }
    }
};
struct EpiRes {
    static constexpr bool PERM = true, VSWAP = false, FUSED = false;
    bf16_t* H; const float* mod; int sh_off, sc_off, g_off;
    __device__ __forceinline__ void operator()(const f32x4 (&acc)[2][2][4][2], const Unit& u, int wr, int wc, int fr, int fq) const {
        const int row0 = u.pm * BM + wr * 64 + fr, col0 = u.pn * BM + wc * 32 + 8 * fq; const int b = u.pm >> 4;
        const float* mb = mod + (size_t)b * NMOD + col0;
#pragma unroll
        for (int bj = 0; bj < 2; ++bj) {
            f32x4 shv[2], aiv[2], g1v[2];
#pragma unroll
            for (int n = 0; n < 2; ++n) { shv[n] = *(const f32x4*)(mb + sh_off + bj * HALF + 4 * n); const f32x4 s1 = *(const f32x4*)(mb + sc_off + bj * HALF + 4 * n) + 1.0f;
                aiv[n] = (f32x4){DN_ALPHA / s1.x, DN_ALPHA / s1.y, DN_ALPHA / s1.z, DN_ALPHA / s1.w}; g1v[n] = *(const f32x4*)(mb + g_off + bj * HALF + 4 * n) + 1.0f; }
#pragma unroll
            for (int ai = 0; ai < 2; ++ai) {
                u32x4 hw[4];
#pragma unroll
                for (int m = 0; m < 4; ++m) hw[m] = *(const u32x4*)(H + (size_t)(row0 + ai * HALF + m * 16) * D + col0 + bj * HALF);
#pragma unroll
                for (int m = 0; m < 4; ++m) { const u32x4 w0 = hw[m];
                    f32x4 h0, h1; h0.x = __builtin_bit_cast(float, w0.x << 16); h0.y = __builtin_bit_cast(float, w0.x & 0xffff0000u); h0.z = __builtin_bit_cast(float, w0.y << 16); h0.w = __builtin_bit_cast(float, w0.y & 0xffff0000u);
                    h1.x = __builtin_bit_cast(float, w0.z << 16); h1.y = __builtin_bit_cast(float, w0.z & 0xffff0000u); h1.z = __builtin_bit_cast(float, w0.w << 16); h1.w = __builtin_bit_cast(float, w0.w & 0xffff0000u);
                    const f32x4 z0 = (h0 - shv[0]) * aiv[0] + g1v[0] * acc[ai][bj][m][0], z1 = (h1 - shv[1]) * aiv[1] + g1v[1] * acc[ai][bj][m][1];
                    u32x4 w; w.x = cvt_pk_bf16(z0[0], z0[1]); w.y = cvt_pk_bf16(z0[2], z0[3]); w.z = cvt_pk_bf16(z1[0], z1[1]); w.w = cvt_pk_bf16(z1[2], z1[3]);
                    *(u32x4*)(H + (size_t)(row0 + ai * HALF + m * 16) * D + col0 + bj * HALF) = w; }
                asm volatile("" ::: "memory"); }
        }
    }
};

constexpr int TAB_OFF = 131072 + 2048;
struct PanelStats {
    unsigned long long* xbuf;
    unsigned* cnt;
    __device__ __forceinline__ void run(const f32x4 (&v)[2][2][4][2], const Unit& u, int wr, int wc, int fr, int fq, LAS unsigned char* lds, int wid, int lane) const {
        LAS f32x2* P = (LAS f32x2*)(lds + TAB_OFF);
        LAS f32x2* S = (LAS f32x2*)(lds + TAB_OFF + 8192);
#pragma unroll
        for (int ai = 0; ai < 2; ++ai)
#pragma unroll
            for (int m = 0; m < 4; ++m) {
                float s = 0.f;
#pragma unroll
                for (int bj = 0; bj < 2; ++bj)
#pragma unroll
                    for (int n = 0; n < 2; ++n) { const f32x4 x = v[ai][bj][m][n]; s += (x[0] + x[1]) + (x[2] + x[3]); }
                s += __shfl_xor(s, 16); s += __shfl_xor(s, 32);
                const float mw = s * (1.0f / 64.0f); float q = 0.f;
#pragma unroll
                for (int bj = 0; bj < 2; ++bj)
#pragma unroll
                    for (int n = 0; n < 2; ++n) { const f32x4 d = v[ai][bj][m][n] - mw; q += (d[0] * d[0] + d[1] * d[1]) + (d[2] * d[2] + d[3] * d[3]); }
                q += __shfl_xor(q, 16); q += __shfl_xor(q, 32);
                if (fq == 0) P[(ai * HALF + wr * 64 + m * 16 + fr) * 4 + wc] = (f32x2){mw, q};
            }
        asm volatile("s_waitcnt lgkmcnt(0)" ::: "memory"); __builtin_amdgcn_s_barrier(); asm volatile("" ::: "memory");
        const int row = wid * 32 + (lane & 31);
        if (lane < 32) {
            const f32x2 a = P[row * 4 + 0], b = P[row * 4 + 1], c = P[row * 4 + 2], d = P[row * 4 + 3];
            const float mt = (a.x + b.x + c.x + d.x) * 0.25f;
            const float da = a.x - mt, db = b.x - mt, dc = c.x - mt, dd = d.x - mt;
            const float m2 = (a.y + b.y) + (c.y + d.y) + 64.0f * ((da * da + db * db) + (dc * dc + dd * dd));
            unsigned long long* slot = xbuf + ((size_t)(u.pm * BM + row) * 4 + u.pn);
            __hip_atomic_store(slot, ((unsigned long long)__float_as_uint(m2) << 32) | __float_as_uint(mt), __ATOMIC_RELAXED, __HIP_MEMORY_SCOPE_AGENT);
        }
        asm volatile("s_waitcnt vmcnt(0)" ::: "memory");
        if (lane == 0) __hip_atomic_fetch_add(cnt + 64 * u.pm, 1u, __ATOMIC_RELAXED, __HIP_MEMORY_SCOPE_AGENT);
        if (wid == 0) {
            unsigned sp = 0;
            while ((unsigned)__builtin_amdgcn_readfirstlane(__hip_atomic_load(cnt + 64 * u.pm, __ATOMIC_RELAXED, __HIP_MEMORY_SCOPE_AGENT)) < 32u) { __builtin_amdgcn_s_sleep(2); if (++sp > (1u << 20)) break; }
            __builtin_amdgcn_fence(__ATOMIC_ACQUIRE, "agent");
        }
        asm volatile("s_waitcnt vmcnt(0) lgkmcnt(0)" ::: "memory"); __builtin_amdgcn_s_barrier(); asm volatile("" ::: "memory");
        if (lane < 32) {
            const unsigned long long* slot = xbuf + (size_t)(u.pm * BM + row) * 4; float mt[4], m2[4]; float ms = 0.f;
#pragma unroll
            for (int t = 0; t < 4; ++t) { const unsigned long long w = __hip_atomic_load(slot + t, __ATOMIC_RELAXED, __HIP_MEMORY_SCOPE_AGENT); mt[t] = __uint_as_float((unsigned)w); m2[t] = __uint_as_float((unsigned)(w >> 32)); ms += mt[t]; }
            const float mean = ms * 0.25f; float q = 0.f;
#pragma unroll
            for (int t = 0; t < 4; ++t) { const float dm = mt[t] - mean; q += m2[t] + 256.0f * dm * dm; }
            S[row] = (f32x2){mean, 1.0f / sqrtf(q * (1.0f / 1024.0f) + LN_EPS)};
        }
        asm volatile("s_waitcnt lgkmcnt(0)" ::: "memory"); __builtin_amdgcn_s_barrier(); asm volatile("" ::: "memory");
    }
};
template <bool OUT_F32> struct EpiResLn {
    static constexpr bool PERM = true, VSWAP = false, FUSED = true;
    bf16_t* H; float* outF; const float* mod; int sh_off, sc_off, g_off; const float* lng; const float* lnb; const float* mod2; int sh2_off, sc2_off; PanelStats st;
    __device__ __forceinline__ void fused(f32x4 (&acc)[2][2][4][2], const Unit& u, int wr, int wc, int fr, int fq, LAS unsigned char* lds, int wid, int lane) const {
        const int row0 = u.pm * BM + wr * 64 + fr, col0 = u.pn * BM + wc * 32 + 8 * fq; const int b = u.pm >> 4;
        const float* mb = mod + (size_t)b * NMOD + col0;
#pragma unroll
        for (int bj = 0; bj < 2; ++bj) {
            f32x4 shv[2], aiv[2], g1v[2];
#pragma unroll
            for (int n = 0; n < 2; ++n) { shv[n] = *(const f32x4*)(mb + sh_off + bj * HALF + 4 * n); const f32x4 s1 = *(const f32x4*)(mb + sc_off + bj * HALF + 4 * n) + 1.0f;
                aiv[n] = (f32x4){DN_ALPHA / s1.x, DN_ALPHA / s1.y, DN_ALPHA / s1.z, DN_ALPHA / s1.w}; g1v[n] = *(const f32x4*)(mb + g_off + bj * HALF + 4 * n) + 1.0f; }
#pragma unroll
            for (int ai = 0; ai < 2; ++ai) {
                u32x4 hw[4];
#pragma unroll
                for (int m = 0; m < 4; ++m) hw[m] = *(const u32x4*)(H + (size_t)(row0 + ai * HALF + m * 16) * D + col0 + bj * HALF);
#pragma unroll
                for (int m = 0; m < 4; ++m) { const u32x4 w0 = hw[m];
                    f32x4 h0, h1; h0.x = __builtin_bit_cast(float, w0.x << 16); h0.y = __builtin_bit_cast(float, w0.x & 0xffff0000u); h0.z = __builtin_bit_cast(float, w0.y << 16); h0.w = __builtin_bit_cast(float, w0.y & 0xffff0000u);
                    h1.x = __builtin_bit_cast(float, w0.z << 16); h1.y = __builtin_bit_cast(float, w0.z & 0xffff0000u); h1.z = __builtin_bit_cast(float, w0.w << 16); h1.w = __builtin_bit_cast(float, w0.w & 0xffff0000u);
                    acc[ai][bj][m][0] = (h0 - shv[0]) * aiv[0] + g1v[0] * acc[ai][bj][m][0]; acc[ai][bj][m][1] = (h1 - shv[1]) * aiv[1] + g1v[1] * acc[ai][bj][m][1]; }
                asm volatile("" : "+v"(acc[ai][bj][0][0]), "+v"(acc[ai][bj][0][1]), "+v"(acc[ai][bj][1][0]), "+v"(acc[ai][bj][1][1]));
                asm volatile("" : "+v"(acc[ai][bj][2][0]), "+v"(acc[ai][bj][2][1]), "+v"(acc[ai][bj][3][0]), "+v"(acc[ai][bj][3][1]));
                asm volatile("" ::: "memory"); }
        }
        st.run(acc, u, wr, wc, fr, fq, lds, wid, lane);
        const LAS f32x2* S = (const LAS f32x2*)(lds + TAB_OFF + 8192);
        const float* m2b = mod2 + (size_t)b * NMOD + col0;
#pragma unroll
        for (int bj = 0; bj < 2; ++bj) {
            f32x4 Av[2], Bv[2];
#pragma unroll
            for (int n = 0; n < 2; ++n) { const f32x4 gl = *(const f32x4*)(lng + col0 + bj * HALF + 4 * n), bl = *(const f32x4*)(lnb + col0 + bj * HALF + 4 * n);
                if (OUT_F32) { Av[n] = gl; Bv[n] = bl; }
                else { const f32x4 s1 = *(const f32x4*)(m2b + sc2_off + bj * HALF + 4 * n) + 1.0f, sh2 = *(const f32x4*)(m2b + sh2_off + bj * HALF + 4 * n); Av[n] = gl * s1; Bv[n] = bl * s1 + sh2; } }
#pragma unroll
            for (int ai = 0; ai < 2; ++ai)
#pragma unroll
                for (int m = 0; m < 4; ++m) { const int r = ai * HALF + wr * 64 + m * 16 + fr; const f32x2 sr = S[r];
                    const f32x4 o0 = (acc[ai][bj][m][0] - sr.x) * sr.y * Av[0] + Bv[0], o1 = (acc[ai][bj][m][1] - sr.x) * sr.y * Av[1] + Bv[1];
                    if (OUT_F32) { float* p = outF + (size_t)(u.pm * BM + r) * D + col0 + bj * HALF; *(f32x4*)p = o0; *(f32x4*)(p + 4) = o1; }
                    else { u32x4 w; w.x = cvt_pk_bf16(o0[0], o0[1]); w.y = cvt_pk_bf16(o0[2], o0[3]); w.z = cvt_pk_bf16(o1[0], o1[1]); w.w = cvt_pk_bf16(o1[2], o1[3]);
                        *(u32x4*)(H + (size_t)(u.pm * BM + r) * D + col0 + bj * HALF) = w; } }
        }
    }
};

template <class Epi, bool ALIGN_EPI>
__device__ __forceinline__ void gemm_phase(LAS unsigned char* lds, const Gemm g, const StaticOrder& S, const Epi& E) {
    int tid = threadIdx.x; asm volatile("" : "+v"(tid));
    const int wid = __builtin_amdgcn_readfirstlane(tid >> 6), lane = tid & 63, wr = wid >> 2, wc = wid & 3, fr = lane & 15, fq = lane >> 4;
    const int K = g.K, nt = K / BK;
    unsigned voffA[2], voffB[2];
#pragma unroll
    for (int i = 0; i < 2; ++i) { int R, C; stage_rc(tid * 16 + i * 8192, R, C); const int Rb = Epi::PERM ? ((R & ~31) + perm32(R & 31)) : R;
        voffA[i] = (unsigned)(R * K + C) * 2u; voffB[i] = (unsigned)(Rb * K + C) * 2u; }
    const size_t kstep = (size_t)(BK * 2);
    const size_t hstep = (size_t)HALF * K * 2;
    const size_t tstep = 2 * hstep;
    const unsigned ldsw = (unsigned)wid * 1024u;
    const int aoff = lds_byte(wr * 64 + fr, fq * 8), boff = lds_byte(wc * 32 + fr, fq * 8);
#define PG8_SA(b, h) (((b) * 2 + (h)) * HTB)
#define PG8_SB(b, h) ((4 + (b) * 2 + (h)) * HTB)
#define PG8_STAGE(bufoff, gbase, voff) do { _Pragma("unroll") for (int _i = 0; _i < 2; ++_i) \
        __builtin_amdgcn_global_load_lds((const unsigned*)((const char*)(gbase) + (voff)[_i]), (LAS unsigned*)(lds + (bufoff) + ldsw + _i * 8192), 16, 0, 0); } while (0)
#define PG8_LDA(dst, b, h) do { _Pragma("unroll") for (int m = 0; m < 4; ++m) _Pragma("unroll") for (int k = 0; k < 2; ++k) dst[m][k] = *(const LAS bf16x8*)(lds + PG8_SA(b, h) + aoff + m * 2048 + k * 1024); } while (0)
#define PG8_LDB(dst, b, h) do { _Pragma("unroll") for (int n = 0; n < 2; ++n) _Pragma("unroll") for (int k = 0; k < 2; ++k) dst[n][k] = *(const LAS bf16x8*)(lds + PG8_SB(b, h) + boff + n * 2048 + k * 1024); } while (0)
#define PG8_MMA(ai, bj, At, Bt) do { __builtin_amdgcn_s_setprio(1); _Pragma("unroll") for (int m = 0; m < 4; ++m) _Pragma("unroll") for (int n = 0; n < 2; ++n) _Pragma("unroll") for (int k = 0; k < 2; ++k) \
        acc[ai][bj][m][n] = __builtin_amdgcn_mfma_f32_16x16x32_bf16(Bt[n][k], At[m][k], acc[ai][bj][m][n], 0, 0, 0); __builtin_amdgcn_s_setprio(0); } while (0)
#define PG8_WAIT_V(n) asm volatile("s_waitcnt vmcnt(" #n ")" ::: "memory")
#define PG8_WAIT_L(n) asm volatile("s_waitcnt lgkmcnt(" #n ")" ::: "memory")
#define PG8_BAR __builtin_amdgcn_s_barrier()
#define PG8_SCHED __builtin_amdgcn_sched_barrier(0)
#define PG8_PTRS(u, pa, pb) do { const bool _sw = Epi::VSWAP && (((u).pn >> 1) == 2); const char* _a = (const char*)g.A + (size_t)(u).pm * tstep; const char* _b = (const char*)g.Bt + (size_t)(u).pn * tstep; pa = _sw ? _b : _a; pb = _sw ? _a : _b; } while (0)
    Unit cur, nxt; int ui = 0;
    if (!S.next(0, cur)) return;
    f32x4 acc[2][2][4][2];
#pragma unroll
    for (int a = 0; a < 2; ++a)
#pragma unroll
        for (int b = 0; b < 2; ++b)
#pragma unroll
            for (int m = 0; m < 4; ++m)
#pragma unroll
                for (int n = 0; n < 2; ++n) acc[a][b][m][n] = (f32x4){0.f, 0.f, 0.f, 0.f};
    bf16x8 At[4][2], B0[2][2], B1[2][2];
    const char* cA; const char* cB; PG8_PTRS(cur, cA, cB);
    PG8_STAGE(PG8_SB(0, 0), cB, voffB); PG8_STAGE(PG8_SB(0, 1), cB + hstep, voffB); PG8_STAGE(PG8_SA(0, 0), cA, voffA); PG8_STAGE(PG8_SA(0, 1), cA + hstep, voffA);
    if (wr == 1) PG8_BAR;
    PG8_WAIT_V(2); PG8_BAR;
    PG8_STAGE(PG8_SB(1, 0), cB + kstep, voffB); PG8_STAGE(PG8_SA(1, 0), cA + kstep, voffA); PG8_STAGE(PG8_SB(1, 1), cB + hstep + kstep, voffB);
    PG8_WAIT_V(6); PG8_BAR;
    for (;;) {
        const bool has_next = S.next(ui + 1, nxt);
        const char* nA = cA; const char* nB = cB; if (has_next) { PG8_PTRS(nxt, nA, nB); }
        for (int t = 0; t < nt; t += 2) {
            const bool last = (t == nt - 2);
            const char* a1 = cA + (size_t)(t + 1) * kstep;
            const char* a2 = last ? nA : cA + (size_t)(t + 2) * kstep; const char* b2 = last ? nB : cB + (size_t)(t + 2) * kstep;
            const char* a3 = a2 + kstep; const char* b3 = b2 + kstep;
            PG8_LDB(B0, 0, 0); PG8_LDB(B1, 0, 1); PG8_SCHED; PG8_LDA(At, 0, 0); PG8_STAGE(PG8_SA(1, 1), a1 + hstep, voffA);
            PG8_WAIT_V(8); PG8_WAIT_L(0); PG8_BAR; PG8_MMA(0, 0, At, B0); PG8_MMA(0, 1, At, B1); PG8_BAR; PG8_SCHED;
            PG8_LDA(At, 0, 1); PG8_STAGE(PG8_SB(0, 0), b2, voffB); PG8_STAGE(PG8_SB(0, 1), b2 + hstep, voffB); PG8_STAGE(PG8_SA(0, 0), a2, voffA);
            PG8_WAIT_V(8); PG8_WAIT_L(0); PG8_BAR; PG8_MMA(1, 0, At, B0); PG8_MMA(1, 1, At, B1); PG8_BAR; PG8_SCHED;
            PG8_LDB(B0, 1, 0); PG8_LDB(B1, 1, 1); PG8_SCHED; PG8_LDA(At, 1, 0); PG8_STAGE(PG8_SA(0, 1), a2 + hstep, voffA);
            PG8_WAIT_V(8); PG8_WAIT_L(0); PG8_BAR; PG8_MMA(0, 0, At, B0); PG8_MMA(0, 1, At, B1); PG8_BAR; PG8_SCHED;
            PG8_LDA(At, 1, 1); PG8_STAGE(PG8_SB(1, 0), b3, voffB); PG8_STAGE(PG8_SB(1, 1), b3 + hstep, voffB); PG8_STAGE(PG8_SA(1, 0), a3, voffA);
            PG8_WAIT_V(8); PG8_WAIT_L(0); PG8_BAR; PG8_MMA(1, 0, At, B0); PG8_MMA(1, 1, At, B1); PG8_BAR; PG8_SCHED;
        }
        if constexpr (ALIGN_EPI) { if (wr == 0) PG8_BAR; }
        if constexpr (Epi::FUSED) E.fused(acc, cur, wr, wc, fr, fq, lds, wid, lane); else E(acc, cur, wr, wc, fr, fq);
        if (!has_next) break;
#pragma unroll
        for (int a = 0; a < 2; ++a)
#pragma unroll
            for (int b = 0; b < 2; ++b)
#pragma unroll
                for (int m = 0; m < 4; ++m)
#pragma unroll
                    for (int n = 0; n < 2; ++n) acc[a][b][m][n] = (f32x4){0.f, 0.f, 0.f, 0.f};
        cur = nxt; cA = nA; cB = nB; ++ui;
        if constexpr (ALIGN_EPI) { if (wr == 1) PG8_BAR; }
    }
    PG8_WAIT_V(0);
    if constexpr (!ALIGN_EPI) { if (wr == 0) PG8_BAR; }
    PG8_BAR;
#undef PG8_SA
#undef PG8_SB
#undef PG8_STAGE
#undef PG8_LDA
#undef PG8_LDB
#undef PG8_MMA
#undef PG8_WAIT_V
#undef PG8_WAIT_L
#undef PG8_BAR
#undef PG8_SCHED
#undef PG8_PTRS
}
}

#define XB_TMO      128
#define XB_XCNT(j)  (256  + 64 * (j))
#define XB_XSUB(j)  (1280 + 64 * (j))
#define XB_XGEN(j)  (2304 + 64 * (j))
#define XB_TOP      3328
#define XB_TOPGEN   3392
#define XCD_BAR_WORDS 3456
#define XB_SPIN_CAP (1u << 18)
__device__ __forceinline__ unsigned xb_ld(unsigned* p)              { return __hip_atomic_load(p, __ATOMIC_RELAXED, __HIP_MEMORY_SCOPE_AGENT); }
__device__ __forceinline__ unsigned xb_add(unsigned* p, unsigned v) { return __hip_atomic_fetch_add(p, v, __ATOMIC_RELAXED, __HIP_MEMORY_SCOPE_AGENT); }
__device__ __forceinline__ unsigned xb_xcc_id() { return (unsigned)__builtin_amdgcn_s_getreg((3 << 11) | 20) & 0xFu; }
#define XB_SPIN(cond, bar) do { unsigned _sp = 0; while (cond) { __builtin_amdgcn_s_sleep(1); \
    if ((++_sp & 255u) == 0u) { if (xb_ld(&(bar)[XB_TMO])) break; if (_sp > XB_SPIN_CAP) { atomicAdd(&(bar)[XB_TMO], 1u); break; } } } } while (0)
struct XcdBarrier { unsigned* bar; unsigned x; volatile LAS unsigned* st; };
__device__ __forceinline__ XcdBarrier xcd_barrier_post(unsigned* bar, volatile LAS unsigned* st) {
    XcdBarrier b; b.bar = bar; b.x = xb_xcc_id(); b.st = st;
    if (threadIdx.x == 0) (void)xb_add(&bar[XB_XCNT(b.x)], 1u);
    return b;
}
__device__ __forceinline__ void xcd_barrier_complete(unsigned* bar, unsigned x, unsigned& nloc, unsigned& nx) {
    const unsigned G = gridDim.x * gridDim.y * gridDim.z;
    unsigned sum, cnt, mine, sp = 0u;
    for (;;) {
        sum = 0u; cnt = 0u; mine = 0u;
#pragma unroll
        for (unsigned j = 0; j < 16; ++j) { const unsigned c = xb_ld(&bar[XB_XCNT(j)]); sum += c; cnt += (c > 0u) ? 1u : 0u; mine = (j == x) ? c : mine; }
        if (sum == G) break;
        __builtin_amdgcn_s_sleep(1);
        if ((++sp & 255u) == 0u) { if (xb_ld(&bar[XB_TMO])) break; if (sp > XB_SPIN_CAP) { atomicAdd(&bar[XB_TMO], 1u); break; } }
    }
    nloc = mine > 0u ? mine : 1u; nx = cnt > 0u ? cnt : 1u;
}
__device__ __forceinline__ void xcd_barrier(const XcdBarrier& b) {
    asm volatile("s_waitcnt vmcnt(0)" ::: "memory");
    __syncthreads();
    if (threadIdx.x == 0) {
        unsigned* bar = b.bar;
        __builtin_amdgcn_s_waitcnt(0);
        unsigned nloc = b.st[0], nx = b.st[1];
        if (nloc == 0u) { xcd_barrier_complete(bar, b.x, nloc, nx); b.st[0] = nloc; b.st[1] = nx; }
        const unsigned old = xb_add(&bar[XB_XSUB(b.x)], 1u);
        const unsigned gen = old / nloc;
        if (old + 1u == (gen + 1u) * nloc) {
            __builtin_amdgcn_fence(__ATOMIC_RELEASE, "agent");
            asm volatile("s_waitcnt vmcnt(0)" ::: "memory");
            const unsigned og = xb_add(&bar[XB_TOP], 1u);
            const unsigned tg = og / nx;
            if (og + 1u == (tg + 1u) * nx) xb_add(&bar[XB_TOPGEN], 1u);
            else XB_SPIN(xb_ld(&bar[XB_TOPGEN]) == tg, bar);
            __builtin_amdgcn_fence(__ATOMIC_ACQUIRE, "agent");
            xb_add(&bar[XB_XGEN(b.x)], 1u);
            asm volatile("s_waitcnt vmcnt(0)" ::: "memory");
        } else {
            XB_SPIN(xb_ld(&bar[XB_XGEN(b.x)]) == gen, bar);
            __builtin_amdgcn_fence(__ATOMIC_ACQUIRE, "agent");
            asm volatile("s_waitcnt vmcnt(0)" ::: "memory");
        }
    }
    __syncthreads();
}

__device__ __forceinline__ unsigned f2bf(float f) { unsigned u = __builtin_bit_cast(unsigned, f); return (u + 0x7fffu + ((u >> 16) & 1u)) >> 16; }
__device__ __forceinline__ unsigned pk2(float lo, float hi) { return f2bf(lo) | (f2bf(hi) << 16); }
__device__ __forceinline__ float bflo(unsigned w) { return __builtin_bit_cast(float, w << 16); }
__device__ __forceinline__ float bfhi(unsigned w) { return __builtin_bit_cast(float, w & 0xffff0000u); }
__device__ __forceinline__ float wave_sum(float v) {
#pragma unroll
    for (int o = 1; o < 64; o <<= 1) v += __shfl_xor(v, o);
    return v;
}

__device__ __forceinline__ void transpose_item(const float* W, int N, bf16_t* WT, int ldw, LAS float* scr, int kb, int nb, int lane) {
    const int k0 = 64 * kb, n0 = 32 * nb;
#pragma unroll 8
    for (int i = 0; i < 32; ++i) { const int kk = 2 * i + (lane >> 5); scr[kk * 33 + (lane & 31)] = W[(size_t)(k0 + kk) * N + n0 + (lane & 31)]; }
    asm volatile("s_waitcnt lgkmcnt(0)" ::: "memory");
    const int c = lane & 7;
#pragma unroll
    for (int j = 0; j < 4; ++j) { const int n = (lane >> 3) + 8 * j; const LAS float* s = scr + (8 * c) * 33 + n;
        u32x4 o; o.x = pk2(s[0 * 33], s[1 * 33]); o.y = pk2(s[2 * 33], s[3 * 33]); o.z = pk2(s[4 * 33], s[5 * 33]); o.w = pk2(s[6 * 33], s[7 * 33]);
        *(u32x4*)(WT + (size_t)(n0 + n) * ldw + k0 + 8 * c) = o; }
    asm volatile("s_waitcnt lgkmcnt(0)" ::: "memory");
}

struct Args {
    const float *x, *c, *ln_in_g, *ln_in_b, *w_ada, *b_ada, *w_in, *rpb, *w_pool, *pool_scale, *w_out, *ln1_g, *ln1_b, *w_mlp1, *w_mlp2, *ln2_g, *ln2_b;
    float* out; unsigned char* ws; int ph_lo, ph_hi;
};

__device__ __forceinline__ void p0_prologue(const Args& a, LAS unsigned char* lds, int G, int bid, int tid) {
    asm volatile("" : "+v"(tid));
    const int lane = tid & 63, wave = tid >> 6;
    unsigned char* ws = a.ws;
    float* mod = (float*)(ws + WS_MOD);
    for (int item = bid; item < 2 * (NMOD / 64); item += G) {
        const int l = item / (NMOD / 64), n0 = (item % (NMOD / 64)) * 64;
        LAS float* cact = (LAS float*)lds;
        LAS float* red = (LAS float*)(lds + 65536);
        for (int i = tid; i < BATCH * D; i += 512) { const int b = i >> 10, k = i & 1023; const float v = a.c[i]; cact[k * 16 + b] = v / (1.0f + expf(-v)); }
        __syncthreads();
        const int ks = tid >> 6, col = tid & 63;
        float acc[16];
#pragma unroll
        for (int b = 0; b < 16; ++b) acc[b] = 0.f;
        const float* wp = a.w_ada + (size_t)l * D * NMOD + (size_t)(ks * 128) * NMOD + n0 + col;
#pragma unroll 4
        for (int kk = 0; kk < 128; ++kk) {
            const float w = wp[(size_t)kk * NMOD];
            const LAS f32x4* cp = (const LAS f32x4*)(cact + (ks * 128 + kk) * 16);
#pragma unroll
            for (int q = 0; q < 4; ++q) { const f32x4 cv = cp[q]; acc[4 * q + 0] += cv.x * w; acc[4 * q + 1] += cv.y * w; acc[4 * q + 2] += cv.z * w; acc[4 * q + 3] += cv.w * w; }
        }
#pragma unroll
        for (int b = 0; b < 16; ++b) red[(ks * 16 + b) * 64 + col] = acc[b];
        __syncthreads();
        for (int o = tid; o < 1024; o += 512) { const int b = o >> 6, cc = o & 63; float s = 0.f;
#pragma unroll
            for (int k8 = 0; k8 < 8; ++k8) s += red[(k8 * 16 + b) * 64 + cc];
            mod[(size_t)(l * 16 + b) * NMOD + n0 + cc] = s + a.b_ada[l * NMOD + n0 + cc]; }
        __syncthreads();
    }
    for (int idx = bid * 512 + tid; idx < 2 * 4 * 16 * 1024; idx += G * 512) {
        const int l = idx >> 16, g = (idx >> 14) & 3, cch = (idx >> 10) & 15, n = idx & 1023;
        const float* wo = a.w_out + (size_t)l * D * D + (size_t)(512 + g * 128) * D + n;
        const float* wpl = a.w_pool + ((size_t)(l * 4 + g) * 128 + cch * 8) * 128;
        const float* ps = a.pool_scale + l * 512 + g * 128;
        float acc[8];
#pragma unroll
        for (int i = 0; i < 8; ++i) acc[i] = 0.f;
#pragma unroll 4
        for (int d = 0; d < 128; ++d) { const float v = wo[(size_t)d * D] * ps[d];
#pragma unroll
            for (int i = 0; i < 8; ++i) acc[i] += wpl[i * 128 + d] * v; }
        u32x4 o; o.x = pk2(acc[0], acc[1]); o.y = pk2(acc[2], acc[3]); o.z = pk2(acc[4], acc[5]); o.w = pk2(acc[6], acc[7]);
        *(u32x4*)((bf16_t*)(ws + WS_WOUT) + (size_t)l * D * D + (size_t)n * D + 512 + g * 128 + cch * 8) = o;
    }
    {
        LAS float* scr = (LAS float*)(lds + wave * 16384);
        const int gw = bid * 8 + wave, NGW = G * 8;
        constexpr int I_IN = 16 * 64, I_OUT = 8 * 32, I_1 = 16 * 128, I_2 = 64 * 32, I_L = I_IN + I_OUT + I_1 + I_2;
        for (int it = gw; it < 2 * I_L; it += NGW) {
            const int l = it / I_L; int r = it % I_L;
            if (r < I_IN) { transpose_item(a.w_in + (size_t)l * D * PROJ, PROJ, (bf16_t*)(ws + WS_WIN) + (size_t)l * PROJ * D, D, scr, r / 64, r % 64, lane); continue; } r -= I_IN;
            if (r < I_OUT) { transpose_item(a.w_out + (size_t)l * D * D, D, (bf16_t*)(ws + WS_WOUT) + (size_t)l * D * D, D, scr, r / 32, r % 32, lane); continue; } r -= I_OUT;
            if (r < I_1) { transpose_item(a.w_mlp1 + (size_t)l * D * FF, FF, (bf16_t*)(ws + WS_W1) + (size_t)l * FF * D, D, scr, r / 128, r % 128, lane); continue; } r -= I_1;
            transpose_item(a.w_mlp2 + (size_t)l * FF * D, D, (bf16_t*)(ws + WS_W2) + (size_t)l * D * FF, FF, scr, r / 32, r % 32, lane);
        }
    }
}

template <bool SRC_BF16, bool OUT_F32>
__device__ __forceinline__ void ln_phase(const void* srcv, float* dstF, bf16_t* dstH, const float* g, const float* bt, const float* sc, const float* sh, int G, int bid, int tid) {
    asm volatile("" : "+v"(tid));
    const int lane = tid & 63, wave = tid >> 6;
    const int gw = bid * 8 + wave, NGW = G * 8;
    const int rpw = (((M + NGW - 1) / NGW) + 3) & ~3;
    const int r0 = gw * rpw, r1 = (r0 + rpw < M) ? r0 + rpw : M;
    if (r0 >= M) return;
    const int c0 = 8 * lane;
    f32x4 gv[4], bv[4], scv[4], shv[4];
#pragma unroll
    for (int j = 0; j < 4; ++j) { const int cj = c0 + (j >> 1) * 512 + (j & 1) * 4; gv[j] = *(const f32x4*)(g + cj); bv[j] = *(const f32x4*)(bt + cj); scv[j] = (f32x4){1.f, 1.f, 1.f, 1.f}; shv[j] = (f32x4){0.f, 0.f, 0.f, 0.f}; }
    int curb = -1;
    for (int r = r0; r < r1; r += 4) {
        f32x4 nf[4][4]; u32x4 nb[4][2];
#pragma unroll
        for (int q = 0; q < 4; ++q) {
            if (SRC_BF16) { const bf16_t* p = (const bf16_t*)srcv + (size_t)(r + q) * D + c0; nb[q][0] = *(const u32x4*)p; nb[q][1] = *(const u32x4*)(p + 512); }
            else { const float* p = (const float*)srcv + (size_t)(r + q) * D + c0; nf[q][0] = *(const f32x4*)p; nf[q][1] = *(const f32x4*)(p + 4); nf[q][2] = *(const f32x4*)(p + 512); nf[q][3] = *(const f32x4*)(p + 516); }
        }
        const int b = r >> 12;
        if (!OUT_F32 && b != curb) { curb = b;
#pragma unroll
            for (int j = 0; j < 4; ++j) { const int cj = c0 + (j >> 1) * 512 + (j & 1) * 4; scv[j] = *(const f32x4*)(sc + (size_t)b * NMOD + cj) + 1.0f; shv[j] = *(const f32x4*)(sh + (size_t)b * NMOD + cj); } }
#pragma unroll
        for (int q = 0; q < 4; ++q) {
            f32x4 v[4];
            if (SRC_BF16) {
#pragma unroll
                for (int t = 0; t < 2; ++t) { const u32x4 w = nb[q][t]; v[2 * t].x = bflo(w.x); v[2 * t].y = bfhi(w.x); v[2 * t].z = bflo(w.y); v[2 * t].w = bfhi(w.y); v[2 * t + 1].x = bflo(w.z); v[2 * t + 1].y = bfhi(w.z); v[2 * t + 1].z = bflo(w.w); v[2 * t + 1].w = bfhi(w.w); }
            } else {
#pragma unroll
                for (int j = 0; j < 4; ++j) v[j] = nf[q][j];
            }
            float s = 0.f;
#pragma unroll
            for (int j = 0; j < 4; ++j) s += (v[j].x + v[j].y) + (v[j].z + v[j].w);
            const float mean = wave_sum(s) * (1.f / D); float s2 = 0.f;
#pragma unroll
            for (int j = 0; j < 4; ++j) { v[j] = v[j] - mean; s2 += (v[j].x * v[j].x + v[j].y * v[j].y) + (v[j].z * v[j].z + v[j].w * v[j].w); }
            const float rstd = 1.f / sqrtf(wave_sum(s2) * (1.f / D) + LN_EPS);
#pragma unroll
            for (int j = 0; j < 4; ++j) v[j] = v[j] * rstd * gv[j] + bv[j];
            if (OUT_F32) { float* p = dstF + (size_t)(r + q) * D + c0; *(f32x4*)p = v[0]; *(f32x4*)(p + 4) = v[1]; *(f32x4*)(p + 512) = v[2]; *(f32x4*)(p + 516) = v[3]; }
            else {
#pragma unroll
                for (int j = 0; j < 4; ++j) v[j] = v[j] * scv[j] + shv[j];
                bf16_t* p = dstH + (size_t)(r + q) * D + c0;
                u32x4 w0, w1; w0.x = pk2(v[0].x, v[0].y); w0.y = pk2(v[0].z, v[0].w); w0.z = pk2(v[1].x, v[1].y); w0.w = pk2(v[1].z, v[1].w);
                w1.x = pk2(v[2].x, v[2].y); w1.y = pk2(v[2].z, v[2].w); w1.z = pk2(v[3].x, v[3].y); w1.w = pk2(v[3].z, v[3].w);
                *(u32x4*)p = w0; *(u32x4*)(p + 512) = w1;
            }
        }
    }
}

__device__ __forceinline__ void add8(float (&s)[8], const u32x4 w) { s[0] += bflo(w.x); s[1] += bfhi(w.x); s[2] += bflo(w.y); s[3] += bfhi(w.y); s[4] += bflo(w.z); s[5] += bfhi(w.z); s[6] += bflo(w.w); s[7] += bfhi(w.w); }
__device__ __forceinline__ void sub8(float (&s)[8], const u32x4 w) { s[0] -= bflo(w.x); s[1] -= bfhi(w.x); s[2] -= bflo(w.y); s[3] -= bfhi(w.y); s[4] -= bflo(w.z); s[5] -= bfhi(w.z); s[6] -= bflo(w.w); s[7] -= bfhi(w.w); }
template <int W>
__device__ __forceinline__ void pool_lane(const bf16_t* Ubc  , bf16_t* catc  , int T0) {
    constexpr int HW = W / 2, NL = 8 + W - 1;
    u32x4 raw[NL];
#pragma unroll
    for (int k = 0; k < NL; ++k) { const int tk = T0 - HW + k; const int tc = tk < 0 ? 0 : (tk > SEQ - 1 ? SEQ - 1 : tk); u32x4 v = *(const u32x4*)(Ubc + (size_t)tc * AW);
        if (tk != tc) v = (u32x4){0u, 0u, 0u, 0u}; raw[k] = v; }
    float sm[8];
#pragma unroll
    for (int e = 0; e < 8; ++e) sm[e] = 0.f;
#pragma unroll
    for (int k = 0; k < W; ++k) add8(sm, raw[k]);
#pragma unroll
    for (int o = 0; o < 8; ++o) {
        int lo = T0 + o - HW, hi = lo + W; lo = lo < 0 ? 0 : lo; hi = hi > SEQ ? SEQ : hi; const float ic = 1.0f / (float)(hi - lo);
        const u32x4 c = raw[o + HW];
        u32x4 w; w.x = pk2(sm[0] * ic - bflo(c.x), sm[1] * ic - bfhi(c.x)); w.y = pk2(sm[2] * ic - bflo(c.y), sm[3] * ic - bfhi(c.y));
        w.z = pk2(sm[4] * ic - bflo(c.z), sm[5] * ic - bfhi(c.z)); w.w = pk2(sm[6] * ic - bflo(c.w), sm[7] * ic - bfhi(c.w));
        *(u32x4*)(catc + (size_t)(T0 + o) * D) = w;
        if (o < 7) { add8(sm, raw[o + W]); sub8(sm, raw[o]); }
    }
}
__device__ __forceinline__ void attn_pool_phase(LAS unsigned char* lds, const bf16_t* Qb, const bf16_t* Kb, const bf16_t* Vt, const bf16_t* Ub, bf16_t* cat, const float* rpb_l, int G, int bid, int tid, int mode = 0) {
    asm volatile("" : "+v"(tid));
    LAS float* tab = (LAS float*)lds;
    for (int i = tid; i < NHEAD * RPB_H * 64; i += 512) { const int c = (i & 63) - 16, hr = i >> 6; tab[i] = (c >= 0 && c < RPB_W) ? rpb_l[hr * RPB_W + c] * LOG2E : 0.f; }
    __syncthreads();
    const int lane = tid & 63, h = __builtin_amdgcn_readfirstlane(tid >> 6), q16 = lane & 15, g4 = lane >> 4;
    const LAS float* tabh = tab + h * (RPB_H * 64) + 16;
    const bool xl = (G == 256); const int nun = xl ? 4 : (BATCH * 64 + G - 1) / G;
    for (int k = 0; k < nun; ++k) {
        const int unit = xl ? ((bid & 7) * 128 + k * 32 + (bid >> 3)) : (bid + k * G);
        if (unit >= BATCH * 64) break;
        const int b = unit >> 6, r = unit & 63; const int rs = r < 4 ? 0 : (r > 60 ? 56 : r - 4);
        const size_t tok0 = (size_t)b * SEQ + r * 64;
#pragma unroll 1
        for (int j = 0; j < ((mode & 2) ? 0 : 4); ++j) {
            const int cb = (j == 0) ? 0 : (j == 1) ? 8 : (j == 2) ? 24 : 32;
            const int qc = 16 * j + q16; const int cs = qc < 8 ? 0 : (qc > 56 ? 48 : qc - 8);
            const int tb0 = cb + g4 * 8 - qc + 15;
            const int vlo = cs - (cb + g4 * 8);
            const size_t cbase = ((size_t)(b * 8 + h) * 8 + g4) * SEQ;
            const bf16_t* qp = Qb + (cbase + r * 64 + qc) * 8;
            const bf16x8 q0 = *(const bf16x8*)qp, q1 = *(const bf16x8*)(qp + (size_t)4 * SEQ * 8);
            bf16x8 kf[8][2][2];
            const bf16_t* kbase = Kb + (cbase + rs * 64 + cb + (q16 >> 2) * 8 + (q16 & 3)) * 8;
#pragma unroll
            for (int i = 0; i < 8; ++i)
#pragma unroll
                for (int hh = 0; hh < 2; ++hh) { const bf16_t* kp = kbase + (size_t)(i * 64 + hh * 4) * 8; kf[i][hh][0] = *(const bf16x8*)kp; kf[i][hh][1] = *(const bf16x8*)(kp + (size_t)4 * SEQ * 8); }
            __builtin_amdgcn_sched_barrier(0);
            f32x4 s[8][2];
            float mx = -1e30f;
#pragma unroll
            for (int i = 0; i < 8; ++i)
#pragma unroll
                for (int hh = 0; hh < 2; ++hh) {
                    f32x4 acc = (f32x4){0.f, 0.f, 0.f, 0.f};
                    acc = __builtin_amdgcn_mfma_f32_16x16x32_bf16(kf[i][hh][0], q0, acc, 0, 0, 0);
                    acc = __builtin_amdgcn_mfma_f32_16x16x32_bf16(kf[i][hh][1], q1, acc, 0, 0, 0);
                    const LAS float* trow = tabh + (rs + i - r + 7) * 64 + tb0 + hh * 4;
#pragma unroll
                    for (int jj = 0; jj < 4; ++jj) {
                        const float bv = trow[jj];
                        const bool valid = (unsigned)(hh * 4 + jj - vlo) < 16u;
                        const float sv = valid ? acc[jj] + bv : -1e30f;
                        acc[jj] = sv; mx = fmaxf(mx, sv);
                    }
                    s[i][hh] = acc;
                }
            bf16x8 vf[8][4];
            const bf16_t* vbase = Vt + (((size_t)(b * 8 + h) * (SEQ / 8) + (rs * 64 + cb) / 8 + g4) * 64 + q16) * 8;
#pragma unroll
            for (int i = 0; i < 8; ++i)
#pragma unroll
                for (int db = 0; db < 4; ++db) vf[i][db] = *(const bf16x8*)(vbase + (size_t)i * 8 * 512 + db * 128);
            __builtin_amdgcn_sched_barrier(0);
            mx = fmaxf(mx, __shfl_xor(mx, 16)); mx = fmaxf(mx, __shfl_xor(mx, 32));
            float sum = 0.f;
            u32x4 pw[8];
#pragma unroll
            for (int i = 0; i < 8; ++i) {
#pragma unroll
                for (int hh = 0; hh < 2; ++hh)
#pragma unroll
                    for (int jj = 0; jj < 4; ++jj) { const float p = __builtin_amdgcn_exp2f(s[i][hh][jj] - mx); s[i][hh][jj] = p; sum += p; }
                pw[i].x = pg8::cvt_pk_bf16(s[i][0][0], s[i][0][1]); pw[i].y = pg8::cvt_pk_bf16(s[i][0][2], s[i][0][3]); pw[i].z = pg8::cvt_pk_bf16(s[i][1][0], s[i][1][1]); pw[i].w = pg8::cvt_pk_bf16(s[i][1][2], s[i][1][3]);
            }
            sum += __shfl_xor(sum, 16); sum += __shfl_xor(sum, 32);
            f32x4 o[4];
#pragma unroll
            for (int db = 0; db < 4; ++db) o[db] = (f32x4){0.f, 0.f, 0.f, 0.f};
#pragma unroll
            for (int i = 0; i < 8; ++i) {
                const bf16x8 pf = __builtin_bit_cast(bf16x8, pw[i]);
#pragma unroll
                for (int db = 0; db < 4; ++db) o[db] = __builtin_amdgcn_mfma_f32_16x16x32_bf16(vf[i][db], pf, o[db], 0, 0, 0);
            }
            const float inv = 1.0f / sum;
            bf16_t* op = cat + (tok0 + qc) * D + h * 64 + g4 * 4;
#pragma unroll
            for (int db = 0; db < 4; ++db) { u32x2 w; w.x = pg8::cvt_pk_bf16(o[db][0] * inv, o[db][1] * inv); w.y = pg8::cvt_pk_bf16(o[db][2] * inv, o[db][3] * inv); *(u32x2*)(op + db * 16) = w; }
        }
        if (!(mode & 1)) {
            const int gidx = h & 3, hfl = h >> 2; const int T0 = r * 64 + hfl * 32 + g4 * 8; const int chan = gidx * 128 + q16 * 8;
            const bf16_t* Ubc = Ub + (size_t)b * SEQ * AW + chan; bf16_t* catc = cat + (size_t)b * SEQ * D + 512 + chan;
            if (gidx == 0) pool_lane<2>(Ubc, catc, T0); else if (gidx == 1) pool_lane<4>(Ubc, catc, T0); else if (gidx == 2) pool_lane<8>(Ubc, catc, T0); else pool_lane<16>(Ubc, catc, T0);
        }
    }
}

constexpr int N_PHASES = 2 + 7 * DEPTH;
__global__ void __launch_bounds__(512, 2) fwd_megakernel(Args a) {
    extern __shared__ __attribute__((aligned(16))) unsigned char lds_raw[];
    LAS unsigned char* lds = (LAS unsigned char*)lds_raw;
    cg::grid_group grid = cg::this_grid();
    const int tid = threadIdx.x, bid = blockIdx.x, G = gridDim.x;
    unsigned char* ws = a.ws;
    bf16_t* H = (bf16_t*)(ws + WS_H); bf16_t* F = (bf16_t*)(ws + WS_F);
    bf16_t* Qb = (bf16_t*)(ws + WS_Q); bf16_t* Kb = (bf16_t*)(ws + WS_K); bf16_t* Vt = (bf16_t*)(ws + WS_VT); bf16_t* Ub = (bf16_t*)(ws + WS_U); bf16_t* CAT = (bf16_t*)(ws + WS_CAT);
    const float* mod = (const float*)(ws + WS_MOD);
    const int lo = a.ph_lo, hi = a.ph_hi;
#define IN(k) (lo <= (k) && (k) < hi)
    unsigned* barw = (unsigned*)(ws + WS_CTL);
    volatile LAS unsigned* misc = (volatile LAS unsigned*)(lds + 131072 + 1024);
    if (bid == 0) { for (int i = tid; i < 8192 + 4 * 16384; i += 512) barw[i] = 0u; }
    if (tid < 8) misc[tid] = 0u;
    __syncthreads();
    XcdBarrier xbar; xbar.bar = barw; xbar.x = 0; xbar.st = misc;
    const bool fusedln = (G == 256);
    int vb = bid;
#define SEAM(k) do { if (IN(k) && IN((k) + 1)) { if ((k) == 0) { grid.sync(); xbar = xcd_barrier_post(barw, misc); if (tid == 0) misc[2] = xb_add(&barw[3456 + 64 * xbar.x], 1u); } \
        else { xcd_barrier(xbar); if ((k) == 1) { \
            if (tid == 0) { bool ok = (G % 8 == 0) && xbar.x < 8u; for (int j = 0; j < 8; ++j) ok = ok && (xb_ld(&barw[3456 + 64 * j]) == (unsigned)(G / 8)); misc[3] = ok ? 1u : 0u; } \
            __syncthreads(); if (misc[3]) vb = (int)(misc[2] * 8u + xbar.x); } } } } while (0)

    if (IN(0)) { for (int rep = 0; rep <= PROBE_P0; ++rep) { p0_prologue(a, lds, G, bid, tid); if (rep < PROBE_P0) __syncthreads(); } }
    SEAM(0);
    if (IN(1)) { ln_phase<false, false>(a.x, nullptr, H, a.ln_in_g, a.ln_in_b, mod + 1 * D, mod + 0 * D, G, bid, tid); }
    SEAM(1);
#pragma unroll 1
    for (int l = 0; l < DEPTH; ++l) {
        const int p = 2 + 7 * l;
        const float* modl = mod + (size_t)l * BATCH * NMOD;
        if (IN(p + 0)) {
            pg8::Gemm g{H, (const bf16_t*)(ws + WS_WIN) + (size_t)l * PROJ * D, M, PROJ, D}; pg8::StaticOrder S; S.init(M, PROJ, G, vb);
            pg8::EpiProj E{Qb, Kb, Vt, Ub};
            pg8::gemm_phase<pg8::EpiProj, true>(lds, g, S, E);
        }
        SEAM(p + 0);
        if (IN(p + 1)) { for (int rep = 0; rep <= PROBE_ATT; ++rep) { attn_pool_phase(lds, Qb, Kb, Vt, Ub, CAT, a.rpb + (size_t)l * NHEAD * RPB_N, G, vb, tid, rep == 0 ? 0 : PROBE_MODE); if (rep < PROBE_ATT) xcd_barrier(xbar); } }
        SEAM(p + 1);
        if (IN(p + 2)) {
            pg8::Gemm g{CAT, (const bf16_t*)(ws + WS_WOUT) + (size_t)l * D * D, M, D, D}; pg8::StaticOrder S; S.init(M, D, G, vb);
            if (fusedln) { pg8::PanelStats st{(unsigned long long*)(ws + WS_X) + (size_t)(2 * l) * M * 4, barw + 8192 + (2 * l) * 16384};
                pg8::EpiResLn<false> E{H, nullptr, modl, 0 * D, 1 * D, 2 * D, a.ln1_g + l * D, a.ln1_b + l * D, modl, 3 * D, 4 * D, st};
                pg8::gemm_phase<pg8::EpiResLn<false>, true>(lds, g, S, E); }
            else { pg8::EpiRes E{H, modl, 0 * D, 1 * D, 2 * D};
                pg8::gemm_phase<pg8::EpiRes, true>(lds, g, S, E); }
        }
        SEAM(p + 2);
        if (IN(p + 3) && !fusedln) { ln_phase<true, false>(H, nullptr, H, a.ln1_g + l * D, a.ln1_b + l * D, modl + 4 * D, modl + 3 * D, G, bid, tid); }
        if (!fusedln) SEAM(p + 3);
        if (IN(p + 4)) {
            pg8::Gemm g{H, (const bf16_t*)(ws + WS_W1) + (size_t)l * FF * D, M, FF, D}; pg8::StaticOrder S; S.init(M, FF, G, vb);
            for (int rep = 0; rep <= PROBE_MLP1; ++rep) { pg8::EpiRelu2 E{F, FF, (rep > 0 && PROBE_MLP1_NOSTORE) ? 1 : 0};
                pg8::gemm_phase<pg8::EpiRelu2, true>(lds, g, S, E); if (rep < PROBE_MLP1) xcd_barrier(xbar); }
        }
        SEAM(p + 4);
        if (IN(p + 5)) {
            pg8::Gemm g{F, (const bf16_t*)(ws + WS_W2) + (size_t)l * D * FF, M, D, FF}; pg8::StaticOrder S; S.init(M, D, G, vb);
            const bool lastl2 = (l == DEPTH - 1); const float* modn2 = mod + (size_t)(lastl2 ? l : l + 1) * BATCH * NMOD;
            if (fusedln) { pg8::PanelStats st{(unsigned long long*)(ws + WS_X) + (size_t)(2 * l + 1) * M * 4, barw + 8192 + (2 * l + 1) * 16384};
                if (lastl2) { pg8::EpiResLn<true> E{H, a.out, modl, 3 * D, 4 * D, 5 * D, a.ln2_g + l * D, a.ln2_b + l * D, modn2, 0, 0, st};
                    pg8::gemm_phase<pg8::EpiResLn<true>, true>(lds, g, S, E); }
                else { pg8::EpiResLn<false> E{H, nullptr, modl, 3 * D, 4 * D, 5 * D, a.ln2_g + l * D, a.ln2_b + l * D, modn2, 0 * D, 1 * D, st};
                    pg8::gemm_phase<pg8::EpiResLn<false>, true>(lds, g, S, E); } }
            else { pg8::EpiRes E{H, modl, 3 * D, 4 * D, 5 * D};
                pg8::gemm_phase<pg8::EpiRes, true>(lds, g, S, E); }
        }
        SEAM(p + 5);
        if (IN(p + 6) && !fusedln) {
            const bool lastl = (l == DEPTH - 1);
            const float* modn = mod + (size_t)(lastl ? l : l + 1) * BATCH * NMOD;
            if (lastl) ln_phase<true, true>(H, a.out, nullptr, a.ln2_g + l * D, a.ln2_b + l * D, modn, modn, G, bid, tid);
            else ln_phase<true, false>(H, nullptr, H, a.ln2_g + l * D, a.ln2_b + l * D, modn + 1 * D, modn + 0 * D, G, bid, tid);
        }
        if (!fusedln) SEAM(p + 6);
    }
    for (int rep = 0; rep < PROBE_SYNC; ++rep) xcd_barrier(xbar);
#undef IN
#undef SEAM
}

extern "C" void kernel_launch(void* const* d_in, const int* in_sizes, int n_in, void* d_out, int out_size, void* d_ws, size_t ws_size, hipStream_t stream) {
    static int grid = 0;
    if (grid == 0) {
        if (n_in != 17 || in_sizes[0] != M * D || out_size != M * D || ws_size < WS_END) { fprintf(stderr, "kernel_launch: unexpected shapes / workspace (n_in %d, in0 %d, out %d, ws %zu)\n", n_in, n_in > 0 ? in_sizes[0] : -1, out_size, ws_size); grid = -1; return; }
        int dev = 0, cus = 0, per_cu = 0;
        hipGetDevice(&dev); hipDeviceGetAttribute(&cus, hipDeviceAttributeMultiprocessorCount, dev);
        if (hipFuncSetAttribute((const void*)fwd_megakernel, hipFuncAttributeMaxDynamicSharedMemorySize, LDS_BYTES) != hipSuccess) { fprintf(stderr, "kernel_launch: hipFuncSetAttribute failed\n"); grid = -1; return; }
        if (hipOccupancyMaxActiveBlocksPerMultiprocessor(&per_cu, (const void*)fwd_megakernel, 512, LDS_BYTES) != hipSuccess || per_cu < 1) { per_cu = 1; (void)hipGetLastError(); }
        grid = (cus > 0 ? cus : 256) * per_cu;
    }
    if (grid < 0) return;
    Args a{};
    a.x = (const float*)d_in[0]; a.c = (const float*)d_in[1]; a.ln_in_g = (const float*)d_in[2]; a.ln_in_b = (const float*)d_in[3]; a.w_ada = (const float*)d_in[4]; a.b_ada = (const float*)d_in[5];
    a.w_in = (const float*)d_in[6]; a.rpb = (const float*)d_in[7]; a.w_pool = (const float*)d_in[8]; a.pool_scale = (const float*)d_in[9]; a.w_out = (const float*)d_in[10];
    a.ln1_g = (const float*)d_in[11]; a.ln1_b = (const float*)d_in[12]; a.w_mlp1 = (const float*)d_in[13]; a.w_mlp2 = (const float*)d_in[14]; a.ln2_g = (const float*)d_in[15]; a.ln2_b = (const float*)d_in[16];
    a.out = (float*)d_out; a.ws = (unsigned char*)d_ws;
#if MK_MULTI
    for (int p = 0; p < N_PHASES; ++p) { a.ph_lo = p; a.ph_hi = p + 1; hipLaunchKernelGGL(fwd_megakernel, dim3(grid), dim3(512), LDS_BYTES, stream, a); }
#else
    a.ph_lo = 0; a.ph_hi = N_PHASES;
    void* args[] = {&a};
    hipError_t e = hipLaunchCooperativeKernel((const void*)fwd_megakernel, dim3(grid), dim3(512), args, LDS_BYTES, stream);
    if (e != hipSuccess) fprintf(stderr, "kernel_launch: cooperative launch failed: %s (grid %d)\n", hipGetErrorString(e), grid);
#endif
}
```

```cpp
#include <hip/hip_runtime.h>
#include <hip/hip_cooperative_groups.h>
#include <cstdio>
#include <cstdint>
namespace cg = cooperative_groups;

#define LAS __attribute__((address_space(3)))
typedef unsigned short bf16_t;
typedef short bf16x8 __attribute__((ext_vector_type(8)));
typedef float f32x4 __attribute__((ext_vector_type(4)));
typedef float f32x2 __attribute__((ext_vector_type(2)));
typedef unsigned u32x4 __attribute__((ext_vector_type(4)));
typedef unsigned u32x2 __attribute__((ext_vector_type(2)));

#ifndef PROBE_ATT
#define PROBE_ATT 0
#endif
#ifndef PROBE_P0
#define PROBE_P0 0
#endif
#ifndef PROBE_MODE
#define PROBE_MODE 0
#endif
#ifndef PROBE_MLP1
#define PROBE_MLP1 0
#endif
#ifndef PROBE_MLP1_HOT
#define PROBE_MLP1_HOT 0
#endif
#ifndef PROBE_MLP1_NOSTORE
#define PROBE_MLP1_NOSTORE 0
#endif
#ifndef PROBE_SYNC
#define PROBE_SYNC 0
#endif
#ifndef MK_MULTI
#define MK_MULTI 0
#endif

constexpr int BATCH = 16, SEQ = 4096, D = 1024, DEPTH = 2, M = BATCH * SEQ;
constexpr int PROJ = 2048, FF = 4096, NMOD = 6 * D, AW = 512;
constexpr int NHEAD = 8;
constexpr float LN_EPS = 1e-5f;
constexpr float DN_ALPHA = 1.41421356237309515f;
constexpr float LOG2E = 1.44269504088896341f;
constexpr float QSCALE = 0.125f * LOG2E;
constexpr int RPB_H = 15, RPB_W = 31, RPB_N = RPB_H * RPB_W;

constexpr size_t MiB = (size_t)1 << 20;
constexpr size_t WS_WIN = 0 * MiB;
constexpr size_t WS_WOUT = 8 * MiB;
constexpr size_t WS_W1 = 12 * MiB;
constexpr size_t WS_W2 = 28 * MiB;
constexpr size_t WS_MOD = 44 * MiB;
constexpr size_t WS_CTL = 46 * MiB;
constexpr size_t WS_X = 48 * MiB;
constexpr size_t WS_H = 304 * MiB;
constexpr size_t WS_F = 432 * MiB;
constexpr size_t WS_Q = 432 * MiB;
constexpr size_t WS_K = 496 * MiB;
constexpr size_t WS_VT = 560 * MiB;
constexpr size_t WS_U = 624 * MiB;
constexpr size_t WS_CAT = 688 * MiB;
constexpr size_t WS_END = 944 * MiB;

constexpr int LDS_BYTES = 147456;

namespace pg8 {
constexpr int BM = 256, BK = 64, HALF = 128, HTB = HALF * BK * 2, STAGE_BYTES = 8 * HTB, NXCD = 8, WGM = 8;
__host__ __device__ __forceinline__ int lds_byte(int r, int c) { const int st = (r >> 4) * 2 + (c >> 5), rr = r & 15, cc = c & 31, ob = rr * 64 + cc * 2; return st * 1024 + (ob ^ (((ob >> 9) & 1) << 5)); }
__host__ __device__ __forceinline__ void stage_rc(int b, int& R, int& C) { const int st = b / 1024, sb = b % 1024, swz = sb ^ (((sb >> 9) & 1) << 5); R = (st >> 1) * 16 + swz / 64; C = (st & 1) * 32 + (swz % 64) / 2; }
__host__ __device__ __forceinline__ int perm32(int rho) { const int n = rho >> 4, i = rho & 15; return 8 * (i >> 2) + 4 * n + (i & 3); }

struct Unit { int pm, pn; };
struct Gemm { const bf16_t* A; const bf16_t* Bt; int M, N, K; };
struct StaticOrder;

struct StaticOrder {
    int nM, nN, nwg, G, c;
    __device__ void init(int M_, int N_, int G_, int c_) { nM = M_ / BM; nN = N_ / BM; nwg = nM * nN; G = G_; c = c_; }
    __device__ bool next(int i, Unit& u) const {
        const long L = (long)i * G + c; if (L >= nwg) return false;
        int wgid = (int)L; { const int q = nwg / NXCD, r = nwg % NXCD, xcd = wgid % NXCD, off = wgid / NXCD; wgid = (xcd < r ? xcd * (q + 1) : r * (q + 1) + (xcd - r) * q) + off; }
        const int nig = WGM * nN, gid = wgid / nig, fm = gid * WGM, gsz = (nM - fm) < WGM ? (nM - fm) : WGM;
        u.pm = fm + ((wgid % nig) % gsz); u.pn = (wgid % nig) / gsz; return true;
    }
};

struct HotOrder : StaticOrder { __device__ bool next(int i, Unit& u) const { const bool r = StaticOrder::next(i, u); u.pm = 0; u.pn = 0; return r; } };
__device__ __forceinline__ unsigned cvt_pk_bf16(float lo, float hi) { unsigned r; asm volatile("v_cvt_pk_bf16_f32 %0, %1, %2" : "=v"(r) : "v"(lo), "v"(hi)); return r; }

struct EpiProj {
    static constexpr bool PERM = true, VSWAP = true, FUSED = false;
    bf16_t* Q; bf16_t* Kb; bf16_t* Vt; bf16_t* U;
    __device__ __forceinline__ void operator()(const f32x4 (&acc)[2][2][4][2], const Unit& u, int wr, int wc, int fr, int fq) const {
        const int t = u.pn >> 1;
        if (t == 2) {
            const int dg0 = (u.pn & 1) * 256 + wr * 64 + fr; const int b = u.pm >> 4; const int s0 = (u.pm & 15) * 256 + wc * 32 + 8 * fq;
#pragma unroll
            for (int ai = 0; ai < 2; ++ai)
#pragma unroll
                for (int m = 0; m < 4; ++m) { const int dg = dg0 + ai * HALF + m * 16;
                    bf16_t* rowp = Vt + ((size_t)(b * 8 + (dg >> 6)) * (SEQ / 8) + (s0 >> 3)) * 512 + (dg & 63) * 8;
#pragma unroll
                    for (int bj = 0; bj < 2; ++bj) { const f32x4 v0 = acc[ai][bj][m][0], v1 = acc[ai][bj][m][1];
                        u32x4 w; w.x = cvt_pk_bf16(v0[0], v0[1]); w.y = cvt_pk_bf16(v0[2], v0[3]); w.z = cvt_pk_bf16(v1[0], v1[1]); w.w = cvt_pk_bf16(v1[2], v1[3]);
                        __builtin_nontemporal_store(w, (u32x4*)(rowp + (size_t)bj * (HALF / 8) * 512)); } }
        } else {
            bf16_t* base = Q + (size_t)t * ((size_t)M * AW); const float sc = t == 0 ? QSCALE : 1.0f;
            const int row0 = u.pm * BM + wr * 64 + fr, col0 = (u.pn & 1) * 256 + wc * 32 + 8 * fq;
            const bool cm = t < 2; const int bq = u.pm >> 4;
#pragma unroll
            for (int ai = 0; ai < 2; ++ai)
#pragma unroll
                for (int m = 0; m < 4; ++m) { const int row = row0 + ai * HALF + m * 16;
                    bf16_t* rowp = cm ? base + ((size_t)(bq * 64 + (col0 >> 3)) * SEQ + (row & (SEQ - 1))) * 8 : base + (size_t)row * AW + col0;
                    const size_t bjs = cm ? (size_t)(HALF / 8) * SEQ * 8 : (size_t)HALF;
#pragma unroll
                    for (int bj = 0; bj < 2; ++bj) { const f32x4 v0 = acc[ai][bj][m][0] * sc, v1 = acc[ai][bj][m][1] * sc;
                        u32x4 w; w.x = cvt_pk_bf16(v0[0], v0[1]); w.y = cvt_pk_bf16(v0[2], v0[3]); w.z = cvt_pk_bf16(v1[0], v1[1]); w.w = cvt_pk_bf16(v1[2], v1[3]);
                        __builtin_nontemporal_store(w, (u32x4*)(rowp + bj * bjs)); } }
        }
    }
};
struct EpiRelu2 {
    static constexpr bool PERM = true, VSWAP = false, FUSED = false;
    bf16_t* O; int ldc; int nostore;
    __device__ __forceinline__ void operator()(const f32x4 (&acc)[2][2][4][2], const Unit& u, int wr, int wc, int fr, int fq) const {
        if (nostore) return;
        const int row0 = u.pm * BM + wr * 64 + fr, col0 = u.pn * BM + wc * 32 + 8 * fq;
#pragma unroll
        for (int ai = 0; ai < 2; ++ai)
#pragma unroll
            for (int m = 0; m < 4; ++m) { bf16_t* rowp = O + (size_t)(row0 + ai * HALF + m * 16) * ldc + col0;
#pragma unroll
                for (int bj = 0; bj < 2; ++bj) { f32x4 v0 = acc[ai][bj][m][0], v1 = acc[ai][bj][m][1];
#pragma unroll
                    for (int j = 0; j < 4; ++j) { const float a = fmaxf(v0[j], 0.f), b = fmaxf(v1[j], 0.f); v0[j] = a * a; v1[j] = b * b; }
                    u32x4 w; w.x = cvt_pk_bf16(v0[0], v0[1]); w.y = cvt_pk_bf16(v0[2], v0[3]); w.z = cvt_pk_bf16(v1[0], v1[1]); w.w = cvt_pk_bf16(v1[2], v1[3]);
                    __builtin_nontemporal_store(w, (u32x4*)(rowp + bj * HALF)); } }
    }
};
struct EpiRes {
    static constexpr bool PERM = true, VSWAP = false, FUSED = false;
    bf16_t* H; const float* mod; int sh_off, sc_off, g_off;
    __device__ __forceinline__ void operator()(const f32x4 (&acc)[2][2][4][2], const Unit& u, int wr, int wc, int fr, int fq) const {
        const int row0 = u.pm * BM + wr * 64 + fr, col0 = u.pn * BM + wc * 32 + 8 * fq; const int b = u.pm >> 4;
        const float* mb = mod + (size_t)b * NMOD + col0;
#pragma unroll
        for (int bj = 0; bj < 2; ++bj) {
            f32x4 shv[2], aiv[2], g1v[2];
#pragma unroll
            for (int n = 0; n < 2; ++n) { shv[n] = *(const f32x4*)(mb + sh_off + bj * HALF + 4 * n); const f32x4 s1 = *(const f32x4*)(mb + sc_off + bj * HALF + 4 * n) + 1.0f;
                aiv[n] = (f32x4){DN_ALPHA / s1.x, DN_ALPHA / s1.y, DN_ALPHA / s1.z, DN_ALPHA / s1.w}; g1v[n] = *(const f32x4*)(mb + g_off + bj * HALF + 4 * n) + 1.0f; }
#pragma unroll
            for (int ai = 0; ai < 2; ++ai) {
                u32x4 hw[4];
#pragma unroll
                for (int m = 0; m < 4; ++m) hw[m] = *(const u32x4*)(H + (size_t)(row0 + ai * HALF + m * 16) * D + col0 + bj * HALF);
#pragma unroll
                for (int m = 0; m < 4; ++m) { const u32x4 w0 = hw[m];
                    f32x4 h0, h1; h0.x = __builtin_bit_cast(float, w0.x << 16); h0.y = __builtin_bit_cast(float, w0.x & 0xffff0000u); h0.z = __builtin_bit_cast(float, w0.y << 16); h0.w = __builtin_bit_cast(float, w0.y & 0xffff0000u);
                    h1.x = __builtin_bit_cast(float, w0.z << 16); h1.y = __builtin_bit_cast(float, w0.z & 0xffff0000u); h1.z = __builtin_bit_cast(float, w0.w << 16); h1.w = __builtin_bit_cast(float, w0.w & 0xffff0000u);
                    const f32x4 z0 = (h0 - shv[0]) * aiv[0] + g1v[0] * acc[ai][bj][m][0], z1 = (h1 - shv[1]) * aiv[1] + g1v[1] * acc[ai][bj][m][1];
                    u32x4 w; w.x = cvt_pk_bf16(z0[0], z0[1]); w.y = cvt_pk_bf16(z0[2], z0[3]); w.z = cvt_pk_bf16(z1[0], z1[1]); w.w = cvt_pk_bf16(z1[2], z1[3]);
                    *(u32x4*)(H + (size_t)(row0 + ai * HALF + m * 16) * D + col0 + bj * HALF) = w; }
                asm volatile("" ::: "memory"); }
        }
    }
};

constexpr int TAB_OFF = 131072 + 2048;
struct PanelStats {
    unsigned long long* xbuf;
    unsigned* cnt;
    __device__ __forceinline__ void run(const f32x4 (&v)[2][2][4][2], const Unit& u, int wr, int wc, int fr, int fq, LAS unsigned char* lds, int wid, int lane) const {
        LAS f32x2* P = (LAS f32x2*)(lds + TAB_OFF);
        LAS f32x2* S = (LAS f32x2*)(lds + TAB_OFF + 8192);
#pragma unroll
        for (int ai = 0; ai < 2; ++ai)
#pragma unroll
            for (int m = 0; m < 4; ++m) {
                float s = 0.f;
#pragma unroll
                for (int bj = 0; bj < 2; ++bj)
#pragma unroll
                    for (int n = 0; n < 2; ++n) { const f32x4 x = v[ai][bj][m][n]; s += (x[0] + x[1]) + (x[2] + x[3]); }
                s += __shfl_xor(s, 16); s += __shfl_xor(s, 32);
                const float mw = s * (1.0f / 64.0f); float q = 0.f;
#pragma unroll
                for (int bj = 0; bj < 2; ++bj)
#pragma unroll
                    for (int n = 0; n < 2; ++n) { const f32x4 d = v[ai][bj][m][n] - mw; q += (d[0] * d[0] + d[1] * d[1]) + (d[2] * d[2] + d[3] * d[3]); }
                q += __shfl_xor(q, 16); q += __shfl_xor(q, 32);
                if (fq == 0) P[(ai * HALF + wr * 64 + m * 16 + fr) * 4 + wc] = (f32x2){mw, q};
            }
        asm volatile("s_waitcnt lgkmcnt(0)" ::: "memory"); __builtin_amdgcn_s_barrier(); asm volatile("" ::: "memory");
        const int row = wid * 32 + (lane & 31);
        if (lane < 32) {
            const f32x2 a = P[row * 4 + 0], b = P[row * 4 + 1], c = P[row * 4 + 2], d = P[row * 4 + 3];
            const float mt = (a.x + b.x + c.x + d.x) * 0.25f;
            const float da = a.x - mt, db = b.x - mt, dc = c.x - mt, dd = d.x - mt;
            const float m2 = (a.y + b.y) + (c.y + d.y) + 64.0f * ((da * da + db * db) + (dc * dc + dd * dd));
            unsigned long long* slot = xbuf + ((size_t)(u.pm * BM + row) * 4 + u.pn);
            __hip_atomic_store(slot, ((unsigned long long)__float_as_uint(m2) << 32) | __float_as_uint(mt), __ATOMIC_RELAXED, __HIP_MEMORY_SCOPE_AGENT);
        }
        asm volatile("s_waitcnt vmcnt(0)" ::: "memory");
        if (lane == 0) __hip_atomic_fetch_add(cnt + 64 * u.pm, 1u, __ATOMIC_RELAXED, __HIP_MEMORY_SCOPE_AGENT);
        if (wid == 0) {
            unsigned sp = 0;
            while ((unsigned)__builtin_amdgcn_readfirstlane(__hip_atomic_load(cnt + 64 * u.pm, __ATOMIC_RELAXED, __HIP_MEMORY_SCOPE_AGENT)) < 32u) { __builtin_amdgcn_s_sleep(2); if (++sp > (1u << 20)) break; }
            __builtin_amdgcn_fence(__ATOMIC_ACQUIRE, "agent");
        }
        asm volatile("s_waitcnt vmcnt(0) lgkmcnt(0)" ::: "memory"); __builtin_amdgcn_s_barrier(); asm volatile("" ::: "memory");
        if (lane < 32) {
            const unsigned long long* slot = xbuf + (size_t)(u.pm * BM + row) * 4; float mt[4], m2[4]; float ms = 0.f;
#pragma unroll
            for (int t = 0; t < 4; ++t) { const unsigned long long w = __hip_atomic_load(slot + t, __ATOMIC_RELAXED, __HIP_MEMORY_SCOPE_AGENT); mt[t] = __uint_as_float((unsigned)w); m2[t] = __uint_as_float((unsigned)(w >> 32)); ms += mt[t]; }
            const float mean = ms * 0.25f; float q = 0.f;
#pragma unroll
            for (int t = 0; t < 4; ++t) { const float dm = mt[t] - mean; q += m2[t] + 256.0f * dm * dm; }
            S[row] = (f32x2){mean, 1.0f / sqrtf(q * (1.0f / 1024.0f) + LN_EPS)};
        }
        asm volatile("s_waitcnt lgkmcnt(0)" ::: "memory"); __builtin_amdgcn_s_barrier(); asm volatile("" ::: "memory");
    }
};
template <bool OUT_F32> struct EpiResLn {
    static constexpr bool PERM = true, VSWAP = false, FUSED = true;
    bf16_t* H; float* outF; const float* mod; int sh_off, sc_off, g_off; const float* lng; const float* lnb; const float* mod2; int sh2_off, sc2_off; PanelStats st;
    __device__ __forceinline__ void fused(f32x4 (&acc)[2][2][4][2], const Unit& u, int wr, int wc, int fr, int fq, LAS unsigned char* lds, int wid, int lane) const {
        const int row0 = u.pm * BM + wr * 64 + fr, col0 = u.pn * BM + wc * 32 + 8 * fq; const int b = u.pm >> 4;
        const float* mb = mod + (size_t)b * NMOD + col0;
#pragma unroll
        for (int bj = 0; bj < 2; ++bj) {
            f32x4 shv[2], aiv[2], g1v[2];
#pragma unroll
            for (int n = 0; n < 2; ++n) { shv[n] = *(const f32x4*)(mb + sh_off + bj * HALF + 4 * n); const f32x4 s1 = *(const f32x4*)(mb + sc_off + bj * HALF + 4 * n) + 1.0f;
                aiv[n] = (f32x4){DN_ALPHA / s1.x, DN_ALPHA / s1.y, DN_ALPHA / s1.z, DN_ALPHA / s1.w}; g1v[n] = *(const f32x4*)(mb + g_off + bj * HALF + 4 * n) + 1.0f; }
#pragma unroll
            for (int ai = 0; ai < 2; ++ai) {
                u32x4 hw[4];
#pragma unroll
                for (int m = 0; m < 4; ++m) hw[m] = *(const u32x4*)(H + (size_t)(row0 + ai * HALF + m * 16) * D + col0 + bj * HALF);
#pragma unroll
                for (int m = 0; m < 4; ++m) { const u32x4 w0 = hw[m];
                    f32x4 h0, h1; h0.x = __builtin_bit_cast(float, w0.x << 16); h0.y = __builtin_bit_cast(float, w0.x & 0xffff0000u); h0.z = __builtin_bit_cast(float, w0.y << 16); h0.w = __builtin_bit_cast(float, w0.y & 0xffff0000u);
                    h1.x = __builtin_bit_cast(float, w0.z << 16); h1.y = __builtin_bit_cast(float, w0.z & 0xffff0000u); h1.z = __builtin_bit_cast(float, w0.w << 16); h1.w = __builtin_bit_cast(float, w0.w & 0xffff0000u);
                    acc[ai][bj][m][0] = (h0 - shv[0]) * aiv[0] + g1v[0] * acc[ai][bj][m][0]; acc[ai][bj][m][1] = (h1 - shv[1]) * aiv[1] + g1v[1] * acc[ai][bj][m][1]; }
                asm volatile("" : "+v"(acc[ai][bj][0][0]), "+v"(acc[ai][bj][0][1]), "+v"(acc[ai][bj][1][0]), "+v"(acc[ai][bj][1][1]));
                asm volatile("" : "+v"(acc[ai][bj][2][0]), "+v"(acc[ai][bj][2][1]), "+v"(acc[ai][bj][3][0]), "+v"(acc[ai][bj][3][1]));
                asm volatile("" ::: "memory"); }
        }
        st.run(acc, u, wr, wc, fr, fq, lds, wid, lane);
        const LAS f32x2* S = (const LAS f32x2*)(lds + TAB_OFF + 8192);
        const float* m2b = mod2 + (size_t)b * NMOD + col0;
#pragma unroll
        for (int bj = 0; bj < 2; ++bj) {
            f32x4 Av[2], Bv[2];
#pragma unroll
            for (int n = 0; n < 2; ++n) { const f32x4 gl = *(const f32x4*)(lng + col0 + bj * HALF + 4 * n), bl = *(const f32x4*)(lnb + col0 + bj * HALF + 4 * n);
                if (OUT_F32) { Av[n] = gl; Bv[n] = bl; }
                else { const f32x4 s1 = *(const f32x4*)(m2b + sc2_off + bj * HALF + 4 * n) + 1.0f, sh2 = *(const f32x4*)(m2b + sh2_off + bj * HALF + 4 * n); Av[n] = gl * s1; Bv[n] = bl * s1 + sh2; } }
#pragma unroll
            for (int ai = 0; ai < 2; ++ai)
#pragma unroll
                for (int m = 0; m < 4; ++m) { const int r = ai * HALF + wr * 64 + m * 16 + fr; const f32x2 sr = S[r];
                    const f32x4 o0 = (acc[ai][bj][m][0] - sr.x) * sr.y * Av[0] + Bv[0], o1 = (acc[ai][bj][m][1] - sr.x) * sr.y * Av[1] + Bv[1];
                    if (OUT_F32) { float* p = outF + (size_t)(u.pm * BM + r) * D + col0 + bj * HALF; *(f32x4*)p = o0; *(f32x4*)(p + 4) = o1; }
                    else { u32x4 w; w.x = cvt_pk_bf16(o0[0], o0[1]); w.y = cvt_pk_bf16(o0[2], o0[3]); w.z = cvt_pk_bf16(o1[0], o1[1]); w.w = cvt_pk_bf16(o1[2], o1[3]);
                        *(u32x4*)(H + (size_t)(u.pm * BM + r) * D + col0 + bj * HALF) = w; } }
        }
    }
};

template <class Epi, bool ALIGN_EPI, class Sched = StaticOrder>
__device__ __forceinline__ void gemm_phase(LAS unsigned char* lds, const Gemm g, const Sched& S, const Epi& E) {
    int tid = threadIdx.x; asm volatile("" : "+v"(tid));
    const int wid = __builtin_amdgcn_readfirstlane(tid >> 6), lane = tid & 63, wr = wid >> 2, wc = wid & 3, fr = lane & 15, fq = lane >> 4;
    const int K = g.K, nt = K / BK;
    unsigned voffA[2], voffB[2];
#pragma unroll
    for (int i = 0; i < 2; ++i) { int R, C; stage_rc(tid * 16 + i * 8192, R, C); const int Rb = Epi::PERM ? ((R & ~31) + perm32(R & 31)) : R;
        voffA[i] = (unsigned)(R * K + C) * 2u; voffB[i] = (unsigned)(Rb * K + C) * 2u; }
    const size_t kstep = (size_t)(BK * 2);
    const size_t hstep = (size_t)HALF * K * 2;
    const size_t tstep = 2 * hstep;
    const unsigned ldsw = (unsigned)wid * 1024u;
    const int aoff = lds_byte(wr * 64 + fr, fq * 8), boff = lds_byte(wc * 32 + fr, fq * 8);
#define PG8_SA(b, h) (((b) * 2 + (h)) * HTB)
#define PG8_SB(b, h) ((4 + (b) * 2 + (h)) * HTB)
#define PG8_STAGE(bufoff, gbase, voff) do { _Pragma("unroll") for (int _i = 0; _i < 2; ++_i) \
        __builtin_amdgcn_global_load_lds((const unsigned*)((const char*)(gbase) + (voff)[_i]), (LAS unsigned*)(lds + (bufoff) + ldsw + _i * 8192), 16, 0, 0); } while (0)
#define PG8_LDA(dst, b, h) do { _Pragma("unroll") for (int m = 0; m < 4; ++m) _Pragma("unroll") for (int k = 0; k < 2; ++k) dst[m][k] = *(const LAS bf16x8*)(lds + PG8_SA(b, h) + aoff + m * 2048 + k * 1024); } while (0)
#define PG8_LDB(dst, b, h) do { _Pragma("unroll") for (int n = 0; n < 2; ++n) _Pragma("unroll") for (int k = 0; k < 2; ++k) dst[n][k] = *(const LAS bf16x8*)(lds + PG8_SB(b, h) + boff + n * 2048 + k * 1024); } while (0)
#define PG8_MMA(ai, bj, At, Bt) do { __builtin_amdgcn_s_setprio(1); _Pragma("unroll") for (int m = 0; m < 4; ++m) _Pragma("unroll") for (int n = 0; n < 2; ++n) _Pragma("unroll") for (int k = 0; k < 2; ++k) \
        acc[ai][bj][m][n] = __builtin_amdgcn_mfma_f32_16x16x32_bf16(Bt[n][k], At[m][k], acc[ai][bj][m][n], 0, 0, 0); __builtin_amdgcn_s_setprio(0); } while (0)
#define PG8_WAIT_V(n) asm volatile("s_waitcnt vmcnt(" #n ")" ::: "memory")
#define PG8_WAIT_L(n) asm volatile("s_waitcnt lgkmcnt(" #n ")" ::: "memory")
#define PG8_BAR __builtin_amdgcn_s_barrier()
#define PG8_SCHED __builtin_amdgcn_sched_barrier(0)
#define PG8_PTRS(u, pa, pb) do { const bool _sw = Epi::VSWAP && (((u).pn >> 1) == 2); const char* _a = (const char*)g.A + (size_t)(u).pm * tstep; const char* _b = (const char*)g.Bt + (size_t)(u).pn * tstep; pa = _sw ? _b : _a; pb = _sw ? _a : _b; } while (0)
    Unit cur, nxt; int ui = 0;
    if (!S.next(0, cur)) return;
    f32x4 acc[2][2][4][2];
#pragma unroll
    for (int a = 0; a < 2; ++a)
#pragma unroll
        for (int b = 0; b < 2; ++b)
#pragma unroll
            for (int m = 0; m < 4; ++m)
#pragma unroll
                for (int n = 0; n < 2; ++n) acc[a][b][m][n] = (f32x4){0.f, 0.f, 0.f, 0.f};
    bf16x8 At[4][2], B0[2][2], B1[2][2];
    const char* cA; const char* cB; PG8_PTRS(cur, cA, cB);
    PG8_STAGE(PG8_SB(0, 0), cB, voffB); PG8_STAGE(PG8_SB(0, 1), cB + hstep, voffB); PG8_STAGE(PG8_SA(0, 0), cA, voffA); PG8_STAGE(PG8_SA(0, 1), cA + hstep, voffA);
    if (wr == 1) PG8_BAR;
    PG8_WAIT_V(2); PG8_BAR;
    PG8_STAGE(PG8_SB(1, 0), cB + kstep, voffB); PG8_STAGE(PG8_SA(1, 0), cA + kstep, voffA); PG8_STAGE(PG8_SB(1, 1), cB + hstep + kstep, voffB);
    PG8_WAIT_V(6); PG8_BAR;
    for (;;) {
        const bool has_next = S.next(ui + 1, nxt);
        const char* nA = cA; const char* nB = cB; if (has_next) { PG8_PTRS(nxt, nA, nB); }
        for (int t = 0; t < nt; t += 2) {
            const bool last = (t == nt - 2);
            const char* a1 = cA + (size_t)(t + 1) * kstep;
            const char* a2 = last ? nA : cA + (size_t)(t + 2) * kstep; const char* b2 = last ? nB : cB + (size_t)(t + 2) * kstep;
            const char* a3 = a2 + kstep; const char* b3 = b2 + kstep;
            PG8_LDB(B0, 0, 0); PG8_LDB(B1, 0, 1); PG8_SCHED; PG8_LDA(At, 0, 0); PG8_STAGE(PG8_SA(1, 1), a1 + hstep, voffA);
            PG8_WAIT_V(8); PG8_WAIT_L(0); PG8_BAR; PG8_MMA(0, 0, At, B0); PG8_MMA(0, 1, At, B1); PG8_BAR; PG8_SCHED;
            PG8_LDA(At, 0, 1); PG8_STAGE(PG8_SB(0, 0), b2, voffB); PG8_STAGE(PG8_SB(0, 1), b2 + hstep, voffB); PG8_STAGE(PG8_SA(0, 0), a2, voffA);
            PG8_WAIT_V(8); PG8_WAIT_L(0); PG8_BAR; PG8_MMA(1, 0, At, B0); PG8_MMA(1, 1, At, B1); PG8_BAR; PG8_SCHED;
            PG8_LDB(B0, 1, 0); PG8_LDB(B1, 1, 1); PG8_SCHED; PG8_LDA(At, 1, 0); PG8_STAGE(PG8_SA(0, 1), a2 + hstep, voffA);
            PG8_WAIT_V(8); PG8_WAIT_L(0); PG8_BAR; PG8_MMA(0, 0, At, B0); PG8_MMA(0, 1, At, B1); PG8_BAR; PG8_SCHED;
            PG8_LDA(At, 1, 1); PG8_STAGE(PG8_SB(1, 0), b3, voffB); PG8_STAGE(PG8_SB(1, 1), b3 + hstep, voffB); PG8_STAGE(PG8_SA(1, 0), a3, voffA);
            PG8_WAIT_V(8); PG8_WAIT_L(0); PG8_BAR; PG8_MMA(1, 0, At, B0); PG8_MMA(1, 1, At, B1); PG8_BAR; PG8_SCHED;
        }
        if constexpr (ALIGN_EPI) { if (wr == 0) PG8_BAR; }
        if constexpr (Epi::FUSED) E.fused(acc, cur, wr, wc, fr, fq, lds, wid, lane); else E(acc, cur, wr, wc, fr, fq);
        if (!has_next) break;
#pragma unroll
        for (int a = 0; a < 2; ++a)
#pragma unroll
            for (int b = 0; b < 2; ++b)
#pragma unroll
                for (int m = 0; m < 4; ++m)
#pragma unroll
                    for (int n = 0; n < 2; ++n) acc[a][b][m][n] = (f32x4){0.f, 0.f, 0.f, 0.f};
        cur = nxt; cA = nA; cB = nB; ++ui;
        if constexpr (ALIGN_EPI) { if (wr == 1) PG8_BAR; }
    }
    PG8_WAIT_V(0);
    if constexpr (!ALIGN_EPI) { if (wr == 0) PG8_BAR; }
    PG8_BAR;
#undef PG8_SA
#undef PG8_SB
#undef PG8_STAGE
#undef PG8_LDA
#undef PG8_LDB
#undef PG8_MMA
#undef PG8_WAIT_V
#undef PG8_WAIT_L
#undef PG8_BAR
#undef PG8_SCHED
#undef PG8_PTRS
}
}

#define XB_TMO      128
#define XB_XCNT(j)  (256  + 64 * (j))
#define XB_XSUB(j)  (1280 + 64 * (j))
#define XB_XGEN(j)  (2304 + 64 * (j))
#define XB_TOP      3328
#define XB_TOPGEN   3392
#define XCD_BAR_WORDS 3456
#define XB_SPIN_CAP (1u << 18)
__device__ __forceinline__ unsigned xb_ld(unsigned* p)              { return __hip_atomic_load(p, __ATOMIC_RELAXED, __HIP_MEMORY_SCOPE_AGENT); }
__device__ __forceinline__ unsigned xb_add(unsigned* p, unsigned v) { return __hip_atomic_fetch_add(p, v, __ATOMIC_RELAXED, __HIP_MEMORY_SCOPE_AGENT); }
__device__ __forceinline__ unsigned xb_xcc_id() { return (unsigned)__builtin_amdgcn_s_getreg((3 << 11) | 20) & 0xFu; }
#define XB_SPIN(cond, bar) do { unsigned _sp = 0; while (cond) { __builtin_amdgcn_s_sleep(1); \
    if ((++_sp & 255u) == 0u) { if (xb_ld(&(bar)[XB_TMO])) break; if (_sp > XB_SPIN_CAP) { atomicAdd(&(bar)[XB_TMO], 1u); break; } } } } while (0)
struct XcdBarrier { unsigned* bar; unsigned x; volatile LAS unsigned* st; };
__device__ __forceinline__ XcdBarrier xcd_barrier_post(unsigned* bar, volatile LAS unsigned* st) {
    XcdBarrier b; b.bar = bar; b.x = xb_xcc_id(); b.st = st;
    if (threadIdx.x == 0) (void)xb_add(&bar[XB_XCNT(b.x)], 1u);
    return b;
}
__device__ __forceinline__ void xcd_barrier_complete(unsigned* bar, unsigned x, unsigned& nloc, unsigned& nx) {
    const unsigned G = gridDim.x * gridDim.y * gridDim.z;
    unsigned sum, cnt, mine, sp = 0u;
    for (;;) {
        sum = 0u; cnt = 0u; mine = 0u;
#pragma unroll
        for (unsigned j = 0; j < 16; ++j) { const unsigned c = xb_ld(&bar[XB_XCNT(j)]); sum += c; cnt += (c > 0u) ? 1u : 0u; mine = (j == x) ? c : mine; }
        if (sum == G) break;
        __builtin_amdgcn_s_sleep(1);
        if ((++sp & 255u) == 0u) { if (xb_ld(&bar[XB_TMO])) break; if (sp > XB_SPIN_CAP) { atomicAdd(&bar[XB_TMO], 1u); break; } }
    }
    nloc = mine > 0u ? mine : 1u; nx = cnt > 0u ? cnt : 1u;
}
__device__ __forceinline__ void xcd_barrier(const XcdBarrier& b) {
    asm volatile("s_waitcnt vmcnt(0)" ::: "memory");
    __syncthreads();
    if (threadIdx.x == 0) {
        unsigned* bar = b.bar;
        __builtin_amdgcn_s_waitcnt(0);
        unsigned nloc = b.st[0], nx = b.st[1];
        if (nloc == 0u) { xcd_barrier_complete(bar, b.x, nloc, nx); b.st[0] = nloc; b.st[1] = nx; }
        const unsigned old = xb_add(&bar[XB_XSUB(b.x)], 1u);
        const unsigned gen = old / nloc;
        if (old + 1u == (gen + 1u) * nloc) {
            __builtin_amdgcn_fence(__ATOMIC_RELEASE, "agent");
            asm volatile("s_waitcnt vmcnt(0)" ::: "memory");
            const unsigned og = xb_add(&bar[XB_TOP], 1u);
            const unsigned tg = og / nx;
            if (og + 1u == (tg + 1u) * nx) xb_add(&bar[XB_TOPGEN], 1u);
            else XB_SPIN(xb_ld(&bar[XB_TOPGEN]) == tg, bar);
            __builtin_amdgcn_fence(__ATOMIC_ACQUIRE, "agent");
            xb_add(&bar[XB_XGEN(b.x)], 1u);
            asm volatile("s_waitcnt vmcnt(0)" ::: "memory");
        } else {
            XB_SPIN(xb_ld(&bar[XB_XGEN(b.x)]) == gen, bar);
            __builtin_amdgcn_fence(__ATOMIC_ACQUIRE, "agent");
            asm volatile("s_waitcnt vmcnt(0)" ::: "memory");
        }
    }
    __syncthreads();
}

__device__ __forceinline__ unsigned f2bf(float f) { unsigned u = __builtin_bit_cast(unsigned, f); return (u + 0x7fffu + ((u >> 16) & 1u)) >> 16; }
__device__ __forceinline__ unsigned pk2(float lo, float hi) { return f2bf(lo) | (f2bf(hi) << 16); }
__device__ __forceinline__ float bflo(unsigned w) { return __builtin_bit_cast(float, w << 16); }
__device__ __forceinline__ float bfhi(unsigned w) { return __builtin_bit_cast(float, w & 0xffff0000u); }
__device__ __forceinline__ float wave_sum(float v) {
#pragma unroll
    for (int o = 1; o < 64; o <<= 1) v += __shfl_xor(v, o);
    return v;
}

__device__ __forceinline__ void transpose_item(const float* W, int N, bf16_t* WT, int ldw, LAS float* scr, int kb, int nb, int lane) {
    const int k0 = 64 * kb, n0 = 32 * nb;
#pragma unroll 8
    for (int i = 0; i < 32; ++i) { const int kk = 2 * i + (lane >> 5); scr[kk * 33 + (lane & 31)] = W[(size_t)(k0 + kk) * N + n0 + (lane & 31)]; }
    asm volatile("s_waitcnt lgkmcnt(0)" ::: "memory");
    const int c = lane & 7;
#pragma unroll
    for (int j = 0; j < 4; ++j) { const int n = (lane >> 3) + 8 * j; const LAS float* s = scr + (8 * c) * 33 + n;
        u32x4 o; o.x = pk2(s[0 * 33], s[1 * 33]); o.y = pk2(s[2 * 33], s[3 * 33]); o.z = pk2(s[4 * 33], s[5 * 33]); o.w = pk2(s[6 * 33], s[7 * 33]);
        *(u32x4*)(WT + (size_t)(n0 + n) * ldw + k0 + 8 * c) = o; }
    asm volatile("s_waitcnt lgkmcnt(0)" ::: "memory");
}

struct Args {
    const float *x, *c, *ln_in_g, *ln_in_b, *w_ada, *b_ada, *w_in, *rpb, *w_pool, *pool_scale, *w_out, *ln1_g, *ln1_b, *w_mlp1, *w_mlp2, *ln2_g, *ln2_b;
    float* out; unsigned char* ws; int ph_lo, ph_hi;
};

__device__ __forceinline__ void p0_prologue(const Args& a, LAS unsigned char* lds, int G, int bid, int tid) {
    asm volatile("" : "+v"(tid));
    const int lane = tid & 63, wave = tid >> 6;
    unsigned char* ws = a.ws;
    float* mod = (float*)(ws + WS_MOD);
    for (int item = bid; item < 2 * (NMOD / 64); item += G) {
        const int l = item / (NMOD / 64), n0 = (item % (NMOD / 64)) * 64;
        LAS float* cact = (LAS float*)lds;
        LAS float* red = (LAS float*)(lds + 65536);
        for (int i = tid; i < BATCH * D; i += 512) { const int b = i >> 10, k = i & 1023; const float v = a.c[i]; cact[k * 16 + b] = v / (1.0f + expf(-v)); }
        __syncthreads();
        const int ks = tid >> 6, col = tid & 63;
        float acc[16];
#pragma unroll
        for (int b = 0; b < 16; ++b) acc[b] = 0.f;
        const float* wp = a.w_ada + (size_t)l * D * NMOD + (size_t)(ks * 128) * NMOD + n0 + col;
#pragma unroll 4
        for (int kk = 0; kk < 128; ++kk) {
            const float w = wp[(size_t)kk * NMOD];
            const LAS f32x4* cp = (const LAS f32x4*)(cact + (ks * 128 + kk) * 16);
#pragma unroll
            for (int q = 0; q < 4; ++q) { const f32x4 cv = cp[q]; acc[4 * q + 0] += cv.x * w; acc[4 * q + 1] += cv.y * w; acc[4 * q + 2] += cv.z * w; acc[4 * q + 3] += cv.w * w; }
        }
#pragma unroll
        for (int b = 0; b < 16; ++b) red[(ks * 16 + b) * 64 + col] = acc[b];
        __syncthreads();
        for (int o = tid; o < 1024; o += 512) { const int b = o >> 6, cc = o & 63; float s = 0.f;
#pragma unroll
            for (int k8 = 0; k8 < 8; ++k8) s += red[(k8 * 16 + b) * 64 + cc];
            mod[(size_t)(l * 16 + b) * NMOD + n0 + cc] = s + a.b_ada[l * NMOD + n0 + cc]; }
        __syncthreads();
    }
    for (int idx = bid * 512 + tid; idx < 2 * 4 * 16 * 1024; idx += G * 512) {
        const int l = idx >> 16, g = (idx >> 14) & 3, cch = (idx >> 10) & 15, n = idx & 1023;
        const float* wo = a.w_out + (size_t)l * D * D + (size_t)(512 + g * 128) * D + n;
        const float* wpl = a.w_pool + ((size_t)(l * 4 + g) * 128 + cch * 8) * 128;
        const float* ps = a.pool_scale + l * 512 + g * 128;
        float acc[8];
#pragma unroll
        for (int i = 0; i < 8; ++i) acc[i] = 0.f;
#pragma unroll 4
        for (int d = 0; d < 128; ++d) { const float v = wo[(size_t)d * D] * ps[d];
#pragma unroll
            for (int i = 0; i < 8; ++i) acc[i] += wpl[i * 128 + d] * v; }
        u32x4 o; o.x = pk2(acc[0], acc[1]); o.y = pk2(acc[2], acc[3]); o.z = pk2(acc[4], acc[5]); o.w = pk2(acc[6], acc[7]);
        *(u32x4*)((bf16_t*)(ws + WS_WOUT) + (size_t)l * D * D + (size_t)n * D + 512 + g * 128 + cch * 8) = o;
    }
    {
        LAS float* scr = (LAS float*)(lds + wave * 16384);
        const int gw = bid * 8 + wave, NGW = G * 8;
        constexpr int I_IN = 16 * 64, I_OUT = 8 * 32, I_1 = 16 * 128, I_2 = 64 * 32, I_L = I_IN + I_OUT + I_1 + I_2;
        for (int it = gw; it < 2 * I_L; it += NGW) {
            const int l = it / I_L; int r = it % I_L;
            if (r < I_IN) { transpose_item(a.w_in + (size_t)l * D * PROJ, PROJ, (bf16_t*)(ws + WS_WIN) + (size_t)l * PROJ * D, D, scr, r / 64, r % 64, lane); continue; } r -= I_IN;
            if (r < I_OUT) { transpose_item(a.w_out + (size_t)l * D * D, D, (bf16_t*)(ws + WS_WOUT) + (size_t)l * D * D, D, scr, r / 32, r % 32, lane); continue; } r -= I_OUT;
            if (r < I_1) { transpose_item(a.w_mlp1 + (size_t)l * D * FF, FF, (bf16_t*)(ws + WS_W1) + (size_t)l * FF * D, D, scr, r / 128, r % 128, lane); continue; } r -= I_1;
            transpose_item(a.w_mlp2 + (size_t)l * FF * D, D, (bf16_t*)(ws + WS_W2) + (size_t)l * D * FF, FF, scr, r / 32, r % 32, lane);
        }
    }
}

template <bool SRC_BF16, bool OUT_F32>
__device__ __forceinline__ void ln_phase(const void* srcv, float* dstF, bf16_t* dstH, const float* g, const float* bt, const float* sc, const float* sh, int G, int bid, int tid) {
    asm volatile("" : "+v"(tid));
    const int lane = tid & 63, wave = tid >> 6;
    const int gw = bid * 8 + wave, NGW = G * 8;
    const int rpw = (((M + NGW - 1) / NGW) + 3) & ~3;
    const int r0 = gw * rpw, r1 = (r0 + rpw < M) ? r0 + rpw : M;
    if (r0 >= M) return;
    const int c0 = 8 * lane;
    f32x4 gv[4], bv[4], scv[4], shv[4];
#pragma unroll
    for (int j = 0; j < 4; ++j) { const int cj = c0 + (j >> 1) * 512 + (j & 1) * 4; gv[j] = *(const f32x4*)(g + cj); bv[j] = *(const f32x4*)(bt + cj); scv[j] = (f32x4){1.f, 1.f, 1.f, 1.f}; shv[j] = (f32x4){0.f, 0.f, 0.f, 0.f}; }
    int curb = -1;
    for (int r = r0; r < r1; r += 4) {
        f32x4 nf[4][4]; u32x4 nb[4][2];
#pragma unroll
        for (int q = 0; q < 4; ++q) {
            if (SRC_BF16) { const bf16_t* p = (const bf16_t*)srcv + (size_t)(r + q) * D + c0; nb[q][0] = *(const u32x4*)p; nb[q][1] = *(const u32x4*)(p + 512); }
            else { const float* p = (const float*)srcv + (size_t)(r + q) * D + c0; nf[q][0] = *(const f32x4*)p; nf[q][1] = *(const f32x4*)(p + 4); nf[q][2] = *(const f32x4*)(p + 512); nf[q][3] = *(const f32x4*)(p + 516); }
        }
        const int b = r >> 12;
        if (!OUT_F32 && b != curb) { curb = b;
#pragma unroll
            for (int j = 0; j < 4; ++j) { const int cj = c0 + (j >> 1) * 512 + (j & 1) * 4; scv[j] = *(const f32x4*)(sc + (size_t)b * NMOD + cj) + 1.0f; shv[j] = *(const f32x4*)(sh + (size_t)b * NMOD + cj); } }
#pragma unroll
        for (int q = 0; q < 4; ++q) {
            f32x4 v[4];
            if (SRC_BF16) {
#pragma unroll
                for (int t = 0; t < 2; ++t) { const u32x4 w = nb[q][t]; v[2 * t].x = bflo(w.x); v[2 * t].y = bfhi(w.x); v[2 * t].z = bflo(w.y); v[2 * t].w = bfhi(w.y); v[2 * t + 1].x = bflo(w.z); v[2 * t + 1].y = bfhi(w.z); v[2 * t + 1].z = bflo(w.w); v[2 * t + 1].w = bfhi(w.w); }
            } else {
#pragma unroll
                for (int j = 0; j < 4; ++j) v[j] = nf[q][j];
            }
            float s = 0.f;
#pragma unroll
            for (int j = 0; j < 4; ++j) s += (v[j].x + v[j].y) + (v[j].z + v[j].w);
            const float mean = wave_sum(s) * (1.f / D); float s2 = 0.f;
#pragma unroll
            for (int j = 0; j < 4; ++j) { v[j] = v[j] - mean; s2 += (v[j].x * v[j].x + v[j].y * v[j].y) + (v[j].z * v[j].z + v[j].w * v[j].w); }
            const float rstd = 1.f / sqrtf(wave_sum(s2) * (1.f / D) + LN_EPS);
#pragma unroll
            for (int j = 0; j < 4; ++j) v[j] = v[j] * rstd * gv[j] + bv[j];
            if (OUT_F32) { float* p = dstF + (size_t)(r + q) * D + c0; *(f32x4*)p = v[0]; *(f32x4*)(p + 4) = v[1]; *(f32x4*)(p + 512) = v[2]; *(f32x4*)(p + 516) = v[3]; }
            else {
#pragma unroll
                for (int j = 0; j < 4; ++j) v[j] = v[j] * scv[j] + shv[j];
                bf16_t* p = dstH + (size_t)(r + q) * D + c0;
                u32x4 w0, w1; w0.x = pk2(v[0].x, v[0].y); w0.y = pk2(v[0].z, v[0].w); w0.z = pk2(v[1].x, v[1].y); w0.w = pk2(v[1].z, v[1].w);
                w1.x = pk2(v[2].x, v[2].y); w1.y = pk2(v[2].z, v[2].w); w1.z = pk2(v[3].x, v[3].y); w1.w = pk2(v[3].z, v[3].w);
                *(u32x4*)p = w0; *(u32x4*)(p + 512) = w1;
            }
        }
    }
}

__device__ __forceinline__ void add8(float (&s)[8], const u32x4 w) { s[0] += bflo(w.x); s[1] += bfhi(w.x); s[2] += bflo(w.y); s[3] += bfhi(w.y); s[4] += bflo(w.z); s[5] += bfhi(w.z); s[6] += bflo(w.w); s[7] += bfhi(w.w); }
__device__ __forceinline__ void sub8(float (&s)[8], const u32x4 w) { s[0] -= bflo(w.x); s[1] -= bfhi(w.x); s[2] -= bflo(w.y); s[3] -= bfhi(w.y); s[4] -= bflo(w.z); s[5] -= bfhi(w.z); s[6] -= bflo(w.w); s[7] -= bfhi(w.w); }
template <int W>
__device__ __forceinline__ void pool_lane(const bf16_t* Ubc  , bf16_t* catc  , int T0) {
    constexpr int HW = W / 2, NL = 8 + W - 1;
    u32x4 raw[NL];
#pragma unroll
    for (int k = 0; k < NL; ++k) { const int tk = T0 - HW + k; const int tc = tk < 0 ? 0 : (tk > SEQ - 1 ? SEQ - 1 : tk); u32x4 v = *(const u32x4*)(Ubc + (size_t)tc * AW);
        if (tk != tc) v = (u32x4){0u, 0u, 0u, 0u}; raw[k] = v; }
    float sm[8];
#pragma unroll
    for (int e = 0; e < 8; ++e) sm[e] = 0.f;
#pragma unroll
    for (int k = 0; k < W; ++k) add8(sm, raw[k]);
#pragma unroll
    for (int o = 0; o < 8; ++o) {
        int lo = T0 + o - HW, hi = lo + W; lo = lo < 0 ? 0 : lo; hi = hi > SEQ ? SEQ : hi; const float ic = 1.0f / (float)(hi - lo);
        const u32x4 c = raw[o + HW];
        u32x4 w; w.x = pk2(sm[0] * ic - bflo(c.x), sm[1] * ic - bfhi(c.x)); w.y = pk2(sm[2] * ic - bflo(c.y), sm[3] * ic - bfhi(c.y));
        w.z = pk2(sm[4] * ic - bflo(c.z), sm[5] * ic - bfhi(c.z)); w.w = pk2(sm[6] * ic - bflo(c.w), sm[7] * ic - bfhi(c.w));
        *(u32x4*)(catc + (size_t)(T0 + o) * D) = w;
        if (o < 7) { add8(sm, raw[o + W]); sub8(sm, raw[o]); }
    }
}
__device__ __forceinline__ void attn_pool_phase(LAS unsigned char* lds, const bf16_t* Qb, const bf16_t* Kb, const bf16_t* Vt, const bf16_t* Ub, bf16_t* cat, const float* rpb_l, int G, int bid, int tid, int mode = 0) {
    asm volatile("" : "+v"(tid));
    LAS float* tab = (LAS float*)lds;
    for (int i = tid; i < NHEAD * RPB_H * 64; i += 512) { const int c = (i & 63) - 16, hr = i >> 6; tab[i] = (c >= 0 && c < RPB_W) ? rpb_l[hr * RPB_W + c] * LOG2E : 0.f; }
    __syncthreads();
    const int lane = tid & 63, h = __builtin_amdgcn_readfirstlane(tid >> 6), q16 = lane & 15, g4 = lane >> 4;
    const LAS float* tabh = tab + h * (RPB_H * 64) + 16;
    const bool xl = (G == 256); const int nun = xl ? 4 : (BATCH * 64 + G - 1) / G;
    for (int k = 0; k < nun; ++k) {
        const int unit = xl ? ((bid & 7) * 128 + k * 32 + (bid >> 3)) : (bid + k * G);
        if (unit >= BATCH * 64) break;
        const int b = unit >> 6, r = unit & 63; const int rs = r < 4 ? 0 : (r > 60 ? 56 : r - 4);
        const size_t tok0 = (size_t)b * SEQ + r * 64;
#pragma unroll 1
        for (int j = 0; j < ((mode & 2) ? 0 : 4); ++j) {
            const int cb = (j == 0) ? 0 : (j == 1) ? 8 : (j == 2) ? 24 : 32;
            const int qc = 16 * j + q16; const int cs = qc < 8 ? 0 : (qc > 56 ? 48 : qc - 8);
            const int tb0 = cb + g4 * 8 - qc + 15;
            const int vlo = cs - (cb + g4 * 8);
            const size_t cbase = ((size_t)(b * 8 + h) * 8 + g4) * SEQ;
            const bf16_t* qp = Qb + (cbase + r * 64 + qc) * 8;
            const bf16x8 q0 = *(const bf16x8*)qp, q1 = *(const bf16x8*)(qp + (size_t)4 * SEQ * 8);
            bf16x8 kf[8][2][2];
            const bf16_t* kbase = Kb + (cbase + rs * 64 + cb + (q16 >> 2) * 8 + (q16 & 3)) * 8;
#pragma unroll
            for (int i = 0; i < 8; ++i)
#pragma unroll
                for (int hh = 0; hh < 2; ++hh) { const bf16_t* kp = kbase + (size_t)(i * 64 + hh * 4) * 8; kf[i][hh][0] = *(const bf16x8*)kp; kf[i][hh][1] = *(const bf16x8*)(kp + (size_t)4 * SEQ * 8); }
            __builtin_amdgcn_sched_barrier(0);
            f32x4 s[8][2];
            float mx = -1e30f;
#pragma unroll
            for (int i = 0; i < 8; ++i)
#pragma unroll
                for (int hh = 0; hh < 2; ++hh) {
                    f32x4 acc = (f32x4){0.f, 0.f, 0.f, 0.f};
                    acc = __builtin_amdgcn_mfma_f32_16x16x32_bf16(kf[i][hh][0], q0, acc, 0, 0, 0);
                    acc = __builtin_amdgcn_mfma_f32_16x16x32_bf16(kf[i][hh][1], q1, acc, 0, 0, 0);
                    const LAS float* trow = tabh + (rs + i - r + 7) * 64 + tb0 + hh * 4;
#pragma unroll
                    for (int jj = 0; jj < 4; ++jj) {
                        const float bv = trow[jj];
                        const bool valid = (unsigned)(hh * 4 + jj - vlo) < 16u;
                        const float sv = valid ? acc[jj] + bv : -1e30f;
                        acc[jj] = sv; mx = fmaxf(mx, sv);
                    }
                    s[i][hh] = acc;
                }
            bf16x8 vf[8][4];
            const bf16_t* vbase = Vt + (((size_t)(b * 8 + h) * (SEQ / 8) + (rs * 64 + cb) / 8 + g4) * 64 + q16) * 8;
#pragma unroll
            for (int i = 0; i < 8; ++i)
#pragma unroll
                for (int db = 0; db < 4; ++db) vf[i][db] = *(const bf16x8*)(vbase + (size_t)i * 8 * 512 + db * 128);
            __builtin_amdgcn_sched_barrier(0);
            mx = fmaxf(mx, __shfl_xor(mx, 16)); mx = fmaxf(mx, __shfl_xor(mx, 32));
            float sum = 0.f;
            u32x4 pw[8];
#pragma unroll
            for (int i = 0; i < 8; ++i) {
#pragma unroll
                for (int hh = 0; hh < 2; ++hh)
#pragma unroll
                    for (int jj = 0; jj < 4; ++jj) { const float p = __builtin_amdgcn_exp2f(s[i][hh][jj] - mx); s[i][hh][jj] = p; sum += p; }
                pw[i].x = pg8::cvt_pk_bf16(s[i][0][0], s[i][0][1]); pw[i].y = pg8::cvt_pk_bf16(s[i][0][2], s[i][0][3]); pw[i].z = pg8::cvt_pk_bf16(s[i][1][0], s[i][1][1]); pw[i].w = pg8::cvt_pk_bf16(s[i][1][2], s[i][1][3]);
            }
            sum += __shfl_xor(sum, 16); sum += __shfl_xor(sum, 32);
            f32x4 o[4];
#pragma unroll
            for (int db = 0; db < 4; ++db) o[db] = (f32x4){0.f, 0.f, 0.f, 0.f};
#pragma unroll
            for (int i = 0; i < 8; ++i) {
                const bf16x8 pf = __builtin_bit_cast(bf16x8, pw[i]);
#pragma unroll
                for (int db = 0; db < 4; ++db) o[db] = __builtin_amdgcn_mfma_f32_16x16x32_bf16(vf[i][db], pf, o[db], 0, 0, 0);
            }
            const float inv = 1.0f / sum;
            bf16_t* op = cat + (tok0 + qc) * D + h * 64 + g4 * 4;
#pragma unroll
            for (int db = 0; db < 4; ++db) { u32x2 w; w.x = pg8::cvt_pk_bf16(o[db][0] * inv, o[db][1] * inv); w.y = pg8::cvt_pk_bf16(o[db][2] * inv, o[db][3] * inv); *(u32x2*)(op + db * 16) = w; }
        }
        if (!(mode & 1)) {
            const int gidx = h & 3, hfl = h >> 2; const int T0 = r * 64 + hfl * 32 + g4 * 8; const int chan = gidx * 128 + q16 * 8;
            const bf16_t* Ubc = Ub + (size_t)b * SEQ * AW + chan; bf16_t* catc = cat + (size_t)b * SEQ * D + 512 + chan;
            if (gidx == 0) pool_lane<2>(Ubc, catc, T0); else if (gidx == 1) pool_lane<4>(Ubc, catc, T0); else if (gidx == 2) pool_lane<8>(Ubc, catc, T0); else pool_lane<16>(Ubc, catc, T0);
        }
    }
}

constexpr int N_PHASES = 2 + 7 * DEPTH;
__global__ void __launch_bounds__(512, 2) fwd_megakernel(Args a) {
    extern __shared__ __attribute__((aligned(16))) unsigned char lds_raw[];
    LAS unsigned char* lds = (LAS unsigned char*)lds_raw;
    cg::grid_group grid = cg::this_grid();
    const int tid = threadIdx.x, bid = blockIdx.x, G = gridDim.x;
    unsigned char* ws = a.ws;
    bf16_t* H = (bf16_t*)(ws + WS_H); bf16_t* F = (bf16_t*)(ws + WS_F);
    bf16_t* Qb = (bf16_t*)(ws + WS_Q); bf16_t* Kb = (bf16_t*)(ws + WS_K); bf16_t* Vt = (bf16_t*)(ws + WS_VT); bf16_t* Ub = (bf16_t*)(ws + WS_U); bf16_t* CAT = (bf16_t*)(ws + WS_CAT);
    const float* mod = (const float*)(ws + WS_MOD);
    const int lo = a.ph_lo, hi = a.ph_hi;
#define IN(k) (lo <= (k) && (k) < hi)
    unsigned* barw = (unsigned*)(ws + WS_CTL);
    volatile LAS unsigned* misc = (volatile LAS unsigned*)(lds + 131072 + 1024);
    if (bid == 0) { for (int i = tid; i < 8192 + 4 * 16384; i += 512) barw[i] = 0u; }
    if (tid < 8) misc[tid] = 0u;
    __syncthreads();
    XcdBarrier xbar; xbar.bar = barw; xbar.x = 0; xbar.st = misc;
    const bool fusedln = (G == 256);
    int vb = bid;
#define SEAM(k) do { if (IN(k) && IN((k) + 1)) { if ((k) == 0) { grid.sync(); xbar = xcd_barrier_post(barw, misc); if (tid == 0) misc[2] = xb_add(&barw[3456 + 64 * xbar.x], 1u); } \
        else { xcd_barrier(xbar); if ((k) == 1) { \
            if (tid == 0) { bool ok = (G % 8 == 0) && xbar.x < 8u; for (int j = 0; j < 8; ++j) ok = ok && (xb_ld(&barw[3456 + 64 * j]) == (unsigned)(G / 8)); misc[3] = ok ? 1u : 0u; } \
            __syncthreads(); if (misc[3]) vb = (int)(misc[2] * 8u + xbar.x); } } } } while (0)

    if (IN(0)) { for (int rep = 0; rep <= PROBE_P0; ++rep) { p0_prologue(a, lds, G, bid, tid); if (rep < PROBE_P0) __syncthreads(); } }
    SEAM(0);
    if (IN(1)) { ln_phase<false, false>(a.x, nullptr, H, a.ln_in_g, a.ln_in_b, mod + 1 * D, mod + 0 * D, G, bid, tid); }
    SEAM(1);
#pragma unroll 1
    for (int l = 0; l < DEPTH; ++l) {
        const int p = 2 + 7 * l;
        const float* modl = mod + (size_t)l * BATCH * NMOD;
        if (IN(p + 0)) {
            pg8::Gemm g{H, (const bf16_t*)(ws + WS_WIN) + (size_t)l * PROJ * D, M, PROJ, D}; pg8::StaticOrder S; S.init(M, PROJ, G, vb);
            pg8::EpiProj E{Qb, Kb, Vt, Ub};
            pg8::gemm_phase<pg8::EpiProj, true>(lds, g, S, E);
        }
        SEAM(p + 0);
        if (IN(p + 1)) { for (int rep = 0; rep <= PROBE_ATT; ++rep) { attn_pool_phase(lds, Qb, Kb, Vt, Ub, CAT, a.rpb + (size_t)l * NHEAD * RPB_N, G, vb, tid, rep == 0 ? 0 : PROBE_MODE); if (rep < PROBE_ATT) xcd_barrier(xbar); } }
        SEAM(p + 1);
        if (IN(p + 2)) {
            pg8::Gemm g{CAT, (const bf16_t*)(ws + WS_WOUT) + (size_t)l * D * D, M, D, D}; pg8::StaticOrder S; S.init(M, D, G, vb);
            if (fusedln) { pg8::PanelStats st{(unsigned long long*)(ws + WS_X) + (size_t)(2 * l) * M * 4, barw + 8192 + (2 * l) * 16384};
                pg8::EpiResLn<false> E{H, nullptr, modl, 0 * D, 1 * D, 2 * D, a.ln1_g + l * D, a.ln1_b + l * D, modl, 3 * D, 4 * D, st};
                pg8::gemm_phase<pg8::EpiResLn<false>, true>(lds, g, S, E); }
            else { pg8::EpiRes E{H, modl, 0 * D, 1 * D, 2 * D};
                pg8::gemm_phase<pg8::EpiRes, true>(lds, g, S, E); }
        }
        SEAM(p + 2);
        if (IN(p + 3) && !fusedln) { ln_phase<true, false>(H, nullptr, H, a.ln1_g + l * D, a.ln1_b + l * D, modl + 4 * D, modl + 3 * D, G, bid, tid); }
        if (!fusedln) SEAM(p + 3);
        if (IN(p + 4)) {
            pg8::Gemm g{H, (const bf16_t*)(ws + WS_W1) + (size_t)l * FF * D, M, FF, D}; pg8::StaticOrder S; S.init(M, FF, G, vb);
            { pg8::EpiRelu2 E{F, FF, 0}; pg8::gemm_phase<pg8::EpiRelu2, true>(lds, g, S, E); }
#if PROBE_MLP1
            xcd_barrier(xbar);
            { int ns = PROBE_MLP1_NOSTORE; asm volatile("" : "+s"(ns)); pg8::EpiRelu2 E{F, FF, ns};
#if PROBE_MLP1_HOT
              pg8::HotOrder S2; S2.init(M, FF, G, vb); pg8::gemm_phase<pg8::EpiRelu2, true, pg8::HotOrder>(lds, g, S2, E);
#else
              pg8::gemm_phase<pg8::EpiRelu2, true>(lds, g, S, E);
#endif
            }
#endif
        }
        SEAM(p + 4);
        if (IN(p + 5)) {
            pg8::Gemm g{F, (const bf16_t*)(ws + WS_W2) + (size_t)l * D * FF, M, D, FF}; pg8::StaticOrder S; S.init(M, D, G, vb);
            const bool lastl2 = (l == DEPTH - 1); const float* modn2 = mod + (size_t)(lastl2 ? l : l + 1) * BATCH * NMOD;
            if (fusedln) { pg8::PanelStats st{(unsigned long long*)(ws + WS_X) + (size_t)(2 * l + 1) * M * 4, barw + 8192 + (2 * l + 1) * 16384};
                if (lastl2) { pg8::EpiResLn<true> E{H, a.out, modl, 3 * D, 4 * D, 5 * D, a.ln2_g + l * D, a.ln2_b + l * D, modn2, 0, 0, st};
                    pg8::gemm_phase<pg8::EpiResLn<true>, true>(lds, g, S, E); }
                else { pg8::EpiResLn<false> E{H, nullptr, modl, 3 * D, 4 * D, 5 * D, a.ln2_g + l * D, a.ln2_b + l * D, modn2, 0 * D, 1 * D, st};
                    pg8::gemm_phase<pg8::EpiResLn<false>, true>(lds, g, S, E); } }
            else { pg8::EpiRes E{H, modl, 3 * D, 4 * D, 5 * D};
                pg8::gemm_phase<pg8::EpiRes, true>(lds, g, S, E); }
        }
        if (!(fusedln && l == DEPTH - 1)) SEAM(p + 5);
        if (IN(p + 6) && !fusedln) {
            const bool lastl = (l == DEPTH - 1);
            const float* modn = mod + (size_t)(lastl ? l : l + 1) * BATCH * NMOD;
            if (lastl) ln_phase<true, true>(H, a.out, nullptr, a.ln2_g + l * D, a.ln2_b + l * D, modn, modn, G, bid, tid);
            else ln_phase<true, false>(H, nullptr, H, a.ln2_g + l * D, a.ln2_b + l * D, modn + 1 * D, modn + 0 * D, G, bid, tid);
        }
        if (!fusedln) SEAM(p + 6);
    }
    for (int rep = 0; rep < PROBE_SYNC; ++rep) xcd_barrier(xbar);
#undef IN
#undef SEAM
}

extern "C" void kernel_launch(void* const* d_in, const int* in_sizes, int n_in, void* d_out, int out_size, void* d_ws, size_t ws_size, hipStream_t stream) {
    static int grid = 0;
    if (grid == 0) {
        if (n_in != 17 || in_sizes[0] != M * D || out_size != M * D || ws_size < WS_END) { fprintf(stderr, "kernel_launch: unexpected shapes / workspace (n_in %d, in0 %d, out %d, ws %zu)\n", n_in, n_in > 0 ? in_sizes[0] : -1, out_size, ws_size); grid = -1; return; }
        int dev = 0, cus = 0, per_cu = 0;
        hipGetDevice(&dev); hipDeviceGetAttribute(&cus, hipDeviceAttributeMultiprocessorCount, dev);
        if (hipFuncSetAttribute((const void*)fwd_megakernel, hipFuncAttributeMaxDynamicSharedMemorySize, LDS_BYTES) != hipSuccess) { fprintf(stderr, "kernel_launch: hipFuncSetAttribute failed\n"); grid = -1; return; }
        if (hipOccupancyMaxActiveBlocksPerMultiprocessor(&per_cu, (const void*)fwd_megakernel, 512, LDS_BYTES) != hipSuccess || per_cu < 1) { per_cu = 1; (void)hipGetLastError(); }
        grid = (cus > 0 ? cus : 256) * per_cu;
    }
    if (grid < 0) return;
    Args a{};
    a.x = (const float*)d_in[0]; a.c = (const float*)d_in[1]; a.ln_in_g = (const float*)d_in[2]; a.ln_in_b = (const float*)d_in[3]; a.w_ada = (const float*)d_in[4]; a.b_ada = (const float*)d_in[5];
    a.w_in = (const float*)d_in[6]; a.rpb = (const float*)d_in[7]; a.w_pool = (const float*)d_in[8]; a.pool_scale = (const float*)d_in[9]; a.w_out = (const float*)d_in[10];
    a.ln1_g = (const float*)d_in[11]; a.ln1_b = (const float*)d_in[12]; a.w_mlp1 = (const float*)d_in[13]; a.w_mlp2 = (const float*)d_in[14]; a.ln2_g = (const float*)d_in[15]; a.ln2_b = (const float*)d_in[16];
    a.out = (float*)d_out; a.ws = (unsigned char*)d_ws;
#if MK_MULTI
    for (int p = 0; p < N_PHASES; ++p) { a.ph_lo = p; a.ph_hi = p + 1; hipLaunchKernelGGL(fwd_megakernel, dim3(grid), dim3(512), LDS_BYTES, stream, a); }
#else
    a.ph_lo = 0; a.ph_hi = N_PHASES;
    void* args[] = {&a};
    hipError_t e = hipLaunchCooperativeKernel((const void*)fwd_megakernel, dim3(grid), dim3(512), args, LDS_BYTES, stream);
    if (e != hipSuccess) fprintf(stderr, "kernel_launch: cooperative launch failed: %s (grid %d)\n", hipGetErrorString(e), grid);
#endif
}
```

```cpp
#include <hip/hip_runtime.h>
#include <hip/hip_cooperative_groups.h>
#include <cstdio>
#include <cstdint>
namespace cg = cooperative_groups;

#define LAS __attribute__((address_space(3)))
typedef unsigned short bf16_t;
typedef short bf16x8 __attribute__((ext_vector_type(8)));
typedef float f32x4 __attribute__((ext_vector_type(4)));
typedef float f32x2 __attribute__((ext_vector_type(2)));
typedef unsigned u32x4 __attribute__((ext_vector_type(4)));
typedef unsigned u32x2 __attribute__((ext_vector_type(2)));

#ifndef PROBE_ATT
#define PROBE_ATT 0
#endif
#ifndef PROBE_P0
#define PROBE_P0 0
#endif
#ifndef PROBE_MODE
#define PROBE_MODE 0
#endif
#ifndef PROBE_MLP1
#define PROBE_MLP1 0
#endif
#ifndef PROBE_MLP1_HOT
#define PROBE_MLP1_HOT 0
#endif
#ifndef PROBE_MLP1_NOSTORE
#define PROBE_MLP1_NOSTORE 0
#endif
#ifndef STAGGER_US
#define STAGGER_US 0
#endif
#ifndef PROBE_SYNC
#define PROBE_SYNC 0
#endif
#ifndef MK_MULTI
#define MK_MULTI 0
#endif

constexpr int BATCH = 16, SEQ = 4096, D = 1024, DEPTH = 2, M = BATCH * SEQ;
constexpr int PROJ = 2048, FF = 4096, NMOD = 6 * D, AW = 512;
constexpr int NHEAD = 8;
constexpr float LN_EPS = 1e-5f;
constexpr float DN_ALPHA = 1.41421356237309515f;
constexpr float LOG2E = 1.44269504088896341f;
constexpr float QSCALE = 0.125f * LOG2E;
constexpr int RPB_H = 15, RPB_W = 31, RPB_N = RPB_H * RPB_W;

constexpr size_t MiB = (size_t)1 << 20;
constexpr size_t WS_WIN = 0 * MiB;
constexpr size_t WS_WOUT = 8 * MiB;
constexpr size_t WS_W1 = 12 * MiB;
constexpr size_t WS_W2 = 28 * MiB;
constexpr size_t WS_MOD = 44 * MiB;
constexpr size_t WS_CTL = 46 * MiB;
constexpr size_t WS_X = 48 * MiB;
constexpr size_t WS_H = 304 * MiB;
constexpr size_t WS_F = 432 * MiB;
constexpr size_t WS_Q = 432 * MiB;
constexpr size_t WS_K = 496 * MiB;
constexpr size_t WS_VT = 560 * MiB;
constexpr size_t WS_U = 624 * MiB;
constexpr size_t WS_CAT = 688 * MiB;
constexpr size_t WS_END = 944 * MiB;

constexpr int LDS_BYTES = 147456;

__host__ __device__ __forceinline__ size_t tix(int row, int col) { return (((size_t)(row >> 8) * (D >> 5) + (col >> 5)) * 256 + (row & 255)) * 32 + (col & 31); }

namespace pg8 {
constexpr int BM = 256, BK = 64, HALF = 128, HTB = HALF * BK * 2, STAGE_BYTES = 8 * HTB, NXCD = 8, WGM = 8;
__host__ __device__ __forceinline__ int lds_byte(int r, int c) { const int st = (r >> 4) * 2 + (c >> 5), rr = r & 15, cc = c & 31, ob = rr * 64 + cc * 2; return st * 1024 + (ob ^ (((ob >> 9) & 1) << 5)); }
__host__ __device__ __forceinline__ void stage_rc(int b, int& R, int& C) { const int st = b / 1024, sb = b % 1024, swz = sb ^ (((sb >> 9) & 1) << 5); R = (st >> 1) * 16 + swz / 64; C = (st & 1) * 32 + (swz % 64) / 2; }
__host__ __device__ __forceinline__ int perm32(int rho) { const int n = rho >> 4, i = rho & 15; return 8 * (i >> 2) + 4 * n + (i & 3); }

struct Unit { int pm, pn; };
struct Gemm { const bf16_t* A; const bf16_t* Bt; int M, N, K; };
struct StaticOrder;

struct StaticOrder {
    int nM, nN, nwg, G, c;
    __device__ void init(int M_, int N_, int G_, int c_) { nM = M_ / BM; nN = N_ / BM; nwg = nM * nN; G = G_; c = c_; }
    __device__ bool next(int i, Unit& u) const {
        const long L = (long)i * G + c; if (L >= nwg) return false;
        int wgid = (int)L; { const int q = nwg / NXCD, r = nwg % NXCD, xcd = wgid % NXCD, off = wgid / NXCD; wgid = (xcd < r ? xcd * (q + 1) : r * (q + 1) + (xcd - r) * q) + off; }
        const int nig = WGM * nN, gid = wgid / nig, fm = gid * WGM, gsz = (nM - fm) < WGM ? (nM - fm) : WGM;
        u.pm = fm + ((wgid % nig) % gsz); u.pn = (wgid % nig) / gsz; return true;
    }
};

struct HotOrder : StaticOrder { __device__ bool next(int i, Unit& u) const { const bool r = StaticOrder::next(i, u); u.pm = 0; u.pn = 0; return r; } };
__device__ __forceinline__ unsigned cvt_pk_bf16(float lo, float hi) { unsigned r; asm volatile("v_cvt_pk_bf16_f32 %0, %1, %2" : "=v"(r) : "v"(lo), "v"(hi)); return r; }

struct EpiProj {
    static constexpr bool PERM = true, VSWAP = true, FUSED = false;
    bf16_t* Q; bf16_t* Kb; bf16_t* Vt; bf16_t* U;
    __device__ __forceinline__ void operator()(const f32x4 (&acc)[2][2][4][2], const Unit& u, int wr, int wc, int fr, int fq) const {
        const int t = u.pn >> 1;
        if (t == 2) {
            const int dg0 = (u.pn & 1) * 256 + wr * 64 + fr; const int b = u.pm >> 4; const int s0 = (u.pm & 15) * 256 + wc * 32 + 8 * fq;
#pragma unroll
            for (int ai = 0; ai < 2; ++ai)
#pragma unroll
                for (int m = 0; m < 4; ++m) { const int dg = dg0 + ai * HALF + m * 16;
                    bf16_t* rowp = Vt + ((size_t)(b * 8 + (dg >> 6)) * (SEQ / 8) + (s0 >> 3)) * 512 + (dg & 63) * 8;
#pragma unroll
                    for (int bj = 0; bj < 2; ++bj) { const f32x4 v0 = acc[ai][bj][m][0], v1 = acc[ai][bj][m][1];
                        u32x4 w; w.x = cvt_pk_bf16(v0[0], v0[1]); w.y = cvt_pk_bf16(v0[2], v0[3]); w.z = cvt_pk_bf16(v1[0], v1[1]); w.w = cvt_pk_bf16(v1[2], v1[3]);
                        __builtin_nontemporal_store(w, (u32x4*)(rowp + (size_t)bj * (HALF / 8) * 512)); } }
        } else {
            bf16_t* base = Q + (size_t)t * ((size_t)M * AW); const float sc = t == 0 ? QSCALE : 1.0f;
            const int row0 = u.pm * BM + wr * 64 + fr, col0 = (u.pn & 1) * 256 + wc * 32 + 8 * fq;
            const bool cm = t < 2; const int bq = u.pm >> 4;
#pragma unroll
            for (int ai = 0; ai < 2; ++ai)
#pragma unroll
                for (int m = 0; m < 4; ++m) { const int row = row0 + ai * HALF + m * 16;
                    bf16_t* rowp = cm ? base + ((size_t)(bq * 64 + (col0 >> 3)) * SEQ + (row & (SEQ - 1))) * 8 : base + (size_t)row * AW + col0;
                    const size_t bjs = cm ? (size_t)(HALF / 8) * SEQ * 8 : (size_t)HALF;
#pragma unroll
                    for (int bj = 0; bj < 2; ++bj) { const f32x4 v0 = acc[ai][bj][m][0] * sc, v1 = acc[ai][bj][m][1] * sc;
                        u32x4 w; w.x = cvt_pk_bf16(v0[0], v0[1]); w.y = cvt_pk_bf16(v0[2], v0[3]); w.z = cvt_pk_bf16(v1[0], v1[1]); w.w = cvt_pk_bf16(v1[2], v1[3]);
                        __builtin_nontemporal_store(w, (u32x4*)(rowp + bj * bjs)); } }
        }
    }
};
struct EpiRelu2 {
    static constexpr bool PERM = true, VSWAP = false, FUSED = false;
    bf16_t* O; int ldc; int nostore;
    __device__ __forceinline__ void operator()(const f32x4 (&acc)[2][2][4][2], const Unit& u, int wr, int wc, int fr, int fq) const {
        if (nostore) return;
        const int row0 = u.pm * BM + wr * 64 + fr, col0 = u.pn * BM + wc * 32 + 8 * fq;
#pragma unroll
        for (int ai = 0; ai < 2; ++ai)
#pragma unroll
            for (int m = 0; m < 4; ++m) { bf16_t* rowp = O + (((size_t)u.pm * (ldc >> 5) + (col0 >> 5)) * BM + (wr * 64 + fr + ai * HALF + m * 16)) * 32 + (col0 & 31);
#pragma unroll
                for (int bj = 0; bj < 2; ++bj) { f32x4 v0 = acc[ai][bj][m][0], v1 = acc[ai][bj][m][1];
#pragma unroll
                    for (int j = 0; j < 4; ++j) { const float a = fmaxf(v0[j], 0.f), b = fmaxf(v1[j], 0.f); v0[j] = a * a; v1[j] = b * b; }
                    u32x4 w; w.x = cvt_pk_bf16(v0[0], v0[1]); w.y = cvt_pk_bf16(v0[2], v0[3]); w.z = cvt_pk_bf16(v1[0], v1[1]); w.w = cvt_pk_bf16(v1[2], v1[3]);
                    __builtin_nontemporal_store(w, (u32x4*)(rowp + (size_t)bj * (HALF / 32) * BM * 32)); } }
    }
};
struct EpiRes {
    static constexpr bool PERM = true, VSWAP = false, FUSED = false;
    bf16_t* H; const float* mod; int sh_off, sc_off, g_off;
    __device__ __forceinline__ void operator()(const f32x4 (&acc)[2][2][4][2], const Unit& u, int wr, int wc, int fr, int fq) const {
        const int row0 = u.pm * BM + wr * 64 + fr, col0 = u.pn * BM + wc * 32 + 8 * fq; const int b = u.pm >> 4;
        bf16_t* hb = H + (((size_t)(u.pm * 32 + u.pn * 8 + wc) * 256 + wr * 64 + fr) * 32 + 8 * fq);
        const float* mb = mod + (size_t)b * NMOD + col0;
#pragma unroll
        for (int bj = 0; bj < 2; ++bj) {
            f32x4 shv[2], aiv[2], g1v[2];
#pragma unroll
            for (int n = 0; n < 2; ++n) { shv[n] = *(const f32x4*)(mb + sh_off + bj * HALF + 4 * n); const f32x4 s1 = *(const f32x4*)(mb + sc_off + bj * HALF + 4 * n) + 1.0f;
                aiv[n] = (f32x4){DN_ALPHA / s1.x, DN_ALPHA / s1.y, DN_ALPHA / s1.z, DN_ALPHA / s1.w}; g1v[n] = *(const f32x4*)(mb + g_off + bj * HALF + 4 * n) + 1.0f; }
#pragma unroll
            for (int ai = 0; ai < 2; ++ai) {
                u32x4 hw[4];
#pragma unroll
                for (int m = 0; m < 4; ++m) hw[m] = *(const u32x4*)(hb + bj * (4 * 256 * 32) + (ai * HALF + m * 16) * 32);
#pragma unroll
                for (int m = 0; m < 4; ++m) { const u32x4 w0 = hw[m];
                    f32x4 h0, h1; h0.x = __builtin_bit_cast(float, w0.x << 16); h0.y = __builtin_bit_cast(float, w0.x & 0xffff0000u); h0.z = __builtin_bit_cast(float, w0.y << 16); h0.w = __builtin_bit_cast(float, w0.y & 0xffff0000u);
                    h1.x = __builtin_bit_cast(float, w0.z << 16); h1.y = __builtin_bit_cast(float, w0.z & 0xffff0000u); h1.z = __builtin_bit_cast(float, w0.w << 16); h1.w = __builtin_bit_cast(float, w0.w & 0xffff0000u);
                    const f32x4 z0 = (h0 - shv[0]) * aiv[0] + g1v[0] * acc[ai][bj][m][0], z1 = (h1 - shv[1]) * aiv[1] + g1v[1] * acc[ai][bj][m][1];
                    u32x4 w; w.x = cvt_pk_bf16(z0[0], z0[1]); w.y = cvt_pk_bf16(z0[2], z0[3]); w.z = cvt_pk_bf16(z1[0], z1[1]); w.w = cvt_pk_bf16(z1[2], z1[3]);
                    *(u32x4*)(hb + bj * (4 * 256 * 32) + (ai * HALF + m * 16) * 32) = w; }
                asm volatile("" ::: "memory"); }
        }
    }
};

constexpr int TAB_OFF = 131072 + 2048;
struct PanelStats {
    unsigned long long* xbuf;
    unsigned* cnt;
    __device__ __forceinline__ void run(const f32x4 (&v)[2][2][4][2], const Unit& u, int wr, int wc, int fr, int fq, LAS unsigned char* lds, int wid, int lane) const {
        LAS f32x2* P = (LAS f32x2*)(lds + TAB_OFF);
        LAS f32x2* S = (LAS f32x2*)(lds + TAB_OFF + 8192);
#pragma unroll
        for (int ai = 0; ai < 2; ++ai)
#pragma unroll
            for (int m = 0; m < 4; ++m) {
                float s = 0.f;
#pragma unroll
                for (int bj = 0; bj < 2; ++bj)
#pragma unroll
                    for (int n = 0; n < 2; ++n) { const f32x4 x = v[ai][bj][m][n]; s += (x[0] + x[1]) + (x[2] + x[3]); }
                s += __shfl_xor(s, 16); s += __shfl_xor(s, 32);
                const float mw = s * (1.0f / 64.0f); float q = 0.f;
#pragma unroll
                for (int bj = 0; bj < 2; ++bj)
#pragma unroll
                    for (int n = 0; n < 2; ++n) { const f32x4 d = v[ai][bj][m][n] - mw; q += (d[0] * d[0] + d[1] * d[1]) + (d[2] * d[2] + d[3] * d[3]); }
                q += __shfl_xor(q, 16); q += __shfl_xor(q, 32);
                if (fq == 0) P[(ai * HALF + wr * 64 + m * 16 + fr) * 4 + wc] = (f32x2){mw, q};
            }
        asm volatile("s_waitcnt lgkmcnt(0)" ::: "memory"); __builtin_amdgcn_s_barrier(); asm volatile("" ::: "memory");
        const int row = wid * 32 + (lane & 31);
        if (lane < 32) {
            const f32x2 a = P[row * 4 + 0], b = P[row * 4 + 1], c = P[row * 4 + 2], d = P[row * 4 + 3];
            const float mt = (a.x + b.x + c.x + d.x) * 0.25f;
            const float da = a.x - mt, db = b.x - mt, dc = c.x - mt, dd = d.x - mt;
            const float m2 = (a.y + b.y) + (c.y + d.y) + 64.0f * ((da * da + db * db) + (dc * dc + dd * dd));
            unsigned long long* slot = xbuf + ((size_t)(u.pm * BM + row) * 4 + u.pn);
            __hip_atomic_store(slot, ((unsigned long long)__float_as_uint(m2) << 32) | __float_as_uint(mt), __ATOMIC_RELAXED, __HIP_MEMORY_SCOPE_AGENT);
        }
        asm volatile("s_waitcnt vmcnt(0)" ::: "memory");
        if (lane == 0) __hip_atomic_fetch_add(cnt + 64 * u.pm, 1u, __ATOMIC_RELAXED, __HIP_MEMORY_SCOPE_AGENT);
        if (wid == 0) {
            unsigned sp = 0;
            while ((unsigned)__builtin_amdgcn_readfirstlane(__hip_atomic_load(cnt + 64 * u.pm, __ATOMIC_RELAXED, __HIP_MEMORY_SCOPE_AGENT)) < 32u) { __builtin_amdgcn_s_sleep(2); if (++sp > (1u << 20)) break; }
            __builtin_amdgcn_fence(__ATOMIC_ACQUIRE, "agent");
        }
        asm volatile("s_waitcnt vmcnt(0) lgkmcnt(0)" ::: "memory"); __builtin_amdgcn_s_barrier(); asm volatile("" ::: "memory");
        if (lane < 32) {
            const unsigned long long* slot = xbuf + (size_t)(u.pm * BM + row) * 4; float mt[4], m2[4]; float ms = 0.f;
#pragma unroll
            for (int t = 0; t < 4; ++t) { const unsigned long long w = __hip_atomic_load(slot + t, __ATOMIC_RELAXED, __HIP_MEMORY_SCOPE_AGENT); mt[t] = __uint_as_float((unsigned)w); m2[t] = __uint_as_float((unsigned)(w >> 32)); ms += mt[t]; }
            const float mean = ms * 0.25f; float q = 0.f;
#pragma unroll
            for (int t = 0; t < 4; ++t) { const float dm = mt[t] - mean; q += m2[t] + 256.0f * dm * dm; }
            S[row] = (f32x2){mean, 1.0f / sqrtf(q * (1.0f / 1024.0f) + LN_EPS)};
        }
        asm volatile("s_waitcnt lgkmcnt(0)" ::: "memory"); __builtin_amdgcn_s_barrier(); asm volatile("" ::: "memory");
    }
};
template <bool OUT_F32> struct EpiResLn {
    static constexpr bool PERM = true, VSWAP = false, FUSED = true;
    bf16_t* H; float* outF; const float* mod; int sh_off, sc_off, g_off; const float* lng; const float* lnb; const float* mod2; int sh2_off, sc2_off; PanelStats st;
    __device__ __forceinline__ void fused(f32x4 (&acc)[2][2][4][2], const Unit& u, int wr, int wc, int fr, int fq, LAS unsigned char* lds, int wid, int lane) const {
        const int row0 = u.pm * BM + wr * 64 + fr, col0 = u.pn * BM + wc * 32 + 8 * fq; const int b = u.pm >> 4;
        bf16_t* hb = H + (((size_t)(u.pm * 32 + u.pn * 8 + wc) * 256 + wr * 64 + fr) * 32 + 8 * fq);
        const float* mb = mod + (size_t)b * NMOD + col0;
#pragma unroll
        for (int bj = 0; bj < 2; ++bj) {
            u32x4 hw[2][4];
#pragma unroll
            for (int ai = 0; ai < 2; ++ai)
#pragma unroll
                for (int m = 0; m < 4; ++m) hw[ai][m] = *(const u32x4*)(hb + bj * (4 * 256 * 32) + (ai * HALF + m * 16) * 32);
#pragma unroll
            for (int n = 0; n < 2; ++n) {
                const f32x4 shv = *(const f32x4*)(mb + sh_off + bj * HALF + 4 * n); const f32x4 s1 = *(const f32x4*)(mb + sc_off + bj * HALF + 4 * n) + 1.0f;
                const f32x4 aiv = (f32x4){DN_ALPHA * __builtin_amdgcn_rcpf(s1.x), DN_ALPHA * __builtin_amdgcn_rcpf(s1.y), DN_ALPHA * __builtin_amdgcn_rcpf(s1.z), DN_ALPHA * __builtin_amdgcn_rcpf(s1.w)};
                const f32x4 g1v = *(const f32x4*)(mb + g_off + bj * HALF + 4 * n) + 1.0f;
#pragma unroll
                for (int ai = 0; ai < 2; ++ai)
#pragma unroll
                    for (int m = 0; m < 4; ++m) { const unsigned wa = n ? hw[ai][m].z : hw[ai][m].x, wb = n ? hw[ai][m].w : hw[ai][m].y;
                        f32x4 h0; h0.x = __builtin_bit_cast(float, wa << 16); h0.y = __builtin_bit_cast(float, wa & 0xffff0000u); h0.z = __builtin_bit_cast(float, wb << 16); h0.w = __builtin_bit_cast(float, wb & 0xffff0000u);
                        acc[ai][bj][m][n] = (h0 - shv) * aiv + g1v * acc[ai][bj][m][n]; }
            }
#pragma unroll
            for (int ai = 0; ai < 2; ++ai) {
                asm volatile("" : "+v"(acc[ai][bj][0][0]), "+v"(acc[ai][bj][0][1]), "+v"(acc[ai][bj][1][0]), "+v"(acc[ai][bj][1][1]));
                asm volatile("" : "+v"(acc[ai][bj][2][0]), "+v"(acc[ai][bj][2][1]), "+v"(acc[ai][bj][3][0]), "+v"(acc[ai][bj][3][1])); }
            asm volatile("" ::: "memory");
        }
        st.run(acc, u, wr, wc, fr, fq, lds, wid, lane);
        const LAS f32x2* S = (const LAS f32x2*)(lds + TAB_OFF + 8192);
        const float* m2b = mod2 + (size_t)b * NMOD + col0;
#pragma unroll
        for (int bj = 0; bj < 2; ++bj) {
            f32x4 Av[2], Bv[2];
#pragma unroll
            for (int n = 0; n < 2; ++n) { const f32x4 gl = *(const f32x4*)(lng + col0 + bj * HALF + 4 * n), bl = *(const f32x4*)(lnb + col0 + bj * HALF + 4 * n);
                if (OUT_F32) { Av[n] = gl; Bv[n] = bl; }
                else { const f32x4 s1 = *(const f32x4*)(m2b + sc2_off + bj * HALF + 4 * n) + 1.0f, sh2 = *(const f32x4*)(m2b + sh2_off + bj * HALF + 4 * n); Av[n] = gl * s1; Bv[n] = bl * s1 + sh2; } }
#pragma unroll
            for (int ai = 0; ai < 2; ++ai)
#pragma unroll
                for (int m = 0; m < 4; ++m) { const int r = ai * HALF + wr * 64 + m * 16 + fr; const f32x2 sr = S[r];
                    const f32x4 o0 = (acc[ai][bj][m][0] - sr.x) * sr.y * Av[0] + Bv[0], o1 = (acc[ai][bj][m][1] - sr.x) * sr.y * Av[1] + Bv[1];
                    if (OUT_F32) { float* p = outF + (size_t)(u.pm * BM + r) * D + col0 + bj * HALF; *(f32x4*)p = o0; *(f32x4*)(p + 4) = o1; }
                    else { u32x4 w; w.x = cvt_pk_bf16(o0[0], o0[1]); w.y = cvt_pk_bf16(o0[2], o0[3]); w.z = cvt_pk_bf16(o1[0], o1[1]); w.w = cvt_pk_bf16(o1[2], o1[3]);
                        *(u32x4*)(hb + bj * (4 * 256 * 32) + (ai * HALF + m * 16) * 32) = w; } }
        }
    }
};

template <class Epi, bool ALIGN_EPI, class Sched = StaticOrder, bool ACM = false, bool BCM = false>
__device__ __forceinline__ void gemm_phase(LAS unsigned char* lds, const Gemm g, const Sched& S, const Epi& E) {
    int tid = threadIdx.x; asm volatile("" : "+v"(tid));
    const int wid = __builtin_amdgcn_readfirstlane(tid >> 6), lane = tid & 63, wr = wid >> 2, wc = wid & 3, fr = lane & 15, fq = lane >> 4;
    const int K = g.K, nt = K / BK;
    unsigned voffA[2], voffB[2];
#pragma unroll
    for (int i = 0; i < 2; ++i) { int R, C; stage_rc(tid * 16 + i * 8192, R, C); const int Rb = Epi::PERM ? ((R & ~31) + perm32(R & 31)) : R;
        voffA[i] = ACM ? (unsigned)(((C >> 5) * BM + R) * 64 + (C & 31) * 2) : (unsigned)(R * K + C) * 2u; voffB[i] = BCM ? (unsigned)(((C >> 5) * BM + Rb) * 64 + (C & 31) * 2) : (unsigned)(Rb * K + C) * 2u; }
    static_assert(!Epi::VSWAP || (ACM == BCM), "operand swapping needs A and B in the same layout");
    const size_t kstepR = (size_t)(BK * 2), hstepR = (size_t)HALF * K * 2, tstepR = 2 * hstepR;
    const size_t kstepT = (size_t)(BK / 32) * BM * 64, hstepT = (size_t)HALF * 64, tstepT = (size_t)(K / 32) * BM * 64;
    const size_t kstepA = ACM ? kstepT : kstepR, hstepA = ACM ? hstepT : hstepR, tstepA = ACM ? tstepT : tstepR;
    const size_t kstepB = BCM ? kstepT : kstepR, hstepB = BCM ? hstepT : hstepR, tstepB = BCM ? tstepT : tstepR;
    const unsigned ldsw = (unsigned)wid * 1024u;
    const int aoff = lds_byte(wr * 64 + fr, fq * 8), boff = lds_byte(wc * 32 + fr, fq * 8);
#define PG8_SA(b, h) (((b) * 2 + (h)) * HTB)
#define PG8_SB(b, h) ((4 + (b) * 2 + (h)) * HTB)
#define PG8_STAGE(bufoff, gbase, voff) do { _Pragma("unroll") for (int _i = 0; _i < 2; ++_i) \
        __builtin_amdgcn_global_load_lds((const unsigned*)((const char*)(gbase) + (voff)[_i]), (LAS unsigned*)(lds + (bufoff) + ldsw + _i * 8192), 16, 0, 0); } while (0)
#define PG8_LDA(dst, b, h) do { _Pragma("unroll") for (int m = 0; m < 4; ++m) _Pragma("unroll") for (int k = 0; k < 2; ++k) dst[m][k] = *(const LAS bf16x8*)(lds + PG8_SA(b, h) + aoff + m * 2048 + k * 1024); } while (0)
#define PG8_LDB(dst, b, h) do { _Pragma("unroll") for (int n = 0; n < 2; ++n) _Pragma("unroll") for (int k = 0; k < 2; ++k) dst[n][k] = *(const LAS bf16x8*)(lds + PG8_SB(b, h) + boff + n * 2048 + k * 1024); } while (0)
#define PG8_MMA(ai, bj, At, Bt) do { __builtin_amdgcn_s_setprio(1); _Pragma("unroll") for (int m = 0; m < 4; ++m) _Pragma("unroll") for (int n = 0; n < 2; ++n) _Pragma("unroll") for (int k = 0; k < 2; ++k) \
        acc[ai][bj][m][n] = __builtin_amdgcn_mfma_f32_16x16x32_bf16(Bt[n][k], At[m][k], acc[ai][bj][m][n], 0, 0, 0); __builtin_amdgcn_s_setprio(0); } while (0)
#define PG8_WAIT_V(n) asm volatile("s_waitcnt vmcnt(" #n ")" ::: "memory")
#define PG8_WAIT_L(n) asm volatile("s_waitcnt lgkmcnt(" #n ")" ::: "memory")
#define PG8_BAR __builtin_amdgcn_s_barrier()
#define PG8_SCHED __builtin_amdgcn_sched_barrier(0)
#define PG8_PTRS(u, pa, pb) do { const bool _sw = Epi::VSWAP && (((u).pn >> 1) == 2); const char* _a = (const char*)g.A + (size_t)(u).pm * tstepA; const char* _b = (const char*)g.Bt + (size_t)(u).pn * tstepB; pa = _sw ? _b : _a; pb = _sw ? _a : _b; } while (0)
    Unit cur, nxt; int ui = 0;
    if (!S.next(0, cur)) return;
    f32x4 acc[2][2][4][2];
#pragma unroll
    for (int a = 0; a < 2; ++a)
#pragma unroll
        for (int b = 0; b < 2; ++b)
#pragma unroll
            for (int m = 0; m < 4; ++m)
#pragma unroll
                for (int n = 0; n < 2; ++n) acc[a][b][m][n] = (f32x4){0.f, 0.f, 0.f, 0.f};
    bf16x8 At[4][2], B0[2][2], B1[2][2];
    const char* cA; const char* cB; PG8_PTRS(cur, cA, cB);
    PG8_STAGE(PG8_SB(0, 0), cB, voffB); PG8_STAGE(PG8_SB(0, 1), cB + hstepB, voffB); PG8_STAGE(PG8_SA(0, 0), cA, voffA); PG8_STAGE(PG8_SA(0, 1), cA + hstepA, voffA);
    if (wr == 1) PG8_BAR;
    PG8_WAIT_V(2); PG8_BAR;
    PG8_STAGE(PG8_SB(1, 0), cB + kstepB, voffB); PG8_STAGE(PG8_SA(1, 0), cA + kstepA, voffA); PG8_STAGE(PG8_SB(1, 1), cB + hstepB + kstepB, voffB);
    PG8_WAIT_V(6); PG8_BAR;
    for (;;) {
        const bool has_next = S.next(ui + 1, nxt);
        const char* nA = cA; const char* nB = cB; if (has_next) { PG8_PTRS(nxt, nA, nB); }
        for (int t = 0; t < nt; t += 2) {
            const bool last = (t == nt - 2);
            const char* a1 = cA + (size_t)(t + 1) * kstepA;
            const char* a2 = last ? nA : cA + (size_t)(t + 2) * kstepA; const char* b2 = last ? nB : cB + (size_t)(t + 2) * kstepB;
            const char* a3 = a2 + kstepA; const char* b3 = b2 + kstepB;
            PG8_LDB(B0, 0, 0); PG8_LDB(B1, 0, 1); PG8_SCHED; PG8_LDA(At, 0, 0); PG8_STAGE(PG8_SA(1, 1), a1 + hstepA, voffA);
            PG8_WAIT_V(8); PG8_WAIT_L(0); PG8_BAR; PG8_MMA(0, 0, At, B0); PG8_MMA(0, 1, At, B1); PG8_BAR; PG8_SCHED;
            PG8_LDA(At, 0, 1); PG8_STAGE(PG8_SB(0, 0), b2, voffB); PG8_STAGE(PG8_SB(0, 1), b2 + hstepB, voffB); PG8_STAGE(PG8_SA(0, 0), a2, voffA);
            PG8_WAIT_V(8); PG8_WAIT_L(0); PG8_BAR; PG8_MMA(1, 0, At, B0); PG8_MMA(1, 1, At, B1); PG8_BAR; PG8_SCHED;
            PG8_LDB(B0, 1, 0); PG8_LDB(B1, 1, 1); PG8_SCHED; PG8_LDA(At, 1, 0); PG8_STAGE(PG8_SA(0, 1), a2 + hstepA, voffA);
            PG8_WAIT_V(8); PG8_WAIT_L(0); PG8_BAR; PG8_MMA(0, 0, At, B0); PG8_MMA(0, 1, At, B1); PG8_BAR; PG8_SCHED;
            PG8_LDA(At, 1, 1); PG8_STAGE(PG8_SB(1, 0), b3, voffB); PG8_STAGE(PG8_SB(1, 1), b3 + hstepB, voffB); PG8_STAGE(PG8_SA(1, 0), a3, voffA);
            PG8_WAIT_V(8); PG8_WAIT_L(0); PG8_BAR; PG8_MMA(1, 0, At, B0); PG8_MMA(1, 1, At, B1); PG8_BAR; PG8_SCHED;
        }
        if constexpr (ALIGN_EPI) { if (wr == 0) PG8_BAR; }
        if constexpr (Epi::FUSED) E.fused(acc, cur, wr, wc, fr, fq, lds, wid, lane); else E(acc, cur, wr, wc, fr, fq);
        if (!has_next) break;
#pragma unroll
        for (int a = 0; a < 2; ++a)
#pragma unroll
            for (int b = 0; b < 2; ++b)
#pragma unroll
                for (int m = 0; m < 4; ++m)
#pragma unroll
                    for (int n = 0; n < 2; ++n) acc[a][b][m][n] = (f32x4){0.f, 0.f, 0.f, 0.f};
        cur = nxt; cA = nA; cB = nB; ++ui;
        if constexpr (ALIGN_EPI) { if (wr == 1) PG8_BAR; }
    }
    PG8_WAIT_V(0);
    if constexpr (!ALIGN_EPI) { if (wr == 0) PG8_BAR; }
    PG8_BAR;
#undef PG8_SA
#undef PG8_SB
#undef PG8_STAGE
#undef PG8_LDA
#undef PG8_LDB
#undef PG8_MMA
#undef PG8_WAIT_V
#undef PG8_WAIT_L
#undef PG8_BAR
#undef PG8_SCHED
#undef PG8_PTRS
}
}

#define XB_TMO      128
#define XB_XCNT(j)  (256  + 64 * (j))
#define XB_XSUB(j)  (1280 + 64 * (j))
#define XB_XGEN(j)  (2304 + 64 * (j))
#define XB_TOP      3328
#define XB_TOPGEN   3392
#define XCD_BAR_WORDS 3456
#define XB_SPIN_CAP (1u << 18)
__device__ __forceinline__ unsigned xb_ld(unsigned* p)              { return __hip_atomic_load(p, __ATOMIC_RELAXED, __HIP_MEMORY_SCOPE_AGENT); }
__device__ __forceinline__ unsigned xb_add(unsigned* p, unsigned v) { return __hip_atomic_fetch_add(p, v, __ATOMIC_RELAXED, __HIP_MEMORY_SCOPE_AGENT); }
__device__ __forceinline__ unsigned xb_xcc_id() { return (unsigned)__builtin_amdgcn_s_getreg((3 << 11) | 20) & 0xFu; }
#define XB_SPIN(cond, bar) do { unsigned _sp = 0; while (cond) { __builtin_amdgcn_s_sleep(1); \
    if ((++_sp & 255u) == 0u) { if (xb_ld(&(bar)[XB_TMO])) break; if (_sp > XB_SPIN_CAP) { atomicAdd(&(bar)[XB_TMO], 1u); break; } } } } while (0)
struct XcdBarrier { unsigned* bar; unsigned x; volatile LAS unsigned* st; };
__device__ __forceinline__ XcdBarrier xcd_barrier_post(unsigned* bar, volatile LAS unsigned* st) {
    XcdBarrier b; b.bar = bar; b.x = xb_xcc_id(); b.st = st;
    if (threadIdx.x == 0) (void)xb_add(&bar[XB_XCNT(b.x)], 1u);
    return b;
}
__device__ __forceinline__ void xcd_barrier_complete(unsigned* bar, unsigned x, unsigned& nloc, unsigned& nx) {
    const unsigned G = gridDim.x * gridDim.y * gridDim.z;
    unsigned sum, cnt, mine, sp = 0u;
    for (;;) {
        sum = 0u; cnt = 0u; mine = 0u;
#pragma unroll
        for (unsigned j = 0; j < 16; ++j) { const unsigned c = xb_ld(&bar[XB_XCNT(j)]); sum += c; cnt += (c > 0u) ? 1u : 0u; mine = (j == x) ? c : mine; }
        if (sum == G) break;
        __builtin_amdgcn_s_sleep(1);
        if ((++sp & 255u) == 0u) { if (xb_ld(&bar[XB_TMO])) break; if (sp > XB_SPIN_CAP) { atomicAdd(&bar[XB_TMO], 1u); break; } }
    }
    nloc = mine > 0u ? mine : 1u; nx = cnt > 0u ? cnt : 1u;
}
__device__ __forceinline__ void xcd_barrier(const XcdBarrier& b) {
    asm volatile("s_waitcnt vmcnt(0)" ::: "memory");
    __syncthreads();
    if (threadIdx.x == 0) {
        unsigned* bar = b.bar;
        __builtin_amdgcn_s_waitcnt(0);
        unsigned nloc = b.st[0], nx = b.st[1];
        if (nloc == 0u) { xcd_barrier_complete(bar, b.x, nloc, nx); b.st[0] = nloc; b.st[1] = nx; }
        const unsigned old = xb_add(&bar[XB_XSUB(b.x)], 1u);
        const unsigned gen = old / nloc;
        if (old + 1u == (gen + 1u) * nloc) {
            __builtin_amdgcn_fence(__ATOMIC_RELEASE, "agent");
            asm volatile("s_waitcnt vmcnt(0)" ::: "memory");
            const unsigned og = xb_add(&bar[XB_TOP], 1u);
            const unsigned tg = og / nx;
            if (og + 1u == (tg + 1u) * nx) xb_add(&bar[XB_TOPGEN], 1u);
            else XB_SPIN(xb_ld(&bar[XB_TOPGEN]) == tg, bar);
            __builtin_amdgcn_fence(__ATOMIC_ACQUIRE, "agent");
            xb_add(&bar[XB_XGEN(b.x)], 1u);
            asm volatile("s_waitcnt vmcnt(0)" ::: "memory");
        } else {
            XB_SPIN(xb_ld(&bar[XB_XGEN(b.x)]) == gen, bar);
            __builtin_amdgcn_fence(__ATOMIC_ACQUIRE, "agent");
            asm volatile("s_waitcnt vmcnt(0)" ::: "memory");
        }
    }
    __syncthreads();
}

__device__ __forceinline__ unsigned f2bf(float f) { unsigned u = __builtin_bit_cast(unsigned, f); return (u + 0x7fffu + ((u >> 16) & 1u)) >> 16; }
__device__ __forceinline__ unsigned pk2(float lo, float hi) { return f2bf(lo) | (f2bf(hi) << 16); }
__device__ __forceinline__ float bflo(unsigned w) { return __builtin_bit_cast(float, w << 16); }
__device__ __forceinline__ float bfhi(unsigned w) { return __builtin_bit_cast(float, w & 0xffff0000u); }
__device__ __forceinline__ float wave_sum(float v) {
#pragma unroll
    for (int o = 1; o < 64; o <<= 1) v += __shfl_xor(v, o);
    return v;
}

template <bool TILED>
__device__ __forceinline__ void transpose_item(const float* W, int N, bf16_t* WT, int ldw, LAS float* scr, int kb, int nb, int lane) {
    const int k0 = 64 * kb, n0 = 32 * nb;
    f32x4 wv[8];
#pragma unroll
    for (int i = 0; i < 8; ++i) wv[i] = *(const f32x4*)(W + (size_t)(k0 + 8 * i + (lane >> 3)) * N + n0 + (lane & 7) * 4);
#pragma unroll
    for (int i = 0; i < 8; ++i) { LAS float* d = scr + (8 * i + (lane >> 3)) * 33 + (lane & 7) * 4; d[0] = wv[i].x; d[1] = wv[i].y; d[2] = wv[i].z; d[3] = wv[i].w; }
    asm volatile("s_waitcnt lgkmcnt(0)" ::: "memory");
    const int c = lane & 7;
#pragma unroll
    for (int j = 0; j < 4; ++j) { const int n = (lane >> 3) + 8 * j; const LAS float* s = scr + (8 * c) * 33 + n;
        u32x4 o; o.x = pk2(s[0 * 33], s[1 * 33]); o.y = pk2(s[2 * 33], s[3 * 33]); o.z = pk2(s[4 * 33], s[5 * 33]); o.w = pk2(s[6 * 33], s[7 * 33]);
        const int nn = n0 + n, kk = k0 + 8 * c;
        bf16_t* dst = TILED ? WT + (((size_t)(nn >> 8) * (ldw >> 5) + (kk >> 5)) * 256 + (nn & 255)) * 32 + (kk & 31) : WT + (size_t)nn * ldw + kk;
        *(u32x4*)dst = o; }
    asm volatile("s_waitcnt lgkmcnt(0)" ::: "memory");
}

struct Args {
    const float *x, *c, *ln_in_g, *ln_in_b, *w_ada, *b_ada, *w_in, *rpb, *w_pool, *pool_scale, *w_out, *ln1_g, *ln1_b, *w_mlp1, *w_mlp2, *ln2_g, *ln2_b;
    float* out; unsigned char* ws; int ph_lo, ph_hi;
};

__device__ __forceinline__ void p0_prologue(const Args& a, LAS unsigned char* lds, int G, int bid, int tid) {
    asm volatile("" : "+v"(tid));
    const int lane = tid & 63, wave = tid >> 6;
    unsigned char* ws = a.ws;
    float* mod = (float*)(ws + WS_MOD);
    for (int item = bid; item < 2 * (NMOD / 64); item += G) {
        const int l = item / (NMOD / 64), n0 = (item % (NMOD / 64)) * 64;
        LAS float* cact = (LAS float*)lds;
        LAS float* red = (LAS float*)(lds + 65536);
        for (int i = tid; i < BATCH * D; i += 512) { const int b = i >> 10, k = i & 1023; const float v = a.c[i]; cact[k * 16 + b] = v / (1.0f + expf(-v)); }
        __syncthreads();
        const int ks = tid >> 6, col = tid & 63;
        float acc[16];
#pragma unroll
        for (int b = 0; b < 16; ++b) acc[b] = 0.f;
        const float* wp = a.w_ada + (size_t)l * D * NMOD + (size_t)(ks * 128) * NMOD + n0 + col;
#pragma unroll 4
        for (int kk = 0; kk < 128; ++kk) {
            const float w = wp[(size_t)kk * NMOD];
            const LAS f32x4* cp = (const LAS f32x4*)(cact + (ks * 128 + kk) * 16);
#pragma unroll
            for (int q = 0; q < 4; ++q) { const f32x4 cv = cp[q]; acc[4 * q + 0] += cv.x * w; acc[4 * q + 1] += cv.y * w; acc[4 * q + 2] += cv.z * w; acc[4 * q + 3] += cv.w * w; }
        }
#pragma unroll
        for (int b = 0; b < 16; ++b) red[(ks * 16 + b) * 64 + col] = acc[b];
        __syncthreads();
        for (int o = tid; o < 1024; o += 512) { const int b = o >> 6, cc = o & 63; float s = 0.f;
#pragma unroll
            for (int k8 = 0; k8 < 8; ++k8) s += red[(k8 * 16 + b) * 64 + cc];
            mod[(size_t)(l * 16 + b) * NMOD + n0 + cc] = s + a.b_ada[l * NMOD + n0 + cc]; }
        __syncthreads();
    }
    for (int idx = bid * 512 + tid; idx < 2 * 4 * 16 * 1024; idx += G * 512) {
        const int l = idx >> 16, g = (idx >> 14) & 3, cch = (idx >> 10) & 15, n = idx & 1023;
        const float* wo = a.w_out + (size_t)l * D * D + (size_t)(512 + g * 128) * D + n;
        const float* wpl = a.w_pool + ((size_t)(l * 4 + g) * 128 + cch * 8) * 128;
        const float* ps = a.pool_scale + l * 512 + g * 128;
        float acc[8];
#pragma unroll
        for (int i = 0; i < 8; ++i) acc[i] = 0.f;
#pragma unroll 4
        for (int d = 0; d < 128; ++d) { const float v = wo[(size_t)d * D] * ps[d];
#pragma unroll
            for (int i = 0; i < 8; ++i) acc[i] += wpl[i * 128 + d] * v; }
        u32x4 o; o.x = pk2(acc[0], acc[1]); o.y = pk2(acc[2], acc[3]); o.z = pk2(acc[4], acc[5]); o.w = pk2(acc[6], acc[7]);
        { const int kk = 512 + g * 128 + cch * 8;
          *(u32x4*)((bf16_t*)(ws + WS_WOUT) + (size_t)l * D * D + (((size_t)(n >> 8) * (D >> 5) + (kk >> 5)) * 256 + (n & 255)) * 32 + (kk & 31)) = o; }
    }
    {
        LAS float* scr = (LAS float*)(lds + wave * 16384);
        const int gw = bid * 8 + wave, NGW = G * 8;
        constexpr int I_IN = 16 * 64, I_OUT = 8 * 32, I_1 = 16 * 128, I_2 = 64 * 32, I_L = I_IN + I_OUT + I_1 + I_2;
        for (int it = gw; it < 2 * I_L; it += NGW) {
            const int l = it / I_L; int r = it % I_L;
            if (r < I_IN) { transpose_item<true>(a.w_in + (size_t)l * D * PROJ, PROJ, (bf16_t*)(ws + WS_WIN) + (size_t)l * PROJ * D, D, scr, r / 64, r % 64, lane); continue; } r -= I_IN;
            if (r < I_OUT) { transpose_item<true>(a.w_out + (size_t)l * D * D, D, (bf16_t*)(ws + WS_WOUT) + (size_t)l * D * D, D, scr, r / 32, r % 32, lane); continue; } r -= I_OUT;
            if (r < I_1) { transpose_item<true>(a.w_mlp1 + (size_t)l * D * FF, FF, (bf16_t*)(ws + WS_W1) + (size_t)l * FF * D, D, scr, r / 128, r % 128, lane); continue; } r -= I_1;
            transpose_item<true>(a.w_mlp2 + (size_t)l * FF * D, D, (bf16_t*)(ws + WS_W2) + (size_t)l * D * FF, FF, scr, r / 32, r % 32, lane);
        }
    }
}

template <bool SRC_BF16, bool OUT_F32>
__device__ __forceinline__ void ln_phase(const void* srcv, float* dstF, bf16_t* dstH, const float* g, const float* bt, const float* sc, const float* sh, int G, int bid, int tid) {
    asm volatile("" : "+v"(tid));
    const int lane = tid & 63, wave = tid >> 6;
    const int gw = bid * 8 + wave, NGW = G * 8;
    const int rpw = (((M + NGW - 1) / NGW) + 3) & ~3;
    const int r0 = gw * rpw, r1 = (r0 + rpw < M) ? r0 + rpw : M;
    if (r0 >= M) return;
    const int c0 = 8 * lane;
    f32x4 gv[4], bv[4], scv[4], shv[4];
#pragma unroll
    for (int j = 0; j < 4; ++j) { const int cj = c0 + (j >> 1) * 512 + (j & 1) * 4; gv[j] = *(const f32x4*)(g + cj); bv[j] = *(const f32x4*)(bt + cj); scv[j] = (f32x4){1.f, 1.f, 1.f, 1.f}; shv[j] = (f32x4){0.f, 0.f, 0.f, 0.f}; }
    int curb = -1;
    for (int r = r0; r < r1; r += 4) {
        f32x4 nf[4][4]; u32x4 nb[4][2];
#pragma unroll
        for (int q = 0; q < 4; ++q) {
            if (SRC_BF16) { const bf16_t* p = (const bf16_t*)srcv + tix(r, c0) + q * 32; nb[q][0] = *(const u32x4*)p; nb[q][1] = *(const u32x4*)(p + 16 * 256 * 32); }
            else { const float* p = (const float*)srcv + (size_t)(r + q) * D + c0; nf[q][0] = *(const f32x4*)p; nf[q][1] = *(const f32x4*)(p + 4); nf[q][2] = *(const f32x4*)(p + 512); nf[q][3] = *(const f32x4*)(p + 516); }
        }
        const int b = r >> 12;
        if (!OUT_F32 && b != curb) { curb = b;
#pragma unroll
            for (int j = 0; j < 4; ++j) { const int cj = c0 + (j >> 1) * 512 + (j & 1) * 4; scv[j] = *(const f32x4*)(sc + (size_t)b * NMOD + cj) + 1.0f; shv[j] = *(const f32x4*)(sh + (size_t)b * NMOD + cj); } }
#pragma unroll
        for (int q = 0; q < 4; ++q) {
            f32x4 v[4];
            if (SRC_BF16) {
#pragma unroll
                for (int t = 0; t < 2; ++t) { const u32x4 w = nb[q][t]; v[2 * t].x = bflo(w.x); v[2 * t].y = bfhi(w.x); v[2 * t].z = bflo(w.y); v[2 * t].w = bfhi(w.y); v[2 * t + 1].x = bflo(w.z); v[2 * t + 1].y = bfhi(w.z); v[2 * t + 1].z = bflo(w.w); v[2 * t + 1].w = bfhi(w.w); }
            } else {
#pragma unroll
                for (int j = 0; j < 4; ++j) v[j] = nf[q][j];
            }
            float s = 0.f;
#pragma unroll
            for (int j = 0; j < 4; ++j) s += (v[j].x + v[j].y) + (v[j].z + v[j].w);
            const float mean = wave_sum(s) * (1.f / D); float s2 = 0.f;
#pragma unroll
            for (int j = 0; j < 4; ++j) { v[j] = v[j] - mean; s2 += (v[j].x * v[j].x + v[j].y * v[j].y) + (v[j].z * v[j].z + v[j].w * v[j].w); }
            const float rstd = 1.f / sqrtf(wave_sum(s2) * (1.f / D) + LN_EPS);
#pragma unroll
            for (int j = 0; j < 4; ++j) v[j] = v[j] * rstd * gv[j] + bv[j];
            if (OUT_F32) { float* p = dstF + (size_t)(r + q) * D + c0; *(f32x4*)p = v[0]; *(f32x4*)(p + 4) = v[1]; *(f32x4*)(p + 512) = v[2]; *(f32x4*)(p + 516) = v[3]; }
            else {
#pragma unroll
                for (int j = 0; j < 4; ++j) v[j] = v[j] * scv[j] + shv[j];
                u32x4 w0, w1; w0.x = pk2(v[0].x, v[0].y); w0.y = pk2(v[0].z, v[0].w); w0.z = pk2(v[1].x, v[1].y); w0.w = pk2(v[1].z, v[1].w);
                w1.x = pk2(v[2].x, v[2].y); w1.y = pk2(v[2].z, v[2].w); w1.z = pk2(v[3].x, v[3].y); w1.w = pk2(v[3].z, v[3].w);
                bf16_t* p = dstH + tix(r, c0) + q * 32; *(u32x4*)p = w0; *(u32x4*)(p + 16 * 256 * 32) = w1;
            }
        }
    }
}

__device__ __forceinline__ void add8(float (&s)[8], const u32x4 w) { s[0] += bflo(w.x); s[1] += bfhi(w.x); s[2] += bflo(w.y); s[3] += bfhi(w.y); s[4] += bflo(w.z); s[5] += bfhi(w.z); s[6] += bflo(w.w); s[7] += bfhi(w.w); }
__device__ __forceinline__ void sub8(float (&s)[8], const u32x4 w) { s[0] -= bflo(w.x); s[1] -= bfhi(w.x); s[2] -= bflo(w.y); s[3] -= bfhi(w.y); s[4] -= bflo(w.z); s[5] -= bfhi(w.z); s[6] -= bflo(w.w); s[7] -= bfhi(w.w); }
template <int W>
__device__ __forceinline__ void pool_lane(const bf16_t* Ubc  , bf16_t* catc  , int T0) {
    constexpr int HW = W / 2, NL = 8 + W - 1;
    u32x4 raw[NL];
#pragma unroll
    for (int k = 0; k < NL; ++k) { const int tk = T0 - HW + k; const int tc = tk < 0 ? 0 : (tk > SEQ - 1 ? SEQ - 1 : tk); u32x4 v = *(const u32x4*)(Ubc + (size_t)tc * AW);
        if (tk != tc) v = (u32x4){0u, 0u, 0u, 0u}; raw[k] = v; }
    float sm[8];
#pragma unroll
    for (int e = 0; e < 8; ++e) sm[e] = 0.f;
#pragma unroll
    for (int k = 0; k < W; ++k) add8(sm, raw[k]);
#pragma unroll
    for (int o = 0; o < 8; ++o) {
        int lo = T0 + o - HW, hi = lo + W; lo = lo < 0 ? 0 : lo; hi = hi > SEQ ? SEQ : hi; const float ic = 1.0f / (float)(hi - lo);
        const u32x4 c = raw[o + HW];
        u32x4 w; w.x = pk2(sm[0] * ic - bflo(c.x), sm[1] * ic - bfhi(c.x)); w.y = pk2(sm[2] * ic - bflo(c.y), sm[3] * ic - bfhi(c.y));
        w.z = pk2(sm[4] * ic - bflo(c.z), sm[5] * ic - bfhi(c.z)); w.w = pk2(sm[6] * ic - bflo(c.w), sm[7] * ic - bfhi(c.w));
        *(u32x4*)(catc + o * 32) = w;
        if (o < 7) { add8(sm, raw[o + W]); sub8(sm, raw[o]); }
    }
}
__device__ __forceinline__ void attn_pool_phase(LAS unsigned char* lds, const bf16_t* Qb, const bf16_t* Kb, const bf16_t* Vt, const bf16_t* Ub, bf16_t* cat, const float* rpb_l, int G, int bid, int tid, int mode = 0) {
    asm volatile("" : "+v"(tid));
    LAS float* tab = (LAS float*)lds;
    for (int i = tid; i < NHEAD * RPB_H * 64; i += 512) { const int c = (i & 63) - 16, hr = i >> 6; tab[i] = (c >= 0 && c < RPB_W) ? rpb_l[hr * RPB_W + c] * LOG2E : 0.f; }
    __syncthreads();
    const int lane = tid & 63, h = __builtin_amdgcn_readfirstlane(tid >> 6), q16 = lane & 15, g4 = lane >> 4;
    const LAS float* tabh = tab + h * (RPB_H * 64) + 16;
    const bool xl = (G == 256); const int nun = xl ? 4 : (BATCH * 64 + G - 1) / G;
    for (int k = 0; k < nun; ++k) {
        const int unit = (mode & 4) ? 0 : (xl ? ((bid & 7) * 128 + k * 32 + (bid >> 3)) : (bid + k * G));
        if (unit >= BATCH * 64) break;
        const int b = unit >> 6, r = unit & 63; const int rs = r < 4 ? 0 : (r > 60 ? 56 : r - 4);
        const size_t tok0 = (size_t)b * SEQ + r * 64;
#pragma unroll 1
        for (int j = 0; j < ((mode & 2) ? 0 : 4); ++j) {
            const int cb = (j == 0) ? 0 : (j == 1) ? 8 : (j == 2) ? 24 : 32;
            const int qc = 16 * j + q16; const int cs = qc < 8 ? 0 : (qc > 56 ? 48 : qc - 8);
            const int tb0 = cb + g4 * 8 - qc + 15;
            const int vlo = cs - (cb + g4 * 8);
            f32x4 mb4[2];
#pragma unroll
            for (int hh = 0; hh < 2; ++hh)
#pragma unroll
                for (int jj = 0; jj < 4; ++jj) mb4[hh][jj] = ((unsigned)(hh * 4 + jj - vlo) < 16u) ? 0.f : -1e30f;
            const size_t cbase = ((size_t)(b * 8 + h) * 8 + g4) * SEQ;
            const bf16_t* qp = Qb + (cbase + r * 64 + qc) * 8;
            const bf16x8 q0 = *(const bf16x8*)qp, q1 = *(const bf16x8*)(qp + (size_t)4 * SEQ * 8);
            bf16x8 kf[8][2][2];
            const bf16_t* kbase = Kb + (cbase + rs * 64 + cb + (q16 >> 2) * 8 + (q16 & 3)) * 8;
#pragma unroll
            for (int i = 0; i < 8; ++i)
#pragma unroll
                for (int hh = 0; hh < 2; ++hh) { const bf16_t* kp = kbase + (size_t)(i * 64 + hh * 4) * 8; kf[i][hh][0] = *(const bf16x8*)kp; kf[i][hh][1] = *(const bf16x8*)(kp + (size_t)4 * SEQ * 8); }
            __builtin_amdgcn_sched_barrier(0);
            f32x4 s[8][2];
            float mx = -1e30f;
#pragma unroll
            for (int i = 0; i < 8; ++i)
#pragma unroll
                for (int hh = 0; hh < 2; ++hh) {
                    f32x4 acc = (f32x4){0.f, 0.f, 0.f, 0.f};
                    acc = __builtin_amdgcn_mfma_f32_16x16x32_bf16(kf[i][hh][0], q0, acc, 0, 0, 0);
                    acc = __builtin_amdgcn_mfma_f32_16x16x32_bf16(kf[i][hh][1], q1, acc, 0, 0, 0);
                    const LAS float* trow = tabh + (rs + i - r + 7) * 64 + tb0 + hh * 4;
                    f32x4 bias4; bias4.x = trow[0]; bias4.y = trow[1]; bias4.z = trow[2]; bias4.w = trow[3];
                    acc = (acc + bias4) + mb4[hh];
                    mx = fmaxf(mx, fmaxf(fmaxf(acc.x, acc.y), fmaxf(acc.z, acc.w)));
                    s[i][hh] = acc;
                }
            bf16x8 vf[8][4];
            const bf16_t* vbase = Vt + (((size_t)(b * 8 + h) * (SEQ / 8) + (rs * 64 + cb) / 8 + g4) * 64 + q16) * 8;
#pragma unroll
            for (int i = 0; i < 8; ++i)
#pragma unroll
                for (int db = 0; db < 4; ++db) vf[i][db] = *(const bf16x8*)(vbase + (size_t)i * 8 * 512 + db * 128);
            __builtin_amdgcn_sched_barrier(0);
            mx = fmaxf(mx, __shfl_xor(mx, 16)); mx = fmaxf(mx, __shfl_xor(mx, 32));
            f32x4 sum4 = (f32x4){0.f, 0.f, 0.f, 0.f}; const f32x4 mx4 = (f32x4){mx, mx, mx, mx};
            u32x4 pw[8];
#pragma unroll
            for (int i = 0; i < 8; ++i) {
#pragma unroll
                for (int hh = 0; hh < 2; ++hh) { const f32x4 d = s[i][hh] - mx4;
                    f32x4 p; p.x = __builtin_amdgcn_exp2f(d.x); p.y = __builtin_amdgcn_exp2f(d.y); p.z = __builtin_amdgcn_exp2f(d.z); p.w = __builtin_amdgcn_exp2f(d.w);
                    s[i][hh] = p; sum4 += p; }
                pw[i].x = pg8::cvt_pk_bf16(s[i][0][0], s[i][0][1]); pw[i].y = pg8::cvt_pk_bf16(s[i][0][2], s[i][0][3]); pw[i].z = pg8::cvt_pk_bf16(s[i][1][0], s[i][1][1]); pw[i].w = pg8::cvt_pk_bf16(s[i][1][2], s[i][1][3]);
            }
            float sum = (sum4.x + sum4.y) + (sum4.z + sum4.w);
            sum += __shfl_xor(sum, 16); sum += __shfl_xor(sum, 32);
            f32x4 o[4];
#pragma unroll
            for (int db = 0; db < 4; ++db) o[db] = (f32x4){0.f, 0.f, 0.f, 0.f};
#pragma unroll
            for (int i = 0; i < 8; ++i) {
                const bf16x8 pf = __builtin_bit_cast(bf16x8, pw[i]);
#pragma unroll
                for (int db = 0; db < 4; ++db) o[db] = __builtin_amdgcn_mfma_f32_16x16x32_bf16(vf[i][db], pf, o[db], 0, 0, 0);
            }
            const float inv = 1.0f / sum;
            bf16_t* op = cat + tix((int)(tok0 + qc), h * 64) + g4 * 4;
#pragma unroll
            for (int db = 0; db < 4; ++db) { u32x2 w; w.x = pg8::cvt_pk_bf16(o[db][0] * inv, o[db][1] * inv); w.y = pg8::cvt_pk_bf16(o[db][2] * inv, o[db][3] * inv); *(u32x2*)(op + (db >> 1) * (256 * 32) + (db & 1) * 16) = w; }
        }
        if (!(mode & 1)) {
            const int gidx = h & 3, hfl = h >> 2; const int T0 = r * 64 + hfl * 32 + g4 * 8; const int chan = gidx * 128 + q16 * 8;
            const bf16_t* Ubc = Ub + (size_t)b * SEQ * AW + chan; bf16_t* catc = cat + tix(b * SEQ + T0, 512 + chan);
            if (gidx == 0) pool_lane<2>(Ubc, catc, T0); else if (gidx == 1) pool_lane<4>(Ubc, catc, T0); else if (gidx == 2) pool_lane<8>(Ubc, catc, T0); else pool_lane<16>(Ubc, catc, T0);
        }
    }
}

constexpr int N_PHASES = 2 + 7 * DEPTH;
__global__ void __launch_bounds__(512, 2) fwd_megakernel(Args a) {
    extern __shared__ __attribute__((aligned(16))) unsigned char lds_raw[];
    LAS unsigned char* lds = (LAS unsigned char*)lds_raw;
    cg::grid_group grid = cg::this_grid();
    const int tid = threadIdx.x, bid = blockIdx.x, G = gridDim.x;
    unsigned char* ws = a.ws;
    bf16_t* H = (bf16_t*)(ws + WS_H); bf16_t* F = (bf16_t*)(ws + WS_F);
    bf16_t* Qb = (bf16_t*)(ws + WS_Q); bf16_t* Kb = (bf16_t*)(ws + WS_K); bf16_t* Vt = (bf16_t*)(ws + WS_VT); bf16_t* Ub = (bf16_t*)(ws + WS_U); bf16_t* CAT = (bf16_t*)(ws + WS_CAT);
    const float* mod = (const float*)(ws + WS_MOD);
    const int lo = a.ph_lo, hi = a.ph_hi;
#define IN(k) (lo <= (k) && (k) < hi)
    unsigned* barw = (unsigned*)(ws + WS_CTL);
    volatile LAS unsigned* misc = (volatile LAS unsigned*)(lds + 131072 + 1024);
    if (bid == 0) { for (int i = tid; i < 8192 + 4 * 16384; i += 512) barw[i] = 0u; }
    if (tid < 8) misc[tid] = 0u;
    __syncthreads();
    XcdBarrier xbar; xbar.bar = barw; xbar.x = 0; xbar.st = misc;
    const bool fusedln = (G == 256);
    int vb = bid;
#define SEAM(k) do { if (IN(k) && IN((k) + 1)) { if ((k) == 0) { grid.sync(); xbar = xcd_barrier_post(barw, misc); if (tid == 0) misc[2] = xb_add(&barw[3456 + 64 * xbar.x], 1u); } \
        else { xcd_barrier(xbar); if ((k) == 1) { \
            if (tid == 0) { bool ok = (G % 8 == 0) && xbar.x < 8u; for (int j = 0; j < 8; ++j) ok = ok && (xb_ld(&barw[3456 + 64 * j]) == (unsigned)(G / 8)); misc[3] = ok ? 1u : 0u; } \
            __syncthreads(); if (misc[3]) vb = (int)(misc[2] * 8u + xbar.x); } } } } while (0)

    if (IN(0)) { for (int rep = 0; rep <= PROBE_P0; ++rep) { p0_prologue(a, lds, G, bid, tid); if (rep < PROBE_P0) __syncthreads(); } }
    SEAM(0);
    if (IN(1)) { ln_phase<false, false>(a.x, nullptr, H, a.ln_in_g, a.ln_in_b, mod + 1 * D, mod + 0 * D, G, bid, tid); }
    SEAM(1);
#pragma unroll 1
    for (int l = 0; l < DEPTH; ++l) {
        const int p = 2 + 7 * l;
        unsigned char* ws = a.ws; asm volatile("" : "+s"(ws));
        bf16_t* H = (bf16_t*)(ws + WS_H); bf16_t* F = (bf16_t*)(ws + WS_F);
        bf16_t* Qb = (bf16_t*)(ws + WS_Q); bf16_t* Kb = (bf16_t*)(ws + WS_K); bf16_t* Vt = (bf16_t*)(ws + WS_VT); bf16_t* Ub = (bf16_t*)(ws + WS_U); bf16_t* CAT = (bf16_t*)(ws + WS_CAT);
        const float* mod = (const float*)(ws + WS_MOD); unsigned* barw = (unsigned*)(ws + WS_CTL);
        const float* modl = mod + (size_t)l * BATCH * NMOD;
        if (IN(p + 0)) {
            pg8::Gemm g{H, (const bf16_t*)(ws + WS_WIN) + (size_t)l * PROJ * D, M, PROJ, D}; pg8::StaticOrder S; S.init(M, PROJ, G, vb);
            pg8::EpiProj E{Qb, Kb, Vt, Ub};
            pg8::gemm_phase<pg8::EpiProj, true, pg8::StaticOrder, true, true>(lds, g, S, E);
        }
        SEAM(p + 0);
        if (IN(p + 1)) { for (int rep = 0; rep <= PROBE_ATT; ++rep) { attn_pool_phase(lds, Qb, Kb, Vt, Ub, CAT, a.rpb + (size_t)l * NHEAD * RPB_N, G, vb, tid, rep < PROBE_ATT ? PROBE_MODE : 0); if (rep < PROBE_ATT) xcd_barrier(xbar); } }
        SEAM(p + 1);
        if (IN(p + 2)) {
            pg8::Gemm g{CAT, (const bf16_t*)(ws + WS_WOUT) + (size_t)l * D * D, M, D, D}; pg8::StaticOrder S; S.init(M, D, G, vb);
            if (fusedln) { pg8::PanelStats st{(unsigned long long*)(ws + WS_X) + (size_t)(2 * l) * M * 4, barw + 8192 + (2 * l) * 16384};
                pg8::EpiResLn<false> E{H, nullptr, modl, 0 * D, 1 * D, 2 * D, a.ln1_g + l * D, a.ln1_b + l * D, modl, 3 * D, 4 * D, st};
                pg8::gemm_phase<pg8::EpiResLn<false>, true, pg8::StaticOrder, true, true>(lds, g, S, E); }
            else { pg8::EpiRes E{H, modl, 0 * D, 1 * D, 2 * D};
                pg8::gemm_phase<pg8::EpiRes, true, pg8::StaticOrder, true, true>(lds, g, S, E); }
        }
        SEAM(p + 2);
        if (IN(p + 3) && !fusedln) { ln_phase<true, false>(H, nullptr, H, a.ln1_g + l * D, a.ln1_b + l * D, modl + 4 * D, modl + 3 * D, G, bid, tid); }
        if (!fusedln) SEAM(p + 3);
        if (IN(p + 4)) {
            pg8::Gemm g{H, (const bf16_t*)(ws + WS_W1) + (size_t)l * FF * D, M, FF, D}; pg8::StaticOrder S; S.init(M, FF, G, vb);
#if STAGGER_US
            { const unsigned long long t0 = __builtin_amdgcn_s_memrealtime(); const unsigned long long dl = (unsigned long long)(vb & 3) * (STAGGER_US * 100ull);
              while (__builtin_amdgcn_s_memrealtime() - t0 < dl) __builtin_amdgcn_s_sleep(16); }
#endif
            { pg8::EpiRelu2 E{F, FF, 0}; pg8::gemm_phase<pg8::EpiRelu2, false, pg8::StaticOrder, true, true>(lds, g, S, E); }
#if PROBE_MLP1
            xcd_barrier(xbar);
            { int ns = PROBE_MLP1_NOSTORE; asm volatile("" : "+s"(ns)); pg8::EpiRelu2 E{F, FF, ns};
#if PROBE_MLP1_HOT
              pg8::HotOrder S2; S2.init(M, FF, G, vb); pg8::gemm_phase<pg8::EpiRelu2, true, pg8::HotOrder>(lds, g, S2, E);
#else
              pg8::gemm_phase<pg8::EpiRelu2, true>(lds, g, S, E);
#endif
            }
#endif
        }
        SEAM(p + 4);
        if (IN(p + 5)) {
            pg8::Gemm g{F, (const bf16_t*)(ws + WS_W2) + (size_t)l * D * FF, M, D, FF}; pg8::StaticOrder S; S.init(M, D, G, vb);
            const bool lastl2 = (l == DEPTH - 1); const float* modn2 = mod + (size_t)(lastl2 ? l : l + 1) * BATCH * NMOD;
            if (fusedln) { pg8::PanelStats st{(unsigned long long*)(ws + WS_X) + (size_t)(2 * l + 1) * M * 4, barw + 8192 + (2 * l + 1) * 16384};
                if (lastl2) { pg8::EpiResLn<true> E{H, a.out, modl, 3 * D, 4 * D, 5 * D, a.ln2_g + l * D, a.ln2_b + l * D, modn2, 0, 0, st};
                    pg8::gemm_phase<pg8::EpiResLn<true>, true, pg8::StaticOrder, true, true>(lds, g, S, E); }
                else { pg8::EpiResLn<false> E{H, nullptr, modl, 3 * D, 4 * D, 5 * D, a.ln2_g + l * D, a.ln2_b + l * D, modn2, 0 * D, 1 * D, st};
                    pg8::gemm_phase<pg8::EpiResLn<false>, true, pg8::StaticOrder, true, true>(lds, g, S, E); } }
            else { pg8::EpiRes E{H, modl, 3 * D, 4 * D, 5 * D};
                pg8::gemm_phase<pg8::EpiRes, true, pg8::StaticOrder, true, true>(lds, g, S, E); }
        }
        if (!(fusedln && l == DEPTH - 1)) SEAM(p + 5);
        if (IN(p + 6) && !fusedln) {
            const bool lastl = (l == DEPTH - 1);
            const float* modn = mod + (size_t)(lastl ? l : l + 1) * BATCH * NMOD;
            if (lastl) ln_phase<true, true>(H, a.out, nullptr, a.ln2_g + l * D, a.ln2_b + l * D, modn, modn, G, bid, tid);
            else ln_phase<true, false>(H, nullptr, H, a.ln2_g + l * D, a.ln2_b + l * D, modn + 1 * D, modn + 0 * D, G, bid, tid);
        }
        if (!fusedln) SEAM(p + 6);
    }
    for (int rep = 0; rep < PROBE_SYNC; ++rep) xcd_barrier(xbar);
#undef IN
#undef SEAM
}

extern "C" void kernel_launch(void* const* d_in, const int* in_sizes, int n_in, void* d_out, int out_size, void* d_ws, size_t ws_size, hipStream_t stream) {
    static int grid = 0;
    if (grid == 0) {
        if (n_in != 17 || in_sizes[0] != M * D || out_size != M * D || ws_size < WS_END) { fprintf(stderr, "kernel_launch: unexpected shapes / workspace (n_in %d, in0 %d, out %d, ws %zu)\n", n_in, n_in > 0 ? in_sizes[0] : -1, out_size, ws_size); grid = -1; return; }
        int dev = 0, cus = 0, per_cu = 0;
        hipGetDevice(&dev); hipDeviceGetAttribute(&cus, hipDeviceAttributeMultiprocessorCount, dev);
        if (hipFuncSetAttribute((const void*)fwd_megakernel, hipFuncAttributeMaxDynamicSharedMemorySize, LDS_BYTES) != hipSuccess) { fprintf(stderr, "kernel_launch: hipFuncSetAttribute failed\n"); grid = -1; return; }
        if (hipOccupancyMaxActiveBlocksPerMultiprocessor(&per_cu, (const void*)fwd_megakernel, 512, LDS_BYTES) != hipSuccess || per_cu < 1) { per_cu = 1; (void)hipGetLastError(); }
        grid = (cus > 0 ? cus : 256) * per_cu;
    }
    if (grid < 0) return;
    Args a{};
    a.x = (const float*)d_in[0]; a.c = (const float*)d_in[1]; a.ln_in_g = (const float*)d_in[2]; a.ln_in_b = (const float*)d_in[3]; a.w_ada = (const float*)d_in[4]; a.b_ada = (const float*)d_in[5];
    a.w_in = (const float*)d_in[6]; a.rpb = (const float*)d_in[7]; a.w_pool = (const float*)d_in[8]; a.pool_scale = (const float*)d_in[9]; a.w_out = (const float*)d_in[10];
    a.ln1_g = (const float*)d_in[11]; a.ln1_b = (const float*)d_in[12]; a.w_mlp1 = (const float*)d_in[13]; a.w_mlp2 = (const float*)d_in[14]; a.ln2_g = (const float*)d_in[15]; a.ln2_b = (const float*)d_in[16];
    a.out = (float*)d_out; a.ws = (unsigned char*)d_ws;
#if MK_MULTI
    for (int p = 0; p < N_PHASES; ++p) { a.ph_lo = p; a.ph_hi = p + 1; hipLaunchKernelGGL(fwd_megakernel, dim3(grid), dim3(512), LDS_BYTES, stream, a); }
#else
    a.ph_lo = 0; a.ph_hi = N_PHASES;
    void* args[] = {&a};
    hipError_t e = hipLaunchCooperativeKernel((const void*)fwd_megakernel, dim3(grid), dim3(512), args, LDS_BYTES, stream);
    if (e != hipSuccess) fprintf(stderr, "kernel_launch: cooperative launch failed: %s (grid %d)\n", hipGetErrorString(e), grid);
#endif
}
```

```cpp
#include <hip/hip_runtime.h>
#include <hip/hip_cooperative_groups.h>
#include <cstdio>
#include <cstdint>
namespace cg = cooperative_groups;

#define LAS __attribute__((address_space(3)))
typedef unsigned short bf16_t;
typedef short bf16x8 __attribute__((ext_vector_type(8)));
typedef float f32x4 __attribute__((ext_vector_type(4)));
typedef float f32x2 __attribute__((ext_vector_type(2)));
typedef unsigned u32x4 __attribute__((ext_vector_type(4)));
typedef unsigned u32x2 __attribute__((ext_vector_type(2)));

#ifndef PROBE_ATT
#define PROBE_ATT 0
#endif
#ifndef PROBE_P0
#define PROBE_P0 0
#endif
#ifndef PROBE_MODE
#define PROBE_MODE 0
#endif
#ifndef PROBE_MLP1
#define PROBE_MLP1 0
#endif
#ifndef PROBE_MLP1_HOT
#define PROBE_MLP1_HOT 0
#endif
#ifndef PROBE_MLP1_NOSTORE
#define PROBE_MLP1_NOSTORE 0
#endif
#ifndef STAGGER_US
#define STAGGER_US 0
#endif
#ifndef PROBE_SYNC
#define PROBE_SYNC 0
#endif
#ifndef MK_MULTI
#define MK_MULTI 0
#endif

constexpr int BATCH = 16, SEQ = 4096, D = 1024, DEPTH = 2, M = BATCH * SEQ;
constexpr int PROJ = 2048, FF = 4096, NMOD = 6 * D, AW = 512;
constexpr int NHEAD = 8;
constexpr float LN_EPS = 1e-5f;
constexpr float DN_ALPHA = 1.41421356237309515f;
constexpr float LOG2E = 1.44269504088896341f;
constexpr float QSCALE = 0.125f * LOG2E;
constexpr int RPB_H = 15, RPB_W = 31, RPB_N = RPB_H * RPB_W;

constexpr size_t MiB = (size_t)1 << 20;
constexpr size_t WS_WIN = 0 * MiB;
constexpr size_t WS_WOUT = 8 * MiB;
constexpr size_t WS_W1 = 12 * MiB;
constexpr size_t WS_W2 = 28 * MiB;
constexpr size_t WS_MOD = 44 * MiB;
constexpr size_t WS_CTL = 46 * MiB;
constexpr size_t WS_X = 48 * MiB;
constexpr size_t WS_H = 304 * MiB;
constexpr size_t WS_F = 432 * MiB;
constexpr size_t WS_Q = 432 * MiB;
constexpr size_t WS_K = 496 * MiB;
constexpr size_t WS_VT = 560 * MiB;
constexpr size_t WS_U = 624 * MiB;
constexpr size_t WS_CAT = 688 * MiB;
constexpr size_t WS_END = 944 * MiB;

constexpr int LDS_BYTES = 147456;

__host__ __device__ __forceinline__ size_t tix(int row, int col) { return (((size_t)(row >> 8) * (D >> 5) + (col >> 5)) * 256 + (row & 255)) * 32 + (col & 31); }

namespace pg8 {
constexpr int BM = 256, BK = 64, HALF = 128, HTB = HALF * BK * 2, STAGE_BYTES = 8 * HTB, NXCD = 8, WGM = 8;
__host__ __device__ __forceinline__ int lds_byte(int r, int c) { const int st = (r >> 4) * 2 + (c >> 5), rr = r & 15, cc = c & 31, ob = rr * 64 + cc * 2; return st * 1024 + (ob ^ (((ob >> 9) & 1) << 5)); }
__host__ __device__ __forceinline__ void stage_rc(int b, int& R, int& C) { const int st = b / 1024, sb = b % 1024, swz = sb ^ (((sb >> 9) & 1) << 5); R = (st >> 1) * 16 + swz / 64; C = (st & 1) * 32 + (swz % 64) / 2; }
__host__ __device__ __forceinline__ int perm32(int rho) { const int n = rho >> 4, i = rho & 15; return 8 * (i >> 2) + 4 * n + (i & 3); }

struct Unit { int pm, pn; };
struct Gemm { const bf16_t* A; const bf16_t* Bt; int M, N, K; };
struct StaticOrder;

struct StaticOrder {
    int nM, nN, nwg, G, c;
    __device__ void init(int M_, int N_, int G_, int c_) { nM = M_ / BM; nN = N_ / BM; nwg = nM * nN; G = G_; c = c_; }
    __device__ bool next(int i, Unit& u) const {
        const long L = (long)i * G + c; if (L >= nwg) return false;
        int wgid = (int)L; { const int q = nwg / NXCD, r = nwg % NXCD, xcd = wgid % NXCD, off = wgid / NXCD; wgid = (xcd < r ? xcd * (q + 1) : r * (q + 1) + (xcd - r) * q) + off; }
        const int nig = WGM * nN, gid = wgid / nig, fm = gid * WGM, gsz = (nM - fm) < WGM ? (nM - fm) : WGM;
        u.pm = fm + ((wgid % nig) % gsz); u.pn = (wgid % nig) / gsz; return true;
    }
};

struct HotOrder : StaticOrder { __device__ bool next(int i, Unit& u) const { const bool r = StaticOrder::next(i, u); u.pm = 0; u.pn = 0; return r; } };
__device__ __forceinline__ unsigned cvt_pk_bf16(float lo, float hi) { unsigned r; asm volatile("v_cvt_pk_bf16_f32 %0, %1, %2" : "=v"(r) : "v"(lo), "v"(hi)); return r; }

struct EpiProj {
    static constexpr bool PERM = true, VSWAP = true, FUSED = false;
    bf16_t* Q; bf16_t* Kb; bf16_t* Vt; bf16_t* U;
    __device__ __forceinline__ void operator()(const f32x4 (&acc)[2][2][4][2], const Unit& u, int wr, int wc, int fr, int fq) const {
        const int t = u.pn >> 1;
        if (t == 2) {
            const int dg0 = (u.pn & 1) * 256 + wr * 64 + fr; const int b = u.pm >> 4; const int s0 = (u.pm & 15) * 256 + wc * 32 + 8 * fq;
#pragma unroll
            for (int ai = 0; ai < 2; ++ai)
#pragma unroll
                for (int m = 0; m < 4; ++m) { const int dg = dg0 + ai * HALF + m * 16;
                    bf16_t* rowp = Vt + ((size_t)(b * 8 + (dg >> 6)) * (SEQ / 8) + (s0 >> 3)) * 512 + (dg & 63) * 8;
#pragma unroll
                    for (int bj = 0; bj < 2; ++bj) { const f32x4 v0 = acc[ai][bj][m][0], v1 = acc[ai][bj][m][1];
                        u32x4 w; w.x = cvt_pk_bf16(v0[0], v0[1]); w.y = cvt_pk_bf16(v0[2], v0[3]); w.z = cvt_pk_bf16(v1[0], v1[1]); w.w = cvt_pk_bf16(v1[2], v1[3]);
                        __builtin_nontemporal_store(w, (u32x4*)(rowp + (size_t)bj * (HALF / 8) * 512)); } }
        } else {
            bf16_t* base = Q + (size_t)t * ((size_t)M * AW); const float sc = t == 0 ? QSCALE : 1.0f;
            const int row0 = u.pm * BM + wr * 64 + fr, col0 = (u.pn & 1) * 256 + wc * 32 + 8 * fq;
            const bool cm = t < 2; const int bq = u.pm >> 4;
#pragma unroll
            for (int ai = 0; ai < 2; ++ai)
#pragma unroll
                for (int m = 0; m < 4; ++m) { const int row = row0 + ai * HALF + m * 16;
                    const int tok = row & (SEQ - 1);
                    bf16_t* rowp = cm ? base + ((((size_t)(bq * 8 + (col0 >> 6)) * (SEQ / 16) + (tok >> 4)) * 8 + ((col0 >> 3) & 7)) * 16 + (tok & 15)) * 8 : base + (size_t)row * AW + col0;
                    const size_t bjs = cm ? (size_t)(HALF / 8) * SEQ * 8 : (size_t)HALF;
#pragma unroll
                    for (int bj = 0; bj < 2; ++bj) { const f32x4 v0 = acc[ai][bj][m][0] * sc, v1 = acc[ai][bj][m][1] * sc;
                        u32x4 w; w.x = cvt_pk_bf16(v0[0], v0[1]); w.y = cvt_pk_bf16(v0[2], v0[3]); w.z = cvt_pk_bf16(v1[0], v1[1]); w.w = cvt_pk_bf16(v1[2], v1[3]);
                        __builtin_nontemporal_store(w, (u32x4*)(rowp + bj * bjs)); } }
        }
    }
};
struct EpiRelu2 {
    static constexpr bool PERM = true, VSWAP = false, FUSED = false;
    bf16_t* O; int ldc; int nostore;
    __device__ __forceinline__ void operator()(const f32x4 (&acc)[2][2][4][2], const Unit& u, int wr, int wc, int fr, int fq) const {
        if (nostore) return;
        const int row0 = u.pm * BM + wr * 64 + fr, col0 = u.pn * BM + wc * 32 + 8 * fq;
#pragma unroll
        for (int ai = 0; ai < 2; ++ai)
#pragma unroll
            for (int m = 0; m < 4; ++m) { bf16_t* rowp = O + (((size_t)u.pm * (ldc >> 5) + (col0 >> 5)) * BM + (wr * 64 + fr + ai * HALF + m * 16)) * 32 + (col0 & 31);
#pragma unroll
                for (int bj = 0; bj < 2; ++bj) { f32x4 v0 = acc[ai][bj][m][0], v1 = acc[ai][bj][m][1];
#pragma unroll
                    for (int j = 0; j < 4; ++j) { const float a = fmaxf(v0[j], 0.f), b = fmaxf(v1[j], 0.f); v0[j] = a * a; v1[j] = b * b; }
                    u32x4 w; w.x = cvt_pk_bf16(v0[0], v0[1]); w.y = cvt_pk_bf16(v0[2], v0[3]); w.z = cvt_pk_bf16(v1[0], v1[1]); w.w = cvt_pk_bf16(v1[2], v1[3]);
                    __builtin_nontemporal_store(w, (u32x4*)(rowp + (size_t)bj * (HALF / 32) * BM * 32)); } }
    }
};
struct EpiRes {
    static constexpr bool PERM = true, VSWAP = false, FUSED = false;
    bf16_t* H; const float* mod; int sh_off, sc_off, g_off;
    __device__ __forceinline__ void operator()(const f32x4 (&acc)[2][2][4][2], const Unit& u, int wr, int wc, int fr, int fq) const {
        const int row0 = u.pm * BM + wr * 64 + fr, col0 = u.pn * BM + wc * 32 + 8 * fq; const int b = u.pm >> 4;
        bf16_t* hb = H + (((size_t)(u.pm * 32 + u.pn * 8 + wc) * 256 + wr * 64 + fr) * 32 + 8 * fq);
        const float* mb = mod + (size_t)b * NMOD + col0;
#pragma unroll
        for (int bj = 0; bj < 2; ++bj) {
            f32x4 shv[2], aiv[2], g1v[2];
#pragma unroll
            for (int n = 0; n < 2; ++n) { shv[n] = *(const f32x4*)(mb + sh_off + bj * HALF + 4 * n); const f32x4 s1 = *(const f32x4*)(mb + sc_off + bj * HALF + 4 * n) + 1.0f;
                aiv[n] = (f32x4){DN_ALPHA / s1.x, DN_ALPHA / s1.y, DN_ALPHA / s1.z, DN_ALPHA / s1.w}; g1v[n] = *(const f32x4*)(mb + g_off + bj * HALF + 4 * n) + 1.0f; }
#pragma unroll
            for (int ai = 0; ai < 2; ++ai) {
                u32x4 hw[4];
#pragma unroll
                for (int m = 0; m < 4; ++m) hw[m] = *(const u32x4*)(hb + bj * (4 * 256 * 32) + (ai * HALF + m * 16) * 32);
#pragma unroll
                for (int m = 0; m < 4; ++m) { const u32x4 w0 = hw[m];
                    f32x4 h0, h1; h0.x = __builtin_bit_cast(float, w0.x << 16); h0.y = __builtin_bit_cast(float, w0.x & 0xffff0000u); h0.z = __builtin_bit_cast(float, w0.y << 16); h0.w = __builtin_bit_cast(float, w0.y & 0xffff0000u);
                    h1.x = __builtin_bit_cast(float, w0.z << 16); h1.y = __builtin_bit_cast(float, w0.z & 0xffff0000u); h1.z = __builtin_bit_cast(float, w0.w << 16); h1.w = __builtin_bit_cast(float, w0.w & 0xffff0000u);
                    const f32x4 z0 = (h0 - shv[0]) * aiv[0] + g1v[0] * acc[ai][bj][m][0], z1 = (h1 - shv[1]) * aiv[1] + g1v[1] * acc[ai][bj][m][1];
                    u32x4 w; w.x = cvt_pk_bf16(z0[0], z0[1]); w.y = cvt_pk_bf16(z0[2], z0[3]); w.z = cvt_pk_bf16(z1[0], z1[1]); w.w = cvt_pk_bf16(z1[2], z1[3]);
                    *(u32x4*)(hb + bj * (4 * 256 * 32) + (ai * HALF + m * 16) * 32) = w; }
                asm volatile("" ::: "memory"); }
        }
    }
};

constexpr int TAB_OFF = 131072 + 2048;
struct PanelStats {
    unsigned long long* xbuf;
    unsigned* cnt;
    __device__ __forceinline__ void run(const f32x4 (&v)[2][2][4][2], const Unit& u, int wr, int wc, int fr, int fq, LAS unsigned char* lds, int wid, int lane) const {
        LAS f32x2* P = (LAS f32x2*)(lds + TAB_OFF);
        LAS f32x2* S = (LAS f32x2*)(lds + TAB_OFF + 8192);
#pragma unroll
        for (int ai = 0; ai < 2; ++ai)
#pragma unroll
            for (int m = 0; m < 4; ++m) {
                float s = 0.f;
#pragma unroll
                for (int bj = 0; bj < 2; ++bj)
#pragma unroll
                    for (int n = 0; n < 2; ++n) { const f32x4 x = v[ai][bj][m][n]; s += (x[0] + x[1]) + (x[2] + x[3]); }
                s += __shfl_xor(s, 16); s += __shfl_xor(s, 32);
                const float mw = s * (1.0f / 64.0f); float q = 0.f;
#pragma unroll
                for (int bj = 0; bj < 2; ++bj)
#pragma unroll
                    for (int n = 0; n < 2; ++n) { const f32x4 d = v[ai][bj][m][n] - mw; q += (d[0] * d[0] + d[1] * d[1]) + (d[2] * d[2] + d[3] * d[3]); }
                q += __shfl_xor(q, 16); q += __shfl_xor(q, 32);
                if (fq == 0) P[(ai * HALF + wr * 64 + m * 16 + fr) * 4 + wc] = (f32x2){mw, q};
            }
        asm volatile("s_waitcnt lgkmcnt(0)" ::: "memory"); __builtin_amdgcn_s_barrier(); asm volatile("" ::: "memory");
        const int row = wid * 32 + (lane & 31);
        if (lane < 32) {
            const f32x2 a = P[row * 4 + 0], b = P[row * 4 + 1], c = P[row * 4 + 2], d = P[row * 4 + 3];
            const float mt = (a.x + b.x + c.x + d.x) * 0.25f;
            const float da = a.x - mt, db = b.x - mt, dc = c.x - mt, dd = d.x - mt;
            const float m2 = (a.y + b.y) + (c.y + d.y) + 64.0f * ((da * da + db * db) + (dc * dc + dd * dd));
            unsigned long long* slot = xbuf + ((size_t)(u.pm * BM + row) * 4 + u.pn);
            __hip_atomic_store(slot, ((unsigned long long)__float_as_uint(m2) << 32) | __float_as_uint(mt), __ATOMIC_RELAXED, __HIP_MEMORY_SCOPE_AGENT);
        }
        asm volatile("s_waitcnt vmcnt(0)" ::: "memory");
        if (lane == 0) __hip_atomic_fetch_add(cnt + 64 * u.pm, 1u, __ATOMIC_RELAXED, __HIP_MEMORY_SCOPE_AGENT);
        if (wid == 0) {
            unsigned sp = 0;
            while ((unsigned)__builtin_amdgcn_readfirstlane(__hip_atomic_load(cnt + 64 * u.pm, __ATOMIC_RELAXED, __HIP_MEMORY_SCOPE_AGENT)) < 32u) { __builtin_amdgcn_s_sleep(2); if (++sp > (1u << 20)) break; }
            __builtin_amdgcn_fence(__ATOMIC_ACQUIRE, "agent");
        }
        asm volatile("s_waitcnt vmcnt(0) lgkmcnt(0)" ::: "memory"); __builtin_amdgcn_s_barrier(); asm volatile("" ::: "memory");
        if (lane < 32) {
            const unsigned long long* slot = xbuf + (size_t)(u.pm * BM + row) * 4; float mt[4], m2[4]; float ms = 0.f;
#pragma unroll
            for (int t = 0; t < 4; ++t) { const unsigned long long w = __hip_atomic_load(slot + t, __ATOMIC_RELAXED, __HIP_MEMORY_SCOPE_AGENT); mt[t] = __uint_as_float((unsigned)w); m2[t] = __uint_as_float((unsigned)(w >> 32)); ms += mt[t]; }
            const float mean = ms * 0.25f; float q = 0.f;
#pragma unroll
            for (int t = 0; t < 4; ++t) { const float dm = mt[t] - mean; q += m2[t] + 256.0f * dm * dm; }
            S[row] = (f32x2){mean, 1.0f / sqrtf(q * (1.0f / 1024.0f) + LN_EPS)};
        }
        asm volatile("s_waitcnt lgkmcnt(0)" ::: "memory"); __builtin_amdgcn_s_barrier(); asm volatile("" ::: "memory");
    }
};
template <bool OUT_F32> struct EpiResLn {
    static constexpr bool PERM = true, VSWAP = false, FUSED = true;
    bf16_t* H; float* outF; const float* mod; int sh_off, sc_off, g_off; const float* lng; const float* lnb; const float* mod2; int sh2_off, sc2_off; PanelStats st;
    __device__ __forceinline__ void fused(f32x4 (&acc)[2][2][4][2], const Unit& u, int wr, int wc, int fr, int fq, LAS unsigned char* lds, int wid, int lane) const {
        const int row0 = u.pm * BM + wr * 64 + fr, col0 = u.pn * BM + wc * 32 + 8 * fq; const int b = u.pm >> 4;
        bf16_t* hb = H + (((size_t)(u.pm * 32 + u.pn * 8 + wc) * 256 + wr * 64 + fr) * 32 + 8 * fq);
        const float* mb = mod + (size_t)b * NMOD + col0;
#pragma unroll
        for (int bj = 0; bj < 2; ++bj) {
            u32x4 hw[2][4];
#pragma unroll
            for (int ai = 0; ai < 2; ++ai)
#pragma unroll
                for (int m = 0; m < 4; ++m) hw[ai][m] = *(const u32x4*)(hb + bj * (4 * 256 * 32) + (ai * HALF + m * 16) * 32);
#pragma unroll
            for (int n = 0; n < 2; ++n) {
                const f32x4 shv = *(const f32x4*)(mb + sh_off + bj * HALF + 4 * n); const f32x4 s1 = *(const f32x4*)(mb + sc_off + bj * HALF + 4 * n) + 1.0f;
                const f32x4 aiv = (f32x4){DN_ALPHA * __builtin_amdgcn_rcpf(s1.x), DN_ALPHA * __builtin_amdgcn_rcpf(s1.y), DN_ALPHA * __builtin_amdgcn_rcpf(s1.z), DN_ALPHA * __builtin_amdgcn_rcpf(s1.w)};
                const f32x4 g1v = *(const f32x4*)(mb + g_off + bj * HALF + 4 * n) + 1.0f;
#pragma unroll
                for (int ai = 0; ai < 2; ++ai)
#pragma unroll
                    for (int m = 0; m < 4; ++m) { const unsigned wa = n ? hw[ai][m].z : hw[ai][m].x, wb = n ? hw[ai][m].w : hw[ai][m].y;
                        f32x4 h0; h0.x = __builtin_bit_cast(float, wa << 16); h0.y = __builtin_bit_cast(float, wa & 0xffff0000u); h0.z = __builtin_bit_cast(float, wb << 16); h0.w = __builtin_bit_cast(float, wb & 0xffff0000u);
                        acc[ai][bj][m][n] = (h0 - shv) * aiv + g1v * acc[ai][bj][m][n]; }
            }
#pragma unroll
            for (int ai = 0; ai < 2; ++ai) {
                asm volatile("" : "+v"(acc[ai][bj][0][0]), "+v"(acc[ai][bj][0][1]), "+v"(acc[ai][bj][1][0]), "+v"(acc[ai][bj][1][1]));
                asm volatile("" : "+v"(acc[ai][bj][2][0]), "+v"(acc[ai][bj][2][1]), "+v"(acc[ai][bj][3][0]), "+v"(acc[ai][bj][3][1])); }
            asm volatile("" ::: "memory");
        }
        st.run(acc, u, wr, wc, fr, fq, lds, wid, lane);
        const LAS f32x2* S = (const LAS f32x2*)(lds + TAB_OFF + 8192);
        const float* m2b = mod2 + (size_t)b * NMOD + col0;
#pragma unroll
        for (int bj = 0; bj < 2; ++bj) {
            f32x4 Av[2], Bv[2];
#pragma unroll
            for (int n = 0; n < 2; ++n) { const f32x4 gl = *(const f32x4*)(lng + col0 + bj * HALF + 4 * n), bl = *(const f32x4*)(lnb + col0 + bj * HALF + 4 * n);
                if (OUT_F32) { Av[n] = gl; Bv[n] = bl; }
                else { const f32x4 s1 = *(const f32x4*)(m2b + sc2_off + bj * HALF + 4 * n) + 1.0f, sh2 = *(const f32x4*)(m2b + sh2_off + bj * HALF + 4 * n); Av[n] = gl * s1; Bv[n] = bl * s1 + sh2; } }
#pragma unroll
            for (int ai = 0; ai < 2; ++ai)
#pragma unroll
                for (int m = 0; m < 4; ++m) { const int r = ai * HALF + wr * 64 + m * 16 + fr; const f32x2 sr = S[r];
                    const f32x4 o0 = (acc[ai][bj][m][0] - sr.x) * sr.y * Av[0] + Bv[0], o1 = (acc[ai][bj][m][1] - sr.x) * sr.y * Av[1] + Bv[1];
                    if (OUT_F32) { float* p = outF + (size_t)(u.pm * BM + r) * D + col0 + bj * HALF; *(f32x4*)p = o0; *(f32x4*)(p + 4) = o1; }
                    else { u32x4 w; w.x = cvt_pk_bf16(o0[0], o0[1]); w.y = cvt_pk_bf16(o0[2], o0[3]); w.z = cvt_pk_bf16(o1[0], o1[1]); w.w = cvt_pk_bf16(o1[2], o1[3]);
                        *(u32x4*)(hb + bj * (4 * 256 * 32) + (ai * HALF + m * 16) * 32) = w; } }
        }
    }
};

template <class Epi, bool ALIGN_EPI, class Sched = StaticOrder, bool ACM = false, bool BCM = false>
__device__ __forceinline__ void gemm_phase(LAS unsigned char* lds, const Gemm g, const Sched& S, const Epi& E) {
    int tid = threadIdx.x; asm volatile("" : "+v"(tid));
    const int wid = __builtin_amdgcn_readfirstlane(tid >> 6), lane = tid & 63, wr = wid >> 2, wc = wid & 3, fr = lane & 15, fq = lane >> 4;
    const int K = g.K, nt = K / BK;
    unsigned voffA[2], voffB[2];
#pragma unroll
    for (int i = 0; i < 2; ++i) { int R, C; stage_rc(tid * 16 + i * 8192, R, C); const int Rb = Epi::PERM ? ((R & ~31) + perm32(R & 31)) : R;
        voffA[i] = ACM ? (unsigned)(((C >> 5) * BM + R) * 64 + (C & 31) * 2) : (unsigned)(R * K + C) * 2u; voffB[i] = BCM ? (unsigned)(((C >> 5) * BM + Rb) * 64 + (C & 31) * 2) : (unsigned)(Rb * K + C) * 2u; }
    static_assert(!Epi::VSWAP || (ACM == BCM), "operand swapping needs A and B in the same layout");
    const size_t kstepR = (size_t)(BK * 2), hstepR = (size_t)HALF * K * 2, tstepR = 2 * hstepR;
    const size_t kstepT = (size_t)(BK / 32) * BM * 64, hstepT = (size_t)HALF * 64, tstepT = (size_t)(K / 32) * BM * 64;
    const size_t kstepA = ACM ? kstepT : kstepR, hstepA = ACM ? hstepT : hstepR, tstepA = ACM ? tstepT : tstepR;
    const size_t kstepB = BCM ? kstepT : kstepR, hstepB = BCM ? hstepT : hstepR, tstepB = BCM ? tstepT : tstepR;
    const unsigned ldsw = (unsigned)wid * 1024u;
    const int aoff = lds_byte(wr * 64 + fr, fq * 8), boff = lds_byte(wc * 32 + fr, fq * 8);
#define PG8_SA(b, h) (((b) * 2 + (h)) * HTB)
#define PG8_SB(b, h) ((4 + (b) * 2 + (h)) * HTB)
#define PG8_STAGE(bufoff, gbase, voff) do { _Pragma("unroll") for (int _i = 0; _i < 2; ++_i) \
        __builtin_amdgcn_global_load_lds((const unsigned*)((const char*)(gbase) + (voff)[_i]), (LAS unsigned*)(lds + (bufoff) + ldsw + _i * 8192), 16, 0, 0); } while (0)
#define PG8_LDA(dst, b, h) do { _Pragma("unroll") for (int m = 0; m < 4; ++m) _Pragma("unroll") for (int k = 0; k < 2; ++k) dst[m][k] = *(const LAS bf16x8*)(lds + PG8_SA(b, h) + aoff + m * 2048 + k * 1024); } while (0)
#define PG8_LDB(dst, b, h) do { _Pragma("unroll") for (int n = 0; n < 2; ++n) _Pragma("unroll") for (int k = 0; k < 2; ++k) dst[n][k] = *(const LAS bf16x8*)(lds + PG8_SB(b, h) + boff + n * 2048 + k * 1024); } while (0)
#define PG8_MMA(ai, bj, At, Bt) do { __builtin_amdgcn_s_setprio(1); _Pragma("unroll") for (int m = 0; m < 4; ++m) _Pragma("unroll") for (int n = 0; n < 2; ++n) _Pragma("unroll") for (int k = 0; k < 2; ++k) \
        acc[ai][bj][m][n] = __builtin_amdgcn_mfma_f32_16x16x32_bf16(Bt[n][k], At[m][k], acc[ai][bj][m][n], 0, 0, 0); __builtin_amdgcn_s_setprio(0); } while (0)
#define PG8_WAIT_V(n) asm volatile("s_waitcnt vmcnt(" #n ")" ::: "memory")
#define PG8_WAIT_L(n) asm volatile("s_waitcnt lgkmcnt(" #n ")" ::: "memory")
#define PG8_BAR __builtin_amdgcn_s_barrier()
#define PG8_SCHED __builtin_amdgcn_sched_barrier(0)
#define PG8_PTRS(u, pa, pb) do { const bool _sw = Epi::VSWAP && (((u).pn >> 1) == 2); const char* _a = (const char*)g.A + (size_t)(u).pm * tstepA; const char* _b = (const char*)g.Bt + (size_t)(u).pn * tstepB; pa = _sw ? _b : _a; pb = _sw ? _a : _b; } while (0)
    Unit cur, nxt; int ui = 0;
    if (!S.next(0, cur)) return;
    f32x4 acc[2][2][4][2];
#pragma unroll
    for (int a = 0; a < 2; ++a)
#pragma unroll
        for (int b = 0; b < 2; ++b)
#pragma unroll
            for (int m = 0; m < 4; ++m)
#pragma unroll
                for (int n = 0; n < 2; ++n) acc[a][b][m][n] = (f32x4){0.f, 0.f, 0.f, 0.f};
    bf16x8 At[4][2], B0[2][2], B1[2][2];
    const char* cA; const char* cB; PG8_PTRS(cur, cA, cB);
    PG8_STAGE(PG8_SB(0, 0), cB, voffB); PG8_STAGE(PG8_SB(0, 1), cB + hstepB, voffB); PG8_STAGE(PG8_SA(0, 0), cA, voffA); PG8_STAGE(PG8_SA(0, 1), cA + hstepA, voffA);
    if (wr == 1) PG8_BAR;
    PG8_WAIT_V(2); PG8_BAR;
    PG8_STAGE(PG8_SB(1, 0), cB + kstepB, voffB); PG8_STAGE(PG8_SA(1, 0), cA + kstepA, voffA); PG8_STAGE(PG8_SB(1, 1), cB + hstepB + kstepB, voffB);
    PG8_WAIT_V(6); PG8_BAR;
    for (;;) {
        const bool has_next = S.next(ui + 1, nxt);
        const char* nA = cA; const char* nB = cB; if (has_next) { PG8_PTRS(nxt, nA, nB); }
        for (int t = 0; t < nt; t += 2) {
            const bool last = (t == nt - 2);
            const char* a1 = cA + (size_t)(t + 1) * kstepA;
            const char* a2 = last ? nA : cA + (size_t)(t + 2) * kstepA; const char* b2 = last ? nB : cB + (size_t)(t + 2) * kstepB;
            const char* a3 = a2 + kstepA; const char* b3 = b2 + kstepB;
            PG8_LDB(B0, 0, 0); PG8_LDB(B1, 0, 1); PG8_SCHED; PG8_LDA(At, 0, 0); PG8_STAGE(PG8_SA(1, 1), a1 + hstepA, voffA);
            PG8_WAIT_V(8); PG8_WAIT_L(0); PG8_BAR; PG8_MMA(0, 0, At, B0); PG8_MMA(0, 1, At, B1); PG8_BAR; PG8_SCHED;
            PG8_LDA(At, 0, 1); PG8_STAGE(PG8_SB(0, 0), b2, voffB); PG8_STAGE(PG8_SB(0, 1), b2 + hstepB, voffB); PG8_STAGE(PG8_SA(0, 0), a2, voffA);
            PG8_WAIT_V(8); PG8_WAIT_L(0); PG8_BAR; PG8_MMA(1, 0, At, B0); PG8_MMA(1, 1, At, B1); PG8_BAR; PG8_SCHED;
            PG8_LDB(B0, 1, 0); PG8_LDB(B1, 1, 1); PG8_SCHED; PG8_LDA(At, 1, 0); PG8_STAGE(PG8_SA(0, 1), a2 + hstepA, voffA);
            PG8_WAIT_V(8); PG8_WAIT_L(0); PG8_BAR; PG8_MMA(0, 0, At, B0); PG8_MMA(0, 1, At, B1); PG8_BAR; PG8_SCHED;
            PG8_LDA(At, 1, 1); PG8_STAGE(PG8_SB(1, 0), b3, voffB); PG8_STAGE(PG8_SB(1, 1), b3 + hstepB, voffB); PG8_STAGE(PG8_SA(1, 0), a3, voffA);
            PG8_WAIT_V(8); PG8_WAIT_L(0); PG8_BAR; PG8_MMA(1, 0, At, B0); PG8_MMA(1, 1, At, B1); PG8_BAR; PG8_SCHED;
        }
        if constexpr (ALIGN_EPI) { if (wr == 0) PG8_BAR; }
        if constexpr (Epi::FUSED) E.fused(acc, cur, wr, wc, fr, fq, lds, wid, lane); else E(acc, cur, wr, wc, fr, fq);
        if (!has_next) break;
#pragma unroll
        for (int a = 0; a < 2; ++a)
#pragma unroll
            for (int b = 0; b < 2; ++b)
#pragma unroll
                for (int m = 0; m < 4; ++m)
#pragma unroll
                    for (int n = 0; n < 2; ++n) acc[a][b][m][n] = (f32x4){0.f, 0.f, 0.f, 0.f};
        cur = nxt; cA = nA; cB = nB; ++ui;
        if constexpr (ALIGN_EPI) { if (wr == 1) PG8_BAR; }
    }
    PG8_WAIT_V(0);
    if constexpr (!ALIGN_EPI) { if (wr == 0) PG8_BAR; }
    PG8_BAR;
#undef PG8_SA
#undef PG8_SB
#undef PG8_STAGE
#undef PG8_LDA
#undef PG8_LDB
#undef PG8_MMA
#undef PG8_WAIT_V
#undef PG8_WAIT_L
#undef PG8_BAR
#undef PG8_SCHED
#undef PG8_PTRS
}
}

#define XB_TMO      128
#define XB_XCNT(j)  (256  + 64 * (j))
#define XB_XSUB(j)  (1280 + 64 * (j))
#define XB_XGEN(j)  (2304 + 64 * (j))
#define XB_TOP      3328
#define XB_TOPGEN   3392
#define XCD_BAR_WORDS 3456
#define XB_SPIN_CAP (1u << 18)
__device__ __forceinline__ unsigned xb_ld(unsigned* p)              { return __hip_atomic_load(p, __ATOMIC_RELAXED, __HIP_MEMORY_SCOPE_AGENT); }
__device__ __forceinline__ unsigned xb_add(unsigned* p, unsigned v) { return __hip_atomic_fetch_add(p, v, __ATOMIC_RELAXED, __HIP_MEMORY_SCOPE_AGENT); }
__device__ __forceinline__ unsigned xb_xcc_id() { return (unsigned)__builtin_amdgcn_s_getreg((3 << 11) | 20) & 0xFu; }
#define XB_SPIN(cond, bar) do { unsigned _sp = 0; while (cond) { __builtin_amdgcn_s_sleep(1); \
    if ((++_sp & 255u) == 0u) { if (xb_ld(&(bar)[XB_TMO])) break; if (_sp > XB_SPIN_CAP) { atomicAdd(&(bar)[XB_TMO], 1u); break; } } } } while (0)
struct XcdBarrier { unsigned* bar; unsigned x; volatile LAS unsigned* st; };
__device__ __forceinline__ XcdBarrier xcd_barrier_post(unsigned* bar, volatile LAS unsigned* st) {
    XcdBarrier b; b.bar = bar; b.x = xb_xcc_id(); b.st = st;
    if (threadIdx.x == 0) (void)xb_add(&bar[XB_XCNT(b.x)], 1u);
    return b;
}
__device__ __forceinline__ void xcd_barrier_complete(unsigned* bar, unsigned x, unsigned& nloc, unsigned& nx) {
    const unsigned G = gridDim.x * gridDim.y * gridDim.z;
    unsigned sum, cnt, mine, sp = 0u;
    for (;;) {
        sum = 0u; cnt = 0u; mine = 0u;
#pragma unroll
        for (unsigned j = 0; j < 16; ++j) { const unsigned c = xb_ld(&bar[XB_XCNT(j)]); sum += c; cnt += (c > 0u) ? 1u : 0u; mine = (j == x) ? c : mine; }
        if (sum == G) break;
        __builtin_amdgcn_s_sleep(1);
        if ((++sp & 255u) == 0u) { if (xb_ld(&bar[XB_TMO])) break; if (sp > XB_SPIN_CAP) { atomicAdd(&bar[XB_TMO], 1u); break; } }
    }
    nloc = mine > 0u ? mine : 1u; nx = cnt > 0u ? cnt : 1u;
}
__device__ __forceinline__ void xcd_barrier(const XcdBarrier& b) {
    asm volatile("s_waitcnt vmcnt(0)" ::: "memory");
    __syncthreads();
    if (threadIdx.x == 0) {
        unsigned* bar = b.bar;
        __builtin_amdgcn_s_waitcnt(0);
        unsigned nloc = b.st[0], nx = b.st[1];
        if (nloc == 0u) { xcd_barrier_complete(bar, b.x, nloc, nx); b.st[0] = nloc; b.st[1] = nx; }
        const unsigned old = xb_add(&bar[XB_XSUB(b.x)], 1u);
        const unsigned gen = old / nloc;
        if (old + 1u == (gen + 1u) * nloc) {
            __builtin_amdgcn_fence(__ATOMIC_RELEASE, "agent");
            asm volatile("s_waitcnt vmcnt(0)" ::: "memory");
            const unsigned og = xb_add(&bar[XB_TOP], 1u);
            const unsigned tg = og / nx;
            if (og + 1u == (tg + 1u) * nx) xb_add(&bar[XB_TOPGEN], 1u);
            else XB_SPIN(xb_ld(&bar[XB_TOPGEN]) == tg, bar);
            __builtin_amdgcn_fence(__ATOMIC_ACQUIRE, "agent");
            xb_add(&bar[XB_XGEN(b.x)], 1u);
            asm volatile("s_waitcnt vmcnt(0)" ::: "memory");
        } else {
            XB_SPIN(xb_ld(&bar[XB_XGEN(b.x)]) == gen, bar);
            __builtin_amdgcn_fence(__ATOMIC_ACQUIRE, "agent");
            asm volatile("s_waitcnt vmcnt(0)" ::: "memory");
        }
    }
    __syncthreads();
}

__device__ __forceinline__ unsigned f2bf(float f) { unsigned u = __builtin_bit_cast(unsigned, f); return (u + 0x7fffu + ((u >> 16) & 1u)) >> 16; }
__device__ __forceinline__ unsigned pk2(float lo, float hi) { return f2bf(lo) | (f2bf(hi) << 16); }
__device__ __forceinline__ float bflo(unsigned w) { return __builtin_bit_cast(float, w << 16); }
__device__ __forceinline__ float bfhi(unsigned w) { return __builtin_bit_cast(float, w & 0xffff0000u); }
__device__ __forceinline__ float wave_sum(float v) {
#pragma unroll
    for (int o = 1; o < 64; o <<= 1) v += __shfl_xor(v, o);
    return v;
}

template <bool TILED>
__device__ __forceinline__ void transpose_item(const float* W, int N, bf16_t* WT, int ldw, LAS float* scr, int kb, int nb, int lane) {
    const int k0 = 64 * kb, n0 = 32 * nb;
#pragma unroll 8
    for (int i = 0; i < 32; ++i) { const int kk = 2 * i + (lane >> 5); scr[kk * 33 + (lane & 31)] = W[(size_t)(k0 + kk) * N + n0 + (lane & 31)]; }
    asm volatile("s_waitcnt lgkmcnt(0)" ::: "memory");
    const int c = lane & 7;
#pragma unroll
    for (int j = 0; j < 4; ++j) { const int n = (lane >> 3) + 8 * j; const LAS float* s = scr + (8 * c) * 33 + n;
        u32x4 o; o.x = pk2(s[0 * 33], s[1 * 33]); o.y = pk2(s[2 * 33], s[3 * 33]); o.z = pk2(s[4 * 33], s[5 * 33]); o.w = pk2(s[6 * 33], s[7 * 33]);
        const int nn = n0 + n, kk = k0 + 8 * c;
        bf16_t* dst = TILED ? WT + (((size_t)(nn >> 8) * (ldw >> 5) + (kk >> 5)) * 256 + (nn & 255)) * 32 + (kk & 31) : WT + (size_t)nn * ldw + kk;
        *(u32x4*)dst = o; }
    asm volatile("s_waitcnt lgkmcnt(0)" ::: "memory");
}

struct Args {
    const float *x, *c, *ln_in_g, *ln_in_b, *w_ada, *b_ada, *w_in, *rpb, *w_pool, *pool_scale, *w_out, *ln1_g, *ln1_b, *w_mlp1, *w_mlp2, *ln2_g, *ln2_b;
    float* out; unsigned char* ws; int ph_lo, ph_hi;
};

__device__ __forceinline__ void p0_prologue(const Args& a, LAS unsigned char* lds, int G, int bid, int tid) {
    asm volatile("" : "+v"(tid));
    const int lane = tid & 63, wave = tid >> 6;
    unsigned char* ws = a.ws;
    float* mod = (float*)(ws + WS_MOD);
    for (int item = bid; item < 2 * (NMOD / 64); item += G) {
        const int l = item / (NMOD / 64), n0 = (item % (NMOD / 64)) * 64;
        LAS float* cact = (LAS float*)lds;
        LAS float* red = (LAS float*)(lds + 65536);
        for (int i = tid; i < BATCH * D; i += 512) { const int b = i >> 10, k = i & 1023; const float v = a.c[i]; cact[k * 16 + b] = v / (1.0f + expf(-v)); }
        __syncthreads();
        const int ks = tid >> 6, col = tid & 63;
        float acc[16];
#pragma unroll
        for (int b = 0; b < 16; ++b) acc[b] = 0.f;
        const float* wp = a.w_ada + (size_t)l * D * NMOD + (size_t)(ks * 128) * NMOD + n0 + col;
#pragma unroll 4
        for (int kk = 0; kk < 128; ++kk) {
            const float w = wp[(size_t)kk * NMOD];
            const LAS f32x4* cp = (const LAS f32x4*)(cact + (ks * 128 + kk) * 16);
#pragma unroll
            for (int q = 0; q < 4; ++q) { const f32x4 cv = cp[q]; acc[4 * q + 0] += cv.x * w; acc[4 * q + 1] += cv.y * w; acc[4 * q + 2] += cv.z * w; acc[4 * q + 3] += cv.w * w; }
        }
#pragma unroll
        for (int b = 0; b < 16; ++b) red[(ks * 16 + b) * 64 + col] = acc[b];
        __syncthreads();
        for (int o = tid; o < 1024; o += 512) { const int b = o >> 6, cc = o & 63; float s = 0.f;
#pragma unroll
            for (int k8 = 0; k8 < 8; ++k8) s += red[(k8 * 16 + b) * 64 + cc];
            mod[(size_t)(l * 16 + b) * NMOD + n0 + cc] = s + a.b_ada[l * NMOD + n0 + cc]; }
        __syncthreads();
    }
    for (int idx = bid * 512 + tid; idx < 2 * 4 * 16 * 1024; idx += G * 512) {
        const int l = idx >> 16, g = (idx >> 14) & 3, cch = (idx >> 10) & 15, n = idx & 1023;
        const float* wo = a.w_out + (size_t)l * D * D + (size_t)(512 + g * 128) * D + n;
        const float* wpl = a.w_pool + ((size_t)(l * 4 + g) * 128 + cch * 8) * 128;
        const float* ps = a.pool_scale + l * 512 + g * 128;
        float acc[8];
#pragma unroll
        for (int i = 0; i < 8; ++i) acc[i] = 0.f;
#pragma unroll 4
        for (int d = 0; d < 128; ++d) { const float v = wo[(size_t)d * D] * ps[d];
#pragma unroll
            for (int i = 0; i < 8; ++i) acc[i] += wpl[i * 128 + d] * v; }
        u32x4 o; o.x = pk2(acc[0], acc[1]); o.y = pk2(acc[2], acc[3]); o.z = pk2(acc[4], acc[5]); o.w = pk2(acc[6], acc[7]);
        { const int kk = 512 + g * 128 + cch * 8;
          *(u32x4*)((bf16_t*)(ws + WS_WOUT) + (size_t)l * D * D + (((size_t)(n >> 8) * (D >> 5) + (kk >> 5)) * 256 + (n & 255)) * 32 + (kk & 31)) = o; }
    }
    {
        LAS float* scr = (LAS float*)(lds + wave * 16384);
        const int gw = bid * 8 + wave, NGW = G * 8;
        constexpr int I_IN = 16 * 64, I_OUT = 8 * 32, I_1 = 16 * 128, I_2 = 64 * 32, I_L = I_IN + I_OUT + I_1 + I_2;
        for (int it = gw; it < 2 * I_L; it += NGW) {
            const int l = it / I_L; int r = it % I_L;
            if (r < I_IN) { transpose_item<true>(a.w_in + (size_t)l * D * PROJ, PROJ, (bf16_t*)(ws + WS_WIN) + (size_t)l * PROJ * D, D, scr, r / 64, r % 64, lane); continue; } r -= I_IN;
            if (r < I_OUT) { transpose_item<true>(a.w_out + (size_t)l * D * D, D, (bf16_t*)(ws + WS_WOUT) + (size_t)l * D * D, D, scr, r / 32, r % 32, lane); continue; } r -= I_OUT;
            if (r < I_1) { transpose_item<true>(a.w_mlp1 + (size_t)l * D * FF, FF, (bf16_t*)(ws + WS_W1) + (size_t)l * FF * D, D, scr, r / 128, r % 128, lane); continue; } r -= I_1;
            transpose_item<true>(a.w_mlp2 + (size_t)l * FF * D, D, (bf16_t*)(ws + WS_W2) + (size_t)l * D * FF, FF, scr, r / 32, r % 32, lane);
        }
    }
}

template <bool SRC_BF16, bool OUT_F32>
__device__ __forceinline__ void ln_phase(const void* srcv, float* dstF, bf16_t* dstH, const float* g, const float* bt, const float* sc, const float* sh, int G, int bid, int tid) {
    asm volatile("" : "+v"(tid));
    const int lane = tid & 63, wave = tid >> 6;
    const int gw = bid * 8 + wave, NGW = G * 8;
    const int rpw = (((M + NGW - 1) / NGW) + 3) & ~3;
    const int r0 = gw * rpw, r1 = (r0 + rpw < M) ? r0 + rpw : M;
    if (r0 >= M) return;
    const int c0 = 8 * lane;
    f32x4 gv[4], bv[4], scv[4], shv[4];
#pragma unroll
    for (int j = 0; j < 4; ++j) { const int cj = c0 + (j >> 1) * 512 + (j & 1) * 4; gv[j] = *(const f32x4*)(g + cj); bv[j] = *(const f32x4*)(bt + cj); scv[j] = (f32x4){1.f, 1.f, 1.f, 1.f}; shv[j] = (f32x4){0.f, 0.f, 0.f, 0.f}; }
    int curb = -1;
    for (int r = r0; r < r1; r += 4) {
        f32x4 nf[4][4]; u32x4 nb[4][2];
#pragma unroll
        for (int q = 0; q < 4; ++q) {
            if (SRC_BF16) { const bf16_t* p = (const bf16_t*)srcv + tix(r, c0) + q * 32; nb[q][0] = *(const u32x4*)p; nb[q][1] = *(const u32x4*)(p + 16 * 256 * 32); }
            else { const float* p = (const float*)srcv + (size_t)(r + q) * D + c0; nf[q][0] = *(const f32x4*)p; nf[q][1] = *(const f32x4*)(p + 4); nf[q][2] = *(const f32x4*)(p + 512); nf[q][3] = *(const f32x4*)(p + 516); }
        }
        const int b = r >> 12;
        if (!OUT_F32 && b != curb) { curb = b;
#pragma unroll
            for (int j = 0; j < 4; ++j) { const int cj = c0 + (j >> 1) * 512 + (j & 1) * 4; scv[j] = *(const f32x4*)(sc + (size_t)b * NMOD + cj) + 1.0f; shv[j] = *(const f32x4*)(sh + (size_t)b * NMOD + cj); } }
#pragma unroll
        for (int q = 0; q < 4; ++q) {
            f32x4 v[4];
            if (SRC_BF16) {
#pragma unroll
                for (int t = 0; t < 2; ++t) { const u32x4 w = nb[q][t]; v[2 * t].x = bflo(w.x); v[2 * t].y = bfhi(w.x); v[2 * t].z = bflo(w.y); v[2 * t].w = bfhi(w.y); v[2 * t + 1].x = bflo(w.z); v[2 * t + 1].y = bfhi(w.z); v[2 * t + 1].z = bflo(w.w); v[2 * t + 1].w = bfhi(w.w); }
            } else {
#pragma unroll
                for (int j = 0; j < 4; ++j) v[j] = nf[q][j];
            }
            float s = 0.f;
#pragma unroll
            for (int j = 0; j < 4; ++j) s += (v[j].x + v[j].y) + (v[j].z + v[j].w);
            const float mean = wave_sum(s) * (1.f / D); float s2 = 0.f;
#pragma unroll
            for (int j = 0; j < 4; ++j) { v[j] = v[j] - mean; s2 += (v[j].x * v[j].x + v[j].y * v[j].y) + (v[j].z * v[j].z + v[j].w * v[j].w); }
            const float rstd = 1.f / sqrtf(wave_sum(s2) * (1.f / D) + LN_EPS);
#pragma unroll
            for (int j = 0; j < 4; ++j) v[j] = v[j] * rstd * gv[j] + bv[j];
            if (OUT_F32) { float* p = dstF + (size_t)(r + q) * D + c0; *(f32x4*)p = v[0]; *(f32x4*)(p + 4) = v[1]; *(f32x4*)(p + 512) = v[2]; *(f32x4*)(p + 516) = v[3]; }
            else {
#pragma unroll
                for (int j = 0; j < 4; ++j) v[j] = v[j] * scv[j] + shv[j];
                u32x4 w0, w1; w0.x = pk2(v[0].x, v[0].y); w0.y = pk2(v[0].z, v[0].w); w0.z = pk2(v[1].x, v[1].y); w0.w = pk2(v[1].z, v[1].w);
                w1.x = pk2(v[2].x, v[2].y); w1.y = pk2(v[2].z, v[2].w); w1.z = pk2(v[3].x, v[3].y); w1.w = pk2(v[3].z, v[3].w);
                bf16_t* p = dstH + tix(r, c0) + q * 32; *(u32x4*)p = w0; *(u32x4*)(p + 16 * 256 * 32) = w1;
            }
        }
    }
}

__device__ __forceinline__ void add8(float (&s)[8], const u32x4 w) { s[0] += bflo(w.x); s[1] += bfhi(w.x); s[2] += bflo(w.y); s[3] += bfhi(w.y); s[4] += bflo(w.z); s[5] += bfhi(w.z); s[6] += bflo(w.w); s[7] += bfhi(w.w); }
__device__ __forceinline__ void sub8(float (&s)[8], const u32x4 w) { s[0] -= bflo(w.x); s[1] -= bfhi(w.x); s[2] -= bflo(w.y); s[3] -= bfhi(w.y); s[4] -= bflo(w.z); s[5] -= bfhi(w.z); s[6] -= bflo(w.w); s[7] -= bfhi(w.w); }
template <int W>
__device__ __forceinline__ void pool_lane(const bf16_t* Ubc  , bf16_t* catc  , int T0) {
    constexpr int HW = W / 2, NL = 8 + W - 1;
    u32x4 raw[NL];
#pragma unroll
    for (int k = 0; k < NL; ++k) { const int tk = T0 - HW + k; const int tc = tk < 0 ? 0 : (tk > SEQ - 1 ? SEQ - 1 : tk); u32x4 v = *(const u32x4*)(Ubc + (size_t)tc * AW);
        if (tk != tc) v = (u32x4){0u, 0u, 0u, 0u}; raw[k] = v; }
    float sm[8];
#pragma unroll
    for (int e = 0; e < 8; ++e) sm[e] = 0.f;
#pragma unroll
    for (int k = 0; k < W; ++k) add8(sm, raw[k]);
#pragma unroll
    for (int o = 0; o < 8; ++o) {
        int lo = T0 + o - HW, hi = lo + W; lo = lo < 0 ? 0 : lo; hi = hi > SEQ ? SEQ : hi; const float ic = 1.0f / (float)(hi - lo);
        const u32x4 c = raw[o + HW];
        u32x4 w; w.x = pk2(sm[0] * ic - bflo(c.x), sm[1] * ic - bfhi(c.x)); w.y = pk2(sm[2] * ic - bflo(c.y), sm[3] * ic - bfhi(c.y));
        w.z = pk2(sm[4] * ic - bflo(c.z), sm[5] * ic - bfhi(c.z)); w.w = pk2(sm[6] * ic - bflo(c.w), sm[7] * ic - bfhi(c.w));
        *(u32x4*)(catc + o * 32) = w;
        if (o < 7) { add8(sm, raw[o + W]); sub8(sm, raw[o]); }
    }
}
__device__ __forceinline__ void attn_pool_phase(LAS unsigned char* lds, const bf16_t* Qb, const bf16_t* Kb, const bf16_t* Vt, const bf16_t* Ub, bf16_t* cat, const float* rpb_l, int G, int bid, int tid, int mode = 0) {
    asm volatile("" : "+v"(tid));
    LAS float* tab = (LAS float*)lds;
    for (int i = tid; i < NHEAD * RPB_H * 64; i += 512) { const int c = (i & 63) - 16, hr = i >> 6; tab[i] = (c >= 0 && c < RPB_W) ? rpb_l[hr * RPB_W + c] * LOG2E : 0.f; }
    __syncthreads();
    const int lane = tid & 63, h = __builtin_amdgcn_readfirstlane(tid >> 6), q16 = lane & 15, g4 = lane >> 4;
    const LAS float* tabh = tab + h * (RPB_H * 64) + 16;
    const bool xl = (G == 256); const int nun = xl ? 4 : (BATCH * 64 + G - 1) / G;
    for (int k = 0; k < nun; ++k) {
        const int unit = (mode & 4) ? 0 : (xl ? ((bid & 7) * 128 + k * 32 + (bid >> 3)) : (bid + k * G));
        if (unit >= BATCH * 64) break;
        const int b = unit >> 6, r = unit & 63; const int rs = r < 4 ? 0 : (r > 60 ? 56 : r - 4);
        const size_t tok0 = (size_t)b * SEQ + r * 64;
#pragma unroll 1
        for (int j = 0; j < ((mode & 2) ? 0 : 4); ++j) {
            const int cb = (j == 0) ? 0 : (j == 1) ? 8 : (j == 2) ? 24 : 32;
            const int qc = 16 * j + q16; const int cs = qc < 8 ? 0 : (qc > 56 ? 48 : qc - 8);
            const int tb0 = cb + g4 * 8 - qc + 15;
            const int vlo = cs - (cb + g4 * 8);
            f32x4 mb4[2];
#pragma unroll
            for (int hh = 0; hh < 2; ++hh)
#pragma unroll
                for (int jj = 0; jj < 4; ++jj) mb4[hh][jj] = ((unsigned)(hh * 4 + jj - vlo) < 16u) ? 0.f : -1e30f;
            const size_t bhb = (size_t)(b * 8 + h) * (SEQ / 16);
            const bf16_t* qp = Qb + (((bhb + r * 4 + j) * 8 + g4) * 16 + q16) * 8;
            const bf16x8 q0 = *(const bf16x8*)qp, q1 = *(const bf16x8*)(qp + 4 * 128);
            bf16x8 kf[8][2][2];
            const int w8 = (cb >> 3) + (q16 >> 2);
            const bf16_t* kbase = Kb + (((bhb + rs * 4 + (w8 >> 1)) * 8 + g4) * 16 + (w8 & 1) * 8 + (q16 & 3)) * 8;
#pragma unroll
            for (int i = 0; i < 8; ++i)
#pragma unroll
                for (int hh = 0; hh < 2; ++hh) { const bf16_t* kp = kbase + (size_t)i * 4096 + hh * 32; kf[i][hh][0] = *(const bf16x8*)kp; kf[i][hh][1] = *(const bf16x8*)(kp + 4 * 128); }
            __builtin_amdgcn_sched_barrier(0);
            f32x4 s[8][2];
            float mx = -1e30f;
#pragma unroll
            for (int i = 0; i < 8; ++i)
#pragma unroll
                for (int hh = 0; hh < 2; ++hh) {
                    f32x4 acc = (f32x4){0.f, 0.f, 0.f, 0.f};
                    acc = __builtin_amdgcn_mfma_f32_16x16x32_bf16(kf[i][hh][0], q0, acc, 0, 0, 0);
                    acc = __builtin_amdgcn_mfma_f32_16x16x32_bf16(kf[i][hh][1], q1, acc, 0, 0, 0);
                    const LAS float* trow = tabh + (rs + i - r + 7) * 64 + tb0 + hh * 4;
                    f32x4 bias4; bias4.x = trow[0]; bias4.y = trow[1]; bias4.z = trow[2]; bias4.w = trow[3];
                    acc = (acc + bias4) + mb4[hh];
                    mx = fmaxf(mx, fmaxf(fmaxf(acc.x, acc.y), fmaxf(acc.z, acc.w)));
                    s[i][hh] = acc;
                }
            bf16x8 vf[8][4];
            const bf16_t* vbase = Vt + (((size_t)(b * 8 + h) * (SEQ / 8) + (rs * 64 + cb) / 8 + g4) * 64 + q16) * 8;
#pragma unroll
            for (int i = 0; i < 8; ++i)
#pragma unroll
                for (int db = 0; db < 4; ++db) vf[i][db] = *(const bf16x8*)(vbase + (size_t)i * 8 * 512 + db * 128);
            __builtin_amdgcn_sched_barrier(0);
            mx = fmaxf(mx, __shfl_xor(mx, 16)); mx = fmaxf(mx, __shfl_xor(mx, 32));
            f32x4 sum4 = (f32x4){0.f, 0.f, 0.f, 0.f}; const f32x4 mx4 = (f32x4){mx, mx, mx, mx};
            u32x4 pw[8];
#pragma unroll
            for (int i = 0; i < 8; ++i) {
#pragma unroll
                for (int hh = 0; hh < 2; ++hh) { const f32x4 d = s[i][hh] - mx4;
                    f32x4 p; p.x = __builtin_amdgcn_exp2f(d.x); p.y = __builtin_amdgcn_exp2f(d.y); p.z = __builtin_amdgcn_exp2f(d.z); p.w = __builtin_amdgcn_exp2f(d.w);
                    s[i][hh] = p; sum4 += p; }
                pw[i].x = pg8::cvt_pk_bf16(s[i][0][0], s[i][0][1]); pw[i].y = pg8::cvt_pk_bf16(s[i][0][2], s[i][0][3]); pw[i].z = pg8::cvt_pk_bf16(s[i][1][0], s[i][1][1]); pw[i].w = pg8::cvt_pk_bf16(s[i][1][2], s[i][1][3]);
            }
            float sum = (sum4.x + sum4.y) + (sum4.z + sum4.w);
            sum += __shfl_xor(sum, 16); sum += __shfl_xor(sum, 32);
            f32x4 o[4];
#pragma unroll
            for (int db = 0; db < 4; ++db) o[db] = (f32x4){0.f, 0.f, 0.f, 0.f};
#pragma unroll
            for (int i = 0; i < 8; ++i) {
                const bf16x8 pf = __builtin_bit_cast(bf16x8, pw[i]);
#pragma unroll
                for (int db = 0; db < 4; ++db) o[db] = __builtin_amdgcn_mfma_f32_16x16x32_bf16(vf[i][db], pf, o[db], 0, 0, 0);
            }
            const float inv = 1.0f / sum;
            bf16_t* op = cat + tix((int)(tok0 + qc), h * 64) + g4 * 4;
#pragma unroll
            for (int db = 0; db < 4; ++db) { u32x2 w; w.x = pg8::cvt_pk_bf16(o[db][0] * inv, o[db][1] * inv); w.y = pg8::cvt_pk_bf16(o[db][2] * inv, o[db][3] * inv); *(u32x2*)(op + (db >> 1) * (256 * 32) + (db & 1) * 16) = w; }
        }
        if (!(mode & 1)) {
            const int gidx = h & 3, hfl = h >> 2; const int T0 = r * 64 + hfl * 32 + g4 * 8; const int chan = gidx * 128 + q16 * 8;
            const bf16_t* Ubc = Ub + (size_t)b * SEQ * AW + chan; bf16_t* catc = cat + tix(b * SEQ + T0, 512 + chan);
            if (gidx == 0) pool_lane<2>(Ubc, catc, T0); else if (gidx == 1) pool_lane<4>(Ubc, catc, T0); else if (gidx == 2) pool_lane<8>(Ubc, catc, T0); else pool_lane<16>(Ubc, catc, T0);
        }
    }
}

constexpr int N_PHASES = 2 + 7 * DEPTH;
__global__ void __launch_bounds__(512, 2) fwd_megakernel(Args a) {
    extern __shared__ __attribute__((aligned(16))) unsigned char lds_raw[];
    LAS unsigned char* lds = (LAS unsigned char*)lds_raw;
    cg::grid_group grid = cg::this_grid();
    const int tid = threadIdx.x, bid = blockIdx.x, G = gridDim.x;
    unsigned char* ws = a.ws;
    bf16_t* H = (bf16_t*)(ws + WS_H); bf16_t* F = (bf16_t*)(ws + WS_F);
    bf16_t* Qb = (bf16_t*)(ws + WS_Q); bf16_t* Kb = (bf16_t*)(ws + WS_K); bf16_t* Vt = (bf16_t*)(ws + WS_VT); bf16_t* Ub = (bf16_t*)(ws + WS_U); bf16_t* CAT = (bf16_t*)(ws + WS_CAT);
    const float* mod = (const float*)(ws + WS_MOD);
    const int lo = a.ph_lo, hi = a.ph_hi;
#define IN(k) (lo <= (k) && (k) < hi)
    unsigned* barw = (unsigned*)(ws + WS_CTL);
    volatile LAS unsigned* misc = (volatile LAS unsigned*)(lds + 131072 + 1024);
    if (bid == 0) { for (int i = tid; i < 8192 + 4 * 16384; i += 512) barw[i] = 0u; }
    if (tid < 8) misc[tid] = 0u;
    __syncthreads();
    XcdBarrier xbar; xbar.bar = barw; xbar.x = 0; xbar.st = misc;
    const bool fusedln = (G == 256);
    int vb = bid;
#define SEAM(k) do { if (IN(k) && IN((k) + 1)) { if ((k) == 0) { grid.sync(); xbar = xcd_barrier_post(barw, misc); if (tid == 0) misc[2] = xb_add(&barw[3456 + 64 * xbar.x], 1u); } \
        else { xcd_barrier(xbar); if ((k) == 1) { \
            if (tid == 0) { bool ok = (G % 8 == 0) && xbar.x < 8u; for (int j = 0; j < 8; ++j) ok = ok && (xb_ld(&barw[3456 + 64 * j]) == (unsigned)(G / 8)); misc[3] = ok ? 1u : 0u; } \
            __syncthreads(); if (misc[3]) vb = (int)(misc[2] * 8u + xbar.x); } } } } while (0)

    if (IN(0)) { for (int rep = 0; rep <= PROBE_P0; ++rep) { p0_prologue(a, lds, G, bid, tid); if (rep < PROBE_P0) __syncthreads(); } }
    SEAM(0);
    if (IN(1)) { ln_phase<false, false>(a.x, nullptr, H, a.ln_in_g, a.ln_in_b, mod + 1 * D, mod + 0 * D, G, bid, tid); }
    SEAM(1);
#pragma unroll 1
    for (int l = 0; l < DEPTH; ++l) {
        const int p = 2 + 7 * l;
        unsigned char* ws = a.ws; asm volatile("" : "+s"(ws));
        bf16_t* H = (bf16_t*)(ws + WS_H); bf16_t* F = (bf16_t*)(ws + WS_F);
        bf16_t* Qb = (bf16_t*)(ws + WS_Q); bf16_t* Kb = (bf16_t*)(ws + WS_K); bf16_t* Vt = (bf16_t*)(ws + WS_VT); bf16_t* Ub = (bf16_t*)(ws + WS_U); bf16_t* CAT = (bf16_t*)(ws + WS_CAT);
        const float* mod = (const float*)(ws + WS_MOD); unsigned* barw = (unsigned*)(ws + WS_CTL);
        const float* modl = mod + (size_t)l * BATCH * NMOD;
        if (IN(p + 0)) {
            pg8::Gemm g{H, (const bf16_t*)(ws + WS_WIN) + (size_t)l * PROJ * D, M, PROJ, D}; pg8::StaticOrder S; S.init(M, PROJ, G, vb);
            pg8::EpiProj E{Qb, Kb, Vt, Ub};
            pg8::gemm_phase<pg8::EpiProj, true, pg8::StaticOrder, true, true>(lds, g, S, E);
        }
        SEAM(p + 0);
        if (IN(p + 1)) { for (int rep = 0; rep <= PROBE_ATT; ++rep) { attn_pool_phase(lds, Qb, Kb, Vt, Ub, CAT, a.rpb + (size_t)l * NHEAD * RPB_N, G, vb, tid, rep < PROBE_ATT ? PROBE_MODE : 0); if (rep < PROBE_ATT) xcd_barrier(xbar); } }
        SEAM(p + 1);
        if (IN(p + 2)) {
            pg8::Gemm g{CAT, (const bf16_t*)(ws + WS_WOUT) + (size_t)l * D * D, M, D, D}; pg8::StaticOrder S; S.init(M, D, G, vb);
            if (fusedln) { pg8::PanelStats st{(unsigned long long*)(ws + WS_X) + (size_t)(2 * l) * M * 4, barw + 8192 + (2 * l) * 16384};
                pg8::EpiResLn<false> E{H, nullptr, modl, 0 * D, 1 * D, 2 * D, a.ln1_g + l * D, a.ln1_b + l * D, modl, 3 * D, 4 * D, st};
                pg8::gemm_phase<pg8::EpiResLn<false>, true, pg8::StaticOrder, true, true>(lds, g, S, E); }
            else { pg8::EpiRes E{H, modl, 0 * D, 1 * D, 2 * D};
                pg8::gemm_phase<pg8::EpiRes, true, pg8::StaticOrder, true, true>(lds, g, S, E); }
        }
        SEAM(p + 2);
        if (IN(p + 3) && !fusedln) { ln_phase<true, false>(H, nullptr, H, a.ln1_g + l * D, a.ln1_b + l * D, modl + 4 * D, modl + 3 * D, G, bid, tid); }
        if (!fusedln) SEAM(p + 3);
        if (IN(p + 4)) {
            pg8::Gemm g{H, (const bf16_t*)(ws + WS_W1) + (size_t)l * FF * D, M, FF, D}; pg8::StaticOrder S; S.init(M, FF, G, vb);
#if STAGGER_US
            { const unsigned long long t0 = __builtin_amdgcn_s_memrealtime(); const unsigned long long dl = (unsigned long long)(vb & 3) * (STAGGER_US * 100ull);
              while (__builtin_amdgcn_s_memrealtime() - t0 < dl) __builtin_amdgcn_s_sleep(16); }
#endif
            { pg8::EpiRelu2 E{F, FF, 0}; pg8::gemm_phase<pg8::EpiRelu2, false, pg8::StaticOrder, true, true>(lds, g, S, E); }
#if PROBE_MLP1
            xcd_barrier(xbar);
            { int ns = PROBE_MLP1_NOSTORE; asm volatile("" : "+s"(ns)); pg8::EpiRelu2 E{F, FF, ns};
#if PROBE_MLP1_HOT
              pg8::HotOrder S2; S2.init(M, FF, G, vb); pg8::gemm_phase<pg8::EpiRelu2, true, pg8::HotOrder>(lds, g, S2, E);
#else
              pg8::gemm_phase<pg8::EpiRelu2, true>(lds, g, S, E);
#endif
            }
#endif
        }
        SEAM(p + 4);
        if (IN(p + 5)) {
            pg8::Gemm g{F, (const bf16_t*)(ws + WS_W2) + (size_t)l * D * FF, M, D, FF}; pg8::StaticOrder S; S.init(M, D, G, vb);
            const bool lastl2 = (l == DEPTH - 1); const float* modn2 = mod + (size_t)(lastl2 ? l : l + 1) * BATCH * NMOD;
            if (fusedln) { pg8::PanelStats st{(unsigned long long*)(ws + WS_X) + (size_t)(2 * l + 1) * M * 4, barw + 8192 + (2 * l + 1) * 16384};
                if (lastl2) { pg8::EpiResLn<true> E{H, a.out, modl, 3 * D, 4 * D, 5 * D, a.ln2_g + l * D, a.ln2_b + l * D, modn2, 0, 0, st};
                    pg8::gemm_phase<pg8::EpiResLn<true>, true, pg8::StaticOrder, true, true>(lds, g, S, E); }
                else { pg8::EpiResLn<false> E{H, nullptr, modl, 3 * D, 4 * D, 5 * D, a.ln2_g + l * D, a.ln2_b + l * D, modn2, 0 * D, 1 * D, st};
                    pg8::gemm_phase<pg8::EpiResLn<false>, true, pg8::StaticOrder, true, true>(lds, g, S, E); } }
            else { pg8::EpiRes E{H, modl, 3 * D, 4 * D, 5 * D};
                pg8::gemm_phase<pg8::EpiRes, true, pg8::StaticOrder, true, true>(lds, g, S, E); }
        }
        if (!(fusedln && l == DEPTH - 1)) SEAM(p + 5);
        if (IN(p + 6) && !fusedln) {
            const bool lastl = (l == DEPTH - 1);
            const float* modn = mod + (size_t)(lastl ? l : l + 1) * BATCH * NMOD;
            if (lastl) ln_phase<true, true>(H, a.out, nullptr, a.ln2_g + l * D, a.ln2_b + l * D, modn, modn, G, bid, tid);
            else ln_phase<true, false>(H, nullptr, H, a.ln2_g + l * D, a.ln2_b + l * D, modn + 1 * D, modn + 0 * D, G, bid, tid);
        }
        if (!fusedln) SEAM(p + 6);
    }
    for (int rep = 0; rep < PROBE_SYNC; ++rep) xcd_barrier(xbar);
#undef IN
#undef SEAM
}

extern "C" void kernel_launch(void* const* d_in, const int* in_sizes, int n_in, void* d_out, int out_size, void* d_ws, size_t ws_size, hipStream_t stream) {
    static int grid = 0;
    if (grid == 0) {
        if (n_in != 17 || in_sizes[0] != M * D || out_size != M * D || ws_size < WS_END) { fprintf(stderr, "kernel_launch: unexpected shapes / workspace (n_in %d, in0 %d, out %d, ws %zu)\n", n_in, n_in > 0 ? in_sizes[0] : -1, out_size, ws_size); grid = -1; return; }
        int dev = 0, cus = 0, per_cu = 0;
        hipGetDevice(&dev); hipDeviceGetAttribute(&cus, hipDeviceAttributeMultiprocessorCount, dev);
        if (hipFuncSetAttribute((const void*)fwd_megakernel, hipFuncAttributeMaxDynamicSharedMemorySize, LDS_BYTES) != hipSuccess) { fprintf(stderr, "kernel_launch: hipFuncSetAttribute failed\n"); grid = -1; return; }
        if (hipOccupancyMaxActiveBlocksPerMultiprocessor(&per_cu, (const void*)fwd_megakernel, 512, LDS_BYTES) != hipSuccess || per_cu < 1) { per_cu = 1; (void)hipGetLastError(); }
        grid = (cus > 0 ? cus : 256) * per_cu;
    }
    if (grid < 0) return;
    Args a{};
    a.x = (const float*)d_in[0]; a.c = (const float*)d_in[1]; a.ln_in_g = (const float*)d_in[2]; a.ln_in_b = (const float*)d_in[3]; a.w_ada = (const float*)d_in[4]; a.b_ada = (const float*)d_in[5];
    a.w_in = (const float*)d_in[6]; a.rpb = (const float*)d_in[7]; a.w_pool = (const float*)d_in[8]; a.pool_scale = (const float*)d_in[9]; a.w_out = (const float*)d_in[10];
    a.ln1_g = (const float*)d_in[11]; a.ln1_b = (const float*)d_in[12]; a.w_mlp1 = (const float*)d_in[13]; a.w_mlp2 = (const float*)d_in[14]; a.ln2_g = (const float*)d_in[15]; a.ln2_b = (const float*)d_in[16];
    a.out = (float*)d_out; a.ws = (unsigned char*)d_ws;
#if MK_MULTI
    for (int p = 0; p < N_PHASES; ++p) { a.ph_lo = p; a.ph_hi = p + 1; hipLaunchKernelGGL(fwd_megakernel, dim3(grid), dim3(512), LDS_BYTES, stream, a); }
#else
    a.ph_lo = 0; a.ph_hi = N_PHASES;
    void* args[] = {&a};
    hipError_t e = hipLaunchCooperativeKernel((const void*)fwd_megakernel, dim3(grid), dim3(512), args, LDS_BYTES, stream);
    if (e != hipSuccess) fprintf(stderr, "kernel_launch: cooperative launch failed: %s (grid %d)\n", hipGetErrorString(e), grid);
#endif
}
```

```cpp
#include <hip/hip_runtime.h>
#include <hip/hip_cooperative_groups.h>
#include <cstdio>
#include <cstdint>
namespace cg = cooperative_groups;

#define LAS __attribute__((address_space(3)))
typedef unsigned short bf16_t;
typedef short bf16x8 __attribute__((ext_vector_type(8)));
typedef float f32x4 __attribute__((ext_vector_type(4)));
typedef float f32x2 __attribute__((ext_vector_type(2)));
typedef unsigned u32x4 __attribute__((ext_vector_type(4)));
typedef unsigned u32x2 __attribute__((ext_vector_type(2)));

#ifndef PROBE_ATT
#define PROBE_ATT 0
#endif
#ifndef PROBE_P0
#define PROBE_P0 0
#endif
#ifndef PROBE_MODE
#define PROBE_MODE 0
#endif
#ifndef PROBE_MLP1
#define PROBE_MLP1 0
#endif
#ifndef PROBE_MLP1_HOT
#define PROBE_MLP1_HOT 0
#endif
#ifndef PROBE_MLP1_NOSTORE
#define PROBE_MLP1_NOSTORE 0
#endif
#ifndef STAGGER_US
#define STAGGER_US 0
#endif
#ifndef PROBE_SYNC
#define PROBE_SYNC 0
#endif
#ifndef MK_MULTI
#define MK_MULTI 0
#endif

constexpr int BATCH = 16, SEQ = 4096, D = 1024, DEPTH = 2, M = BATCH * SEQ;
constexpr int PROJ = 2048, FF = 4096, NMOD = 6 * D, AW = 512;
constexpr int NHEAD = 8;
constexpr float LN_EPS = 1e-5f;
constexpr float DN_ALPHA = 1.41421356237309515f;
constexpr float LOG2E = 1.44269504088896341f;
constexpr float QSCALE = 0.125f * LOG2E;
constexpr int RPB_H = 15, RPB_W = 31, RPB_N = RPB_H * RPB_W;

constexpr size_t MiB = (size_t)1 << 20;
constexpr size_t WS_WIN = 0 * MiB;
constexpr size_t WS_WOUT = 8 * MiB;
constexpr size_t WS_W1 = 12 * MiB;
constexpr size_t WS_W2 = 28 * MiB;
constexpr size_t WS_MOD = 44 * MiB;
constexpr size_t WS_CTL = 46 * MiB;
constexpr size_t WS_X = 48 * MiB;
constexpr size_t WS_H = 304 * MiB;
constexpr size_t WS_F = 432 * MiB;
constexpr size_t WS_Q = 432 * MiB;
constexpr size_t WS_K = 496 * MiB;
constexpr size_t WS_VT = 560 * MiB;
constexpr size_t WS_U = 624 * MiB;
constexpr size_t WS_CAT = 688 * MiB;
constexpr size_t WS_END = 944 * MiB;

constexpr int LDS_BYTES = 147456;

__host__ __device__ __forceinline__ size_t tix(int row, int col) { return (((size_t)(row >> 8) * (D >> 5) + (col >> 5)) * 256 + (row & 255)) * 32 + (col & 31); }

namespace pg8 {
constexpr int BM = 256, BK = 64, HALF = 128, HTB = HALF * BK * 2, STAGE_BYTES = 8 * HTB, NXCD = 8, WGM = 8;
__host__ __device__ __forceinline__ int lds_byte(int r, int c) { const int st = (r >> 4) * 2 + (c >> 5), rr = r & 15, cc = c & 31, ob = rr * 64 + cc * 2; return st * 1024 + (ob ^ (((ob >> 9) & 1) << 5)); }
__host__ __device__ __forceinline__ void stage_rc(int b, int& R, int& C) { const int st = b / 1024, sb = b % 1024, swz = sb ^ (((sb >> 9) & 1) << 5); R = (st >> 1) * 16 + swz / 64; C = (st & 1) * 32 + (swz % 64) / 2; }
__host__ __device__ __forceinline__ int perm32(int rho) { const int n = rho >> 4, i = rho & 15; return 8 * (i >> 2) + 4 * n + (i & 3); }

struct Unit { int pm, pn; };
struct Gemm { const bf16_t* A; const bf16_t* Bt; int M, N, K; };
struct StaticOrder;

struct StaticOrder {
    int nM, nN, nwg, G, c;
    __device__ void init(int M_, int N_, int G_, int c_) { nM = M_ / BM; nN = N_ / BM; nwg = nM * nN; G = G_; c = c_; }
    __device__ bool next(int i, Unit& u) const {
        const long L = (long)i * G + c; if (L >= nwg) return false;
        int wgid = (int)L; { const int q = nwg / NXCD, r = nwg % NXCD, xcd = wgid % NXCD, off = wgid / NXCD; wgid = (xcd < r ? xcd * (q + 1) : r * (q + 1) + (xcd - r) * q) + off; }
        const int nig = WGM * nN, gid = wgid / nig, fm = gid * WGM, gsz = (nM - fm) < WGM ? (nM - fm) : WGM;
        u.pm = fm + ((wgid % nig) % gsz); u.pn = (wgid % nig) / gsz; return true;
    }
};

struct HotOrder : StaticOrder { __device__ bool next(int i, Unit& u) const { const bool r = StaticOrder::next(i, u); u.pm = 0; u.pn = 0; return r; } };
__device__ __forceinline__ unsigned cvt_pk_bf16(float lo, float hi) { unsigned r; asm volatile("v_cvt_pk_bf16_f32 %0, %1, %2" : "=v"(r) : "v"(lo), "v"(hi)); return r; }

struct EpiProj {
    static constexpr bool PERM = true, VSWAP = true, FUSED = false;
    bf16_t* Q; bf16_t* Kb; bf16_t* Vt; bf16_t* U;
    __device__ __forceinline__ void operator()(const f32x4 (&acc)[2][2][4][2], const Unit& u, int wr, int wc, int fr, int fq) const {
        const int t = u.pn >> 1;
        if (t == 2) {
            const int dg0 = (u.pn & 1) * 256 + wr * 64 + fr; const int b = u.pm >> 4; const int s0 = (u.pm & 15) * 256 + wc * 32 + 8 * fq;
#pragma unroll
            for (int ai = 0; ai < 2; ++ai)
#pragma unroll
                for (int m = 0; m < 4; ++m) { const int dg = dg0 + ai * HALF + m * 16;
                    bf16_t* rowp = Vt + ((size_t)(b * 8 + (dg >> 6)) * (SEQ / 8) + (s0 >> 3)) * 512 + (dg & 63) * 8;
#pragma unroll
                    for (int bj = 0; bj < 2; ++bj) { const f32x4 v0 = acc[ai][bj][m][0], v1 = acc[ai][bj][m][1];
                        u32x4 w; w.x = cvt_pk_bf16(v0[0], v0[1]); w.y = cvt_pk_bf16(v0[2], v0[3]); w.z = cvt_pk_bf16(v1[0], v1[1]); w.w = cvt_pk_bf16(v1[2], v1[3]);
                        __builtin_nontemporal_store(w, (u32x4*)(rowp + (size_t)bj * (HALF / 8) * 512)); } }
        } else {
            bf16_t* base = Q + (size_t)t * ((size_t)M * AW); const float sc = t == 0 ? QSCALE : 1.0f;
            const int row0 = u.pm * BM + wr * 64 + fr, col0 = (u.pn & 1) * 256 + wc * 32 + 8 * fq;
            const bool cm = t < 2; const int bq = u.pm >> 4;
#pragma unroll
            for (int ai = 0; ai < 2; ++ai)
#pragma unroll
                for (int m = 0; m < 4; ++m) { const int row = row0 + ai * HALF + m * 16;
                    bf16_t* rowp = cm ? base + ((size_t)(bq * 64 + (col0 >> 3)) * SEQ + (row & (SEQ - 1))) * 8 : base + (size_t)row * AW + col0;
                    const size_t bjs = cm ? (size_t)(HALF / 8) * SEQ * 8 : (size_t)HALF;
#pragma unroll
                    for (int bj = 0; bj < 2; ++bj) { const f32x4 v0 = acc[ai][bj][m][0] * sc, v1 = acc[ai][bj][m][1] * sc;
                        u32x4 w; w.x = cvt_pk_bf16(v0[0], v0[1]); w.y = cvt_pk_bf16(v0[2], v0[3]); w.z = cvt_pk_bf16(v1[0], v1[1]); w.w = cvt_pk_bf16(v1[2], v1[3]);
                        __builtin_nontemporal_store(w, (u32x4*)(rowp + bj * bjs)); } }
        }
    }
};
struct EpiRelu2 {
    static constexpr bool PERM = true, VSWAP = false, FUSED = false;
    bf16_t* O; int ldc; int nostore;
    __device__ __forceinline__ void operator()(const f32x4 (&acc)[2][2][4][2], const Unit& u, int wr, int wc, int fr, int fq) const {
        if (nostore) return;
        const int row0 = u.pm * BM + wr * 64 + fr, col0 = u.pn * BM + wc * 32 + 8 * fq;
#pragma unroll
        for (int ai = 0; ai < 2; ++ai)
#pragma unroll
            for (int m = 0; m < 4; ++m) { bf16_t* rowp = O + (((size_t)u.pm * (ldc >> 5) + (col0 >> 5)) * BM + (wr * 64 + fr + ai * HALF + m * 16)) * 32 + (col0 & 31);
#pragma unroll
                for (int bj = 0; bj < 2; ++bj) { f32x4 v0 = acc[ai][bj][m][0], v1 = acc[ai][bj][m][1];
#pragma unroll
                    for (int j = 0; j < 4; ++j) { const float a = fmaxf(v0[j], 0.f), b = fmaxf(v1[j], 0.f); v0[j] = a * a; v1[j] = b * b; }
                    u32x4 w; w.x = cvt_pk_bf16(v0[0], v0[1]); w.y = cvt_pk_bf16(v0[2], v0[3]); w.z = cvt_pk_bf16(v1[0], v1[1]); w.w = cvt_pk_bf16(v1[2], v1[3]);
                    __builtin_nontemporal_store(w, (u32x4*)(rowp + (size_t)bj * (HALF / 32) * BM * 32)); } }
    }
};
struct EpiRes {
    static constexpr bool PERM = true, VSWAP = false, FUSED = false;
    bf16_t* H; const float* mod; int sh_off, sc_off, g_off;
    __device__ __forceinline__ void operator()(const f32x4 (&acc)[2][2][4][2], const Unit& u, int wr, int wc, int fr, int fq) const {
        const int row0 = u.pm * BM + wr * 64 + fr, col0 = u.pn * BM + wc * 32 + 8 * fq; const int b = u.pm >> 4;
        bf16_t* hb = H + (((size_t)(u.pm * 32 + u.pn * 8 + wc) * 256 + wr * 64 + fr) * 32 + 8 * fq);
        const float* mb = mod + (size_t)b * NMOD + col0;
#pragma unroll
        for (int bj = 0; bj < 2; ++bj) {
            f32x4 shv[2], aiv[2], g1v[2];
#pragma unroll
            for (int n = 0; n < 2; ++n) { shv[n] = *(const f32x4*)(mb + sh_off + bj * HALF + 4 * n); const f32x4 s1 = *(const f32x4*)(mb + sc_off + bj * HALF + 4 * n) + 1.0f;
                aiv[n] = (f32x4){DN_ALPHA / s1.x, DN_ALPHA / s1.y, DN_ALPHA / s1.z, DN_ALPHA / s1.w}; g1v[n] = *(const f32x4*)(mb + g_off + bj * HALF + 4 * n) + 1.0f; }
#pragma unroll
            for (int ai = 0; ai < 2; ++ai) {
                u32x4 hw[4];
#pragma unroll
                for (int m = 0; m < 4; ++m) hw[m] = *(const u32x4*)(hb + bj * (4 * 256 * 32) + (ai * HALF + m * 16) * 32);
#pragma unroll
                for (int m = 0; m < 4; ++m) { const u32x4 w0 = hw[m];
                    f32x4 h0, h1; h0.x = __builtin_bit_cast(float, w0.x << 16); h0.y = __builtin_bit_cast(float, w0.x & 0xffff0000u); h0.z = __builtin_bit_cast(float, w0.y << 16); h0.w = __builtin_bit_cast(float, w0.y & 0xffff0000u);
                    h1.x = __builtin_bit_cast(float, w0.z << 16); h1.y = __builtin_bit_cast(float, w0.z & 0xffff0000u); h1.z = __builtin_bit_cast(float, w0.w << 16); h1.w = __builtin_bit_cast(float, w0.w & 0xffff0000u);
                    const f32x4 z0 = (h0 - shv[0]) * aiv[0] + g1v[0] * acc[ai][bj][m][0], z1 = (h1 - shv[1]) * aiv[1] + g1v[1] * acc[ai][bj][m][1];
                    u32x4 w; w.x = cvt_pk_bf16(z0[0], z0[1]); w.y = cvt_pk_bf16(z0[2], z0[3]); w.z = cvt_pk_bf16(z1[0], z1[1]); w.w = cvt_pk_bf16(z1[2], z1[3]);
                    *(u32x4*)(hb + bj * (4 * 256 * 32) + (ai * HALF + m * 16) * 32) = w; }
                asm volatile("" ::: "memory"); }
        }
    }
};

constexpr int TAB_OFF = 131072 + 2048;
struct PanelStats {
    unsigned long long* xbuf;
    unsigned* cnt;
    __device__ __forceinline__ void run(const f32x4 (&v)[2][2][4][2], const Unit& u, int wr, int wc, int fr, int fq, LAS unsigned char* lds, int wid, int lane) const {
        LAS f32x2* P = (LAS f32x2*)(lds + TAB_OFF);
        LAS f32x2* S = (LAS f32x2*)(lds + TAB_OFF + 8192);
#pragma unroll
        for (int ai = 0; ai < 2; ++ai)
#pragma unroll
            for (int m = 0; m < 4; ++m) {
                float s = 0.f;
#pragma unroll
                for (int bj = 0; bj < 2; ++bj)
#pragma unroll
                    for (int n = 0; n < 2; ++n) { const f32x4 x = v[ai][bj][m][n]; s += (x[0] + x[1]) + (x[2] + x[3]); }
                s += __shfl_xor(s, 16); s += __shfl_xor(s, 32);
                const float mw = s * (1.0f / 64.0f); float q = 0.f;
#pragma unroll
                for (int bj = 0; bj < 2; ++bj)
#pragma unroll
                    for (int n = 0; n < 2; ++n) { const f32x4 d = v[ai][bj][m][n] - mw; q += (d[0] * d[0] + d[1] * d[1]) + (d[2] * d[2] + d[3] * d[3]); }
                q += __shfl_xor(q, 16); q += __shfl_xor(q, 32);
                if (fq == 0) P[(ai * HALF + wr * 64 + m * 16 + fr) * 4 + wc] = (f32x2){mw, q};
            }
        asm volatile("s_waitcnt lgkmcnt(0)" ::: "memory"); __builtin_amdgcn_s_barrier(); asm volatile("" ::: "memory");
        const int row = wid * 32 + (lane & 31);
        if (lane < 32) {
            const f32x2 a = P[row * 4 + 0], b = P[row * 4 + 1], c = P[row * 4 + 2], d = P[row * 4 + 3];
            const float mt = (a.x + b.x + c.x + d.x) * 0.25f;
            const float da = a.x - mt, db = b.x - mt, dc = c.x - mt, dd = d.x - mt;
            const float m2 = (a.y + b.y) + (c.y + d.y) + 64.0f * ((da * da + db * db) + (dc * dc + dd * dd));
            unsigned long long* slot = xbuf + ((size_t)(u.pm * BM + row) * 4 + u.pn);
            __hip_atomic_store(slot, ((unsigned long long)__float_as_uint(m2) << 32) | __float_as_uint(mt), __ATOMIC_RELAXED, __HIP_MEMORY_SCOPE_AGENT);
        }
        asm volatile("s_waitcnt vmcnt(0)" ::: "memory");
        if (lane == 0) __hip_atomic_fetch_add(cnt + 64 * u.pm, 1u, __ATOMIC_RELAXED, __HIP_MEMORY_SCOPE_AGENT);
        if (wid == 0) {
            unsigned sp = 0;
            while ((unsigned)__builtin_amdgcn_readfirstlane(__hip_atomic_load(cnt + 64 * u.pm, __ATOMIC_RELAXED, __HIP_MEMORY_SCOPE_AGENT)) < 32u) { __builtin_amdgcn_s_sleep(2); if (++sp > (1u << 20)) break; }
            __builtin_amdgcn_fence(__ATOMIC_ACQUIRE, "agent");
        }
        asm volatile("s_waitcnt vmcnt(0) lgkmcnt(0)" ::: "memory"); __builtin_amdgcn_s_barrier(); asm volatile("" ::: "memory");
        if (lane < 32) {
            const unsigned long long* slot = xbuf + (size_t)(u.pm * BM + row) * 4; float mt[4], m2[4]; float ms = 0.f;
#pragma unroll
            for (int t = 0; t < 4; ++t) { const unsigned long long w = __hip_atomic_load(slot + t, __ATOMIC_RELAXED, __HIP_MEMORY_SCOPE_AGENT); mt[t] = __uint_as_float((unsigned)w); m2[t] = __uint_as_float((unsigned)(w >> 32)); ms += mt[t]; }
            const float mean = ms * 0.25f; float q = 0.f;
#pragma unroll
            for (int t = 0; t < 4; ++t) { const float dm = mt[t] - mean; q += m2[t] + 256.0f * dm * dm; }
            S[row] = (f32x2){mean, 1.0f / sqrtf(q * (1.0f / 1024.0f) + LN_EPS)};
        }
        asm volatile("s_waitcnt lgkmcnt(0)" ::: "memory"); __builtin_amdgcn_s_barrier(); asm volatile("" ::: "memory");
    }
};
template <bool OUT_F32> struct EpiResLn {
    static constexpr bool PERM = true, VSWAP = false, FUSED = true;
    bf16_t* H; float* outF; const float* mod; int sh_off, sc_off, g_off; const float* lng; const float* lnb; const float* mod2; int sh2_off, sc2_off; PanelStats st;
    __device__ __forceinline__ void fused(f32x4 (&acc)[2][2][4][2], const Unit& u, int wr, int wc, int fr, int fq, LAS unsigned char* lds, int wid, int lane) const {
        const int row0 = u.pm * BM + wr * 64 + fr, col0 = u.pn * BM + wc * 32 + 8 * fq; const int b = u.pm >> 4;
        bf16_t* hb = H + (((size_t)(u.pm * 32 + u.pn * 8 + wc) * 256 + wr * 64 + fr) * 32 + 8 * fq);
        const float* mb = mod + (size_t)b * NMOD + col0;
#pragma unroll
        for (int bj = 0; bj < 2; ++bj) {
            u32x4 hw[2][4];
#pragma unroll
            for (int ai = 0; ai < 2; ++ai)
#pragma unroll
                for (int m = 0; m < 4; ++m) hw[ai][m] = *(const u32x4*)(hb + bj * (4 * 256 * 32) + (ai * HALF + m * 16) * 32);
#pragma unroll
            for (int n = 0; n < 2; ++n) {
                const f32x4 shv = *(const f32x4*)(mb + sh_off + bj * HALF + 4 * n); const f32x4 s1 = *(const f32x4*)(mb + sc_off + bj * HALF + 4 * n) + 1.0f;
                const f32x4 aiv = (f32x4){DN_ALPHA * __builtin_amdgcn_rcpf(s1.x), DN_ALPHA * __builtin_amdgcn_rcpf(s1.y), DN_ALPHA * __builtin_amdgcn_rcpf(s1.z), DN_ALPHA * __builtin_amdgcn_rcpf(s1.w)};
                const f32x4 g1v = *(const f32x4*)(mb + g_off + bj * HALF + 4 * n) + 1.0f;
#pragma unroll
                for (int ai = 0; ai < 2; ++ai)
#pragma unroll
                    for (int m = 0; m < 4; ++m) { const unsigned wa = n ? hw[ai][m].z : hw[ai][m].x, wb = n ? hw[ai][m].w : hw[ai][m].y;
                        f32x4 h0; h0.x = __builtin_bit_cast(float, wa << 16); h0.y = __builtin_bit_cast(float, wa & 0xffff0000u); h0.z = __builtin_bit_cast(float, wb << 16); h0.w = __builtin_bit_cast(float, wb & 0xffff0000u);
                        acc[ai][bj][m][n] = (h0 - shv) * aiv + g1v * acc[ai][bj][m][n]; }
            }
#pragma unroll
            for (int ai = 0; ai < 2; ++ai) {
                asm volatile("" : "+v"(acc[ai][bj][0][0]), "+v"(acc[ai][bj][0][1]), "+v"(acc[ai][bj][1][0]), "+v"(acc[ai][bj][1][1]));
                asm volatile("" : "+v"(acc[ai][bj][2][0]), "+v"(acc[ai][bj][2][1]), "+v"(acc[ai][bj][3][0]), "+v"(acc[ai][bj][3][1])); }
            asm volatile("" ::: "memory");
        }
        st.run(acc, u, wr, wc, fr, fq, lds, wid, lane);
        const LAS f32x2* S = (const LAS f32x2*)(lds + TAB_OFF + 8192);
        const float* m2b = mod2 + (size_t)b * NMOD + col0;
#pragma unroll
        for (int bj = 0; bj < 2; ++bj) {
            f32x4 Av[2], Bv[2];
#pragma unroll
            for (int n = 0; n < 2; ++n) { const f32x4 gl = *(const f32x4*)(lng + col0 + bj * HALF + 4 * n), bl = *(const f32x4*)(lnb + col0 + bj * HALF + 4 * n);
                if (OUT_F32) { Av[n] = gl; Bv[n] = bl; }
                else { const f32x4 s1 = *(const f32x4*)(m2b + sc2_off + bj * HALF + 4 * n) + 1.0f, sh2 = *(const f32x4*)(m2b + sh2_off + bj * HALF + 4 * n); Av[n] = gl * s1; Bv[n] = bl * s1 + sh2; } }
#pragma unroll
            for (int ai = 0; ai < 2; ++ai)
#pragma unroll
                for (int m = 0; m < 4; ++m) { const int r = ai * HALF + wr * 64 + m * 16 + fr; const f32x2 sr = S[r];
                    const f32x4 o0 = (acc[ai][bj][m][0] - sr.x) * sr.y * Av[0] + Bv[0], o1 = (acc[ai][bj][m][1] - sr.x) * sr.y * Av[1] + Bv[1];
                    if (OUT_F32) { float* p = outF + (size_t)(u.pm * BM + r) * D + col0 + bj * HALF; *(f32x4*)p = o0; *(f32x4*)(p + 4) = o1; }
                    else { u32x4 w; w.x = cvt_pk_bf16(o0[0], o0[1]); w.y = cvt_pk_bf16(o0[2], o0[3]); w.z = cvt_pk_bf16(o1[0], o1[1]); w.w = cvt_pk_bf16(o1[2], o1[3]);
                        *(u32x4*)(hb + bj * (4 * 256 * 32) + (ai * HALF + m * 16) * 32) = w; } }
        }
    }
};

template <class Epi, bool ALIGN_EPI, class Sched = StaticOrder, bool ACM = false, bool BCM = false>
__device__ __forceinline__ void gemm_phase(LAS unsigned char* lds, const Gemm g, const Sched& S, const Epi& E) {
    int tid = threadIdx.x; asm volatile("" : "+v"(tid));
    const int wid = __builtin_amdgcn_readfirstlane(tid >> 6), lane = tid & 63, wr = wid >> 2, wc = wid & 3, fr = lane & 15, fq = lane >> 4;
    const int K = g.K, nt = K / BK;
    unsigned voffA[2], voffB[2];
#pragma unroll
    for (int i = 0; i < 2; ++i) { int R, C; stage_rc(tid * 16 + i * 8192, R, C); const int Rb = Epi::PERM ? ((R & ~31) + perm32(R & 31)) : R;
        voffA[i] = ACM ? (unsigned)(((C >> 5) * BM + R) * 64 + (C & 31) * 2) : (unsigned)(R * K + C) * 2u; voffB[i] = BCM ? (unsigned)(((C >> 5) * BM + Rb) * 64 + (C & 31) * 2) : (unsigned)(Rb * K + C) * 2u; }
    static_assert(!Epi::VSWAP || (ACM == BCM), "operand swapping needs A and B in the same layout");
    const size_t kstepR = (size_t)(BK * 2), hstepR = (size_t)HALF * K * 2, tstepR = 2 * hstepR;
    const size_t kstepT = (size_t)(BK / 32) * BM * 64, hstepT = (size_t)HALF * 64, tstepT = (size_t)(K / 32) * BM * 64;
    const size_t kstepA = ACM ? kstepT : kstepR, hstepA = ACM ? hstepT : hstepR, tstepA = ACM ? tstepT : tstepR;
    const size_t kstepB = BCM ? kstepT : kstepR, hstepB = BCM ? hstepT : hstepR, tstepB = BCM ? tstepT : tstepR;
    const unsigned ldsw = (unsigned)wid * 1024u;
    const int aoff = lds_byte(wr * 64 + fr, fq * 8), boff = lds_byte(wc * 32 + fr, fq * 8);
#define PG8_SA(b, h) (((b) * 2 + (h)) * HTB)
#define PG8_SB(b, h) ((4 + (b) * 2 + (h)) * HTB)
#define PG8_STAGE(bufoff, gbase, voff) do { _Pragma("unroll") for (int _i = 0; _i < 2; ++_i) \
        __builtin_amdgcn_global_load_lds((const unsigned*)((const char*)(gbase) + (voff)[_i]), (LAS unsigned*)(lds + (bufoff) + ldsw + _i * 8192), 16, 0, 0); } while (0)
#define PG8_LDA(dst, b, h) do { _Pragma("unroll") for (int m = 0; m < 4; ++m) _Pragma("unroll") for (int k = 0; k < 2; ++k) dst[m][k] = *(const LAS bf16x8*)(lds + PG8_SA(b, h) + aoff + m * 2048 + k * 1024); } while (0)
#define PG8_LDB(dst, b, h) do { _Pragma("unroll") for (int n = 0; n < 2; ++n) _Pragma("unroll") for (int k = 0; k < 2; ++k) dst[n][k] = *(const LAS bf16x8*)(lds + PG8_SB(b, h) + boff + n * 2048 + k * 1024); } while (0)
#define PG8_MMA(ai, bj, At, Bt) do { __builtin_amdgcn_s_setprio(1); _Pragma("unroll") for (int m = 0; m < 4; ++m) _Pragma("unroll") for (int n = 0; n < 2; ++n) _Pragma("unroll") for (int k = 0; k < 2; ++k) \
        acc[ai][bj][m][n] = __builtin_amdgcn_mfma_f32_16x16x32_bf16(Bt[n][k], At[m][k], acc[ai][bj][m][n], 0, 0, 0); __builtin_amdgcn_s_setprio(0); } while (0)
#define PG8_WAIT_V(n) asm volatile("s_waitcnt vmcnt(" #n ")" ::: "memory")
#define PG8_WAIT_L(n) asm volatile("s_waitcnt lgkmcnt(" #n ")" ::: "memory")
#define PG8_BAR __builtin_amdgcn_s_barrier()
#define PG8_SCHED __builtin_amdgcn_sched_barrier(0)
#define PG8_PTRS(u, pa, pb) do { const bool _sw = Epi::VSWAP && (((u).pn >> 1) == 2); const char* _a = (const char*)g.A + (size_t)(u).pm * tstepA; const char* _b = (const char*)g.Bt + (size_t)(u).pn * tstepB; pa = _sw ? _b : _a; pb = _sw ? _a : _b; } while (0)
    Unit cur, nxt; int ui = 0;
    if (!S.next(0, cur)) return;
    f32x4 acc[2][2][4][2];
#pragma unroll
    for (int a = 0; a < 2; ++a)
#pragma unroll
        for (int b = 0; b < 2; ++b)
#pragma unroll
            for (int m = 0; m < 4; ++m)
#pragma unroll
                for (int n = 0; n < 2; ++n) acc[a][b][m][n] = (f32x4){0.f, 0.f, 0.f, 0.f};
    bf16x8 At[4][2], B0[2][2], B1[2][2];
    const char* cA; const char* cB; PG8_PTRS(cur, cA, cB);
    PG8_STAGE(PG8_SB(0, 0), cB, voffB); PG8_STAGE(PG8_SB(0, 1), cB + hstepB, voffB); PG8_STAGE(PG8_SA(0, 0), cA, voffA); PG8_STAGE(PG8_SA(0, 1), cA + hstepA, voffA);
    if (wr == 1) PG8_BAR;
    PG8_WAIT_V(2); PG8_BAR;
    PG8_STAGE(PG8_SB(1, 0), cB + kstepB, voffB); PG8_STAGE(PG8_SA(1, 0), cA + kstepA, voffA); PG8_STAGE(PG8_SB(1, 1), cB + hstepB + kstepB, voffB);
    PG8_WAIT_V(6); PG8_BAR;
    for (;;) {
        const bool has_next = S.next(ui + 1, nxt);
        const char* nA = cA; const char* nB = cB; if (has_next) { PG8_PTRS(nxt, nA, nB); }
        for (int t = 0; t < nt; t += 2) {
            const bool last = (t == nt - 2);
            const char* a1 = cA + (size_t)(t + 1) * kstepA;
            const char* a2 = last ? nA : cA + (size_t)(t + 2) * kstepA; const char* b2 = last ? nB : cB + (size_t)(t + 2) * kstepB;
            const char* a3 = a2 + kstepA; const char* b3 = b2 + kstepB;
            PG8_LDB(B0, 0, 0); PG8_LDB(B1, 0, 1); PG8_SCHED; PG8_LDA(At, 0, 0); PG8_STAGE(PG8_SA(1, 1), a1 + hstepA, voffA);
            PG8_WAIT_V(8); PG8_WAIT_L(0); PG8_BAR; PG8_MMA(0, 0, At, B0); PG8_MMA(0, 1, At, B1); PG8_BAR; PG8_SCHED;
            PG8_LDA(At, 0, 1); PG8_STAGE(PG8_SB(0, 0), b2, voffB); PG8_STAGE(PG8_SB(0, 1), b2 + hstepB, voffB); PG8_STAGE(PG8_SA(0, 0), a2, voffA);
            PG8_WAIT_V(8); PG8_WAIT_L(0); PG8_BAR; PG8_MMA(1, 0, At, B0); PG8_MMA(1, 1, At, B1); PG8_BAR; PG8_SCHED;
            PG8_LDB(B0, 1, 0); PG8_LDB(B1, 1, 1); PG8_SCHED; PG8_LDA(At, 1, 0); PG8_STAGE(PG8_SA(0, 1), a2 + hstepA, voffA);
            PG8_WAIT_V(8); PG8_WAIT_L(0); PG8_BAR; PG8_MMA(0, 0, At, B0); PG8_MMA(0, 1, At, B1); PG8_BAR; PG8_SCHED;
            PG8_LDA(At, 1, 1); PG8_STAGE(PG8_SB(1, 0), b3, voffB); PG8_STAGE(PG8_SB(1, 1), b3 + hstepB, voffB); PG8_STAGE(PG8_SA(1, 0), a3, voffA);
            PG8_WAIT_V(8); PG8_WAIT_L(0); PG8_BAR; PG8_MMA(1, 0, At, B0); PG8_MMA(1, 1, At, B1); PG8_BAR; PG8_SCHED;
        }
        if constexpr (ALIGN_EPI) { if (wr == 0) PG8_BAR; }
        if constexpr (Epi::FUSED) E.fused(acc, cur, wr, wc, fr, fq, lds, wid, lane); else E(acc, cur, wr, wc, fr, fq);
        if (!has_next) break;
#pragma unroll
        for (int a = 0; a < 2; ++a)
#pragma unroll
            for (int b = 0; b < 2; ++b)
#pragma unroll
                for (int m = 0; m < 4; ++m)
#pragma unroll
                    for (int n = 0; n < 2; ++n) acc[a][b][m][n] = (f32x4){0.f, 0.f, 0.f, 0.f};
        cur = nxt; cA = nA; cB = nB; ++ui;
        if constexpr (ALIGN_EPI) { if (wr == 1) PG8_BAR; }
    }
    PG8_WAIT_V(0);
    if constexpr (!ALIGN_EPI) { if (wr == 0) PG8_BAR; }
    PG8_BAR;
#undef PG8_SA
#undef PG8_SB
#undef PG8_STAGE
#undef PG8_LDA
#undef PG8_LDB
#undef PG8_MMA
#undef PG8_WAIT_V
#undef PG8_WAIT_L
#undef PG8_BAR
#undef PG8_SCHED
#undef PG8_PTRS
}
}

#define XB_TMO      128
#define XB_XCNT(j)  (256  + 64 * (j))
#define XB_XSUB(j)  (1280 + 64 * (j))
#define XB_XGEN(j)  (2304 + 64 * (j))
#define XB_TOP      3328
#define XB_TOPGEN   3392
#define XCD_BAR_WORDS 3456
#define XB_SPIN_CAP (1u << 18)
__device__ __forceinline__ unsigned xb_ld(unsigned* p)              { return __hip_atomic_load(p, __ATOMIC_RELAXED, __HIP_MEMORY_SCOPE_AGENT); }
__device__ __forceinline__ unsigned xb_add(unsigned* p, unsigned v) { return __hip_atomic_fetch_add(p, v, __ATOMIC_RELAXED, __HIP_MEMORY_SCOPE_AGENT); }
__device__ __forceinline__ unsigned xb_xcc_id() { return (unsigned)__builtin_amdgcn_s_getreg((3 << 11) | 20) & 0xFu; }
#define XB_SPIN(cond, bar) do { unsigned _sp = 0; while (cond) { __builtin_amdgcn_s_sleep(1); \
    if ((++_sp & 255u) == 0u) { if (xb_ld(&(bar)[XB_TMO])) break; if (_sp > XB_SPIN_CAP) { atomicAdd(&(bar)[XB_TMO], 1u); break; } } } } while (0)
struct XcdBarrier { unsigned* bar; unsigned x; volatile LAS unsigned* st; };
__device__ __forceinline__ XcdBarrier xcd_barrier_post(unsigned* bar, volatile LAS unsigned* st) {
    XcdBarrier b; b.bar = bar; b.x = xb_xcc_id(); b.st = st;
    if (threadIdx.x == 0) (void)xb_add(&bar[XB_XCNT(b.x)], 1u);
    return b;
}
__device__ __forceinline__ void xcd_barrier_complete(unsigned* bar, unsigned x, unsigned& nloc, unsigned& nx) {
    const unsigned G = gridDim.x * gridDim.y * gridDim.z;
    unsigned sum, cnt, mine, sp = 0u;
    for (;;) {
        sum = 0u; cnt = 0u; mine = 0u;
#pragma unroll
        for (unsigned j = 0; j < 16; ++j) { const unsigned c = xb_ld(&bar[XB_XCNT(j)]); sum += c; cnt += (c > 0u) ? 1u : 0u; mine = (j == x) ? c : mine; }
        if (sum == G) break;
        __builtin_amdgcn_s_sleep(1);
        if ((++sp & 255u) == 0u) { if (xb_ld(&bar[XB_TMO])) break; if (sp > XB_SPIN_CAP) { atomicAdd(&bar[XB_TMO], 1u); break; } }
    }
    nloc = mine > 0u ? mine : 1u; nx = cnt > 0u ? cnt : 1u;
}
__device__ __forceinline__ void xcd_barrier(const XcdBarrier& b) {
    asm volatile("s_waitcnt vmcnt(0)" ::: "memory");
    __syncthreads();
    if (threadIdx.x == 0) {
        unsigned* bar = b.bar;
        __builtin_amdgcn_s_waitcnt(0);
        unsigned nloc = b.st[0], nx = b.st[1];
        if (nloc == 0u) { xcd_barrier_complete(bar, b.x, nloc, nx); b.st[0] = nloc; b.st[1] = nx; }
        const unsigned old = xb_add(&bar[XB_XSUB(b.x)], 1u);
        const unsigned gen = old / nloc;
        if (old + 1u == (gen + 1u) * nloc) {
            __builtin_amdgcn_fence(__ATOMIC_RELEASE, "agent");
            asm volatile("s_waitcnt vmcnt(0)" ::: "memory");
            const unsigned og = xb_add(&bar[XB_TOP], 1u);
            const unsigned tg = og / nx;
            if (og + 1u == (tg + 1u) * nx) xb_add(&bar[XB_TOPGEN], 1u);
            else XB_SPIN(xb_ld(&bar[XB_TOPGEN]) == tg, bar);
            __builtin_amdgcn_fence(__ATOMIC_ACQUIRE, "agent");
            xb_add(&bar[XB_XGEN(b.x)], 1u);
            asm volatile("s_waitcnt vmcnt(0)" ::: "memory");
        } else {
            XB_SPIN(xb_ld(&bar[XB_XGEN(b.x)]) == gen, bar);
            __builtin_amdgcn_fence(__ATOMIC_ACQUIRE, "agent");
            asm volatile("s_waitcnt vmcnt(0)" ::: "memory");
        }
    }
    __syncthreads();
}

__device__ __forceinline__ unsigned f2bf(float f) { unsigned u = __builtin_bit_cast(unsigned, f); return (u + 0x7fffu + ((u >> 16) & 1u)) >> 16; }
__device__ __forceinline__ unsigned pk2(float lo, float hi) { return f2bf(lo) | (f2bf(hi) << 16); }
__device__ __forceinline__ float bflo(unsigned w) { return __builtin_bit_cast(float, w << 16); }
__device__ __forceinline__ float bfhi(unsigned w) { return __builtin_bit_cast(float, w & 0xffff0000u); }
__device__ __forceinline__ float wave_sum(float v) {
#pragma unroll
    for (int o = 1; o < 64; o <<= 1) v += __shfl_xor(v, o);
    return v;
}

template <bool TILED>
__device__ __forceinline__ void transpose_item(const float* W, int N, bf16_t* WT, int ldw, LAS float* scr, int kb, int nb, int lane) {
    const int k0 = 64 * kb, n0 = 32 * nb;
#pragma unroll 8
    for (int i = 0; i < 32; ++i) { const int kk = 2 * i + (lane >> 5); scr[kk * 33 + (lane & 31)] = W[(size_t)(k0 + kk) * N + n0 + (lane & 31)]; }
    asm volatile("s_waitcnt lgkmcnt(0)" ::: "memory");
    const int c = lane & 7;
#pragma unroll
    for (int j = 0; j < 4; ++j) { const int n = (lane >> 3) + 8 * j; const LAS float* s = scr + (8 * c) * 33 + n;
        u32x4 o; o.x = pk2(s[0 * 33], s[1 * 33]); o.y = pk2(s[2 * 33], s[3 * 33]); o.z = pk2(s[4 * 33], s[5 * 33]); o.w = pk2(s[6 * 33], s[7 * 33]);
        const int nn = n0 + n, kk = k0 + 8 * c;
        bf16_t* dst = TILED ? WT + (((size_t)(nn >> 8) * (ldw >> 5) + (kk >> 5)) * 256 + (nn & 255)) * 32 + (kk & 31) : WT + (size_t)nn * ldw + kk;
        *(u32x4*)dst = o; }
    asm volatile("s_waitcnt lgkmcnt(0)" ::: "memory");
}

struct Args {
    const float *x, *c, *ln_in_g, *ln_in_b, *w_ada, *b_ada, *w_in, *rpb, *w_pool, *pool_scale, *w_out, *ln1_g, *ln1_b, *w_mlp1, *w_mlp2, *ln2_g, *ln2_b;
    float* out; unsigned char* ws; int ph_lo, ph_hi;
};

__device__ __forceinline__ void p0_prologue(const Args& a, LAS unsigned char* lds, int G, int bid, int tid) {
    asm volatile("" : "+v"(tid));
    const int lane = tid & 63, wave = tid >> 6;
    unsigned char* ws = a.ws;
    float* mod = (float*)(ws + WS_MOD);
    for (int item = bid; item < 2 * (NMOD / 64); item += G) {
        const int l = item / (NMOD / 64), n0 = (item % (NMOD / 64)) * 64;
        LAS float* cact = (LAS float*)lds;
        LAS float* red = (LAS float*)(lds + 65536);
        for (int i = tid; i < BATCH * D; i += 512) { const int b = i >> 10, k = i & 1023; const float v = a.c[i]; cact[k * 16 + b] = v / (1.0f + expf(-v)); }
        __syncthreads();
        const int ks = tid >> 6, col = tid & 63;
        float acc[16];
#pragma unroll
        for (int b = 0; b < 16; ++b) acc[b] = 0.f;
        const float* wp = a.w_ada + (size_t)l * D * NMOD + (size_t)(ks * 128) * NMOD + n0 + col;
#pragma unroll 4
        for (int kk = 0; kk < 128; ++kk) {
            const float w = wp[(size_t)kk * NMOD];
            const LAS f32x4* cp = (const LAS f32x4*)(cact + (ks * 128 + kk) * 16);
#pragma unroll
            for (int q = 0; q < 4; ++q) { const f32x4 cv = cp[q]; acc[4 * q + 0] += cv.x * w; acc[4 * q + 1] += cv.y * w; acc[4 * q + 2] += cv.z * w; acc[4 * q + 3] += cv.w * w; }
        }
#pragma unroll
        for (int b = 0; b < 16; ++b) red[(ks * 16 + b) * 64 + col] = acc[b];
        __syncthreads();
        for (int o = tid; o < 1024; o += 512) { const int b = o >> 6, cc = o & 63; float s = 0.f;
#pragma unroll
            for (int k8 = 0; k8 < 8; ++k8) s += red[(k8 * 16 + b) * 64 + cc];
            mod[(size_t)(l * 16 + b) * NMOD + n0 + cc] = s + a.b_ada[l * NMOD + n0 + cc]; }
        __syncthreads();
    }
    for (int idx = bid * 512 + tid; idx < 2 * 4 * 16 * 1024; idx += G * 512) {
        const int l = idx >> 16, g = (idx >> 14) & 3, cch = (idx >> 10) & 15, n = idx & 1023;
        const float* wo = a.w_out + (size_t)l * D * D + (size_t)(512 + g * 128) * D + n;
        const float* wpl = a.w_pool + ((size_t)(l * 4 + g) * 128 + cch * 8) * 128;
        const float* ps = a.pool_scale + l * 512 + g * 128;
        float acc[8];
#pragma unroll
        for (int i = 0; i < 8; ++i) acc[i] = 0.f;
#pragma unroll 4
        for (int d = 0; d < 128; ++d) { const float v = wo[(size_t)d * D] * ps[d];
#pragma unroll
            for (int i = 0; i < 8; ++i) acc[i] += wpl[i * 128 + d] * v; }
        u32x4 o; o.x = pk2(acc[0], acc[1]); o.y = pk2(acc[2], acc[3]); o.z = pk2(acc[4], acc[5]); o.w = pk2(acc[6], acc[7]);
        { const int kk = 512 + g * 128 + cch * 8;
          *(u32x4*)((bf16_t*)(ws + WS_WOUT) + (size_t)l * D * D + (((size_t)(n >> 8) * (D >> 5) + (kk >> 5)) * 256 + (n & 255)) * 32 + (kk & 31)) = o; }
    }
    {
        LAS float* scr = (LAS float*)(lds + wave * 16384);
        const int gw = bid * 8 + wave, NGW = G * 8;
        constexpr int I_IN = 16 * 64, I_OUT = 8 * 32, I_1 = 16 * 128, I_2 = 64 * 32, I_L = I_IN + I_OUT + I_1 + I_2;
        for (int it = gw; it < 2 * I_L; it += NGW) {
            const int l = it / I_L; int r = it % I_L;
            if (r < I_IN) { transpose_item<true>(a.w_in + (size_t)l * D * PROJ, PROJ, (bf16_t*)(ws + WS_WIN) + (size_t)l * PROJ * D, D, scr, r / 64, r % 64, lane); continue; } r -= I_IN;
            if (r < I_OUT) { transpose_item<true>(a.w_out + (size_t)l * D * D, D, (bf16_t*)(ws + WS_WOUT) + (size_t)l * D * D, D, scr, r / 32, r % 32, lane); continue; } r -= I_OUT;
            if (r < I_1) { transpose_item<true>(a.w_mlp1 + (size_t)l * D * FF, FF, (bf16_t*)(ws + WS_W1) + (size_t)l * FF * D, D, scr, r / 128, r % 128, lane); continue; } r -= I_1;
            transpose_item<true>(a.w_mlp2 + (size_t)l * FF * D, D, (bf16_t*)(ws + WS_W2) + (size_t)l * D * FF, FF, scr, r / 32, r % 32, lane);
        }
    }
}

template <bool SRC_BF16, bool OUT_F32>
__device__ __forceinline__ void ln_phase(const void* srcv, float* dstF, bf16_t* dstH, const float* g, const float* bt, const float* sc, const float* sh, int G, int bid, int tid) {
    asm volatile("" : "+v"(tid));
    const int lane = tid & 63, wave = tid >> 6;
    const int gw = bid * 8 + wave, NGW = G * 8;
    constexpr int RPI = SRC_BF16 ? 4 : 8;
    const int rpw = (((M + NGW - 1) / NGW) + RPI - 1) & ~(RPI - 1);
    const int r0 = gw * rpw, r1 = (r0 + rpw < M) ? r0 + rpw : M;
    if (r0 >= M) return;
    const int c0 = 8 * lane;
    f32x4 gv[4], bv[4], scv[4], shv[4];
#pragma unroll
    for (int j = 0; j < 4; ++j) { const int cj = c0 + (j >> 1) * 512 + (j & 1) * 4; gv[j] = *(const f32x4*)(g + cj); bv[j] = *(const f32x4*)(bt + cj); scv[j] = (f32x4){1.f, 1.f, 1.f, 1.f}; shv[j] = (f32x4){0.f, 0.f, 0.f, 0.f}; }
    int curb = -1;
    for (int r = r0; r < r1; r += RPI) {
        f32x4 nf[RPI][4]; u32x4 nb[RPI][2];
#pragma unroll
        for (int q = 0; q < RPI; ++q) {
            if (SRC_BF16) { const bf16_t* p = (const bf16_t*)srcv + tix(r, c0) + q * 32; nb[q][0] = *(const u32x4*)p; nb[q][1] = *(const u32x4*)(p + 16 * 256 * 32); }
            else { const float* p = (const float*)srcv + (size_t)(r + q) * D + c0; nf[q][0] = *(const f32x4*)p; nf[q][1] = *(const f32x4*)(p + 4); nf[q][2] = *(const f32x4*)(p + 512); nf[q][3] = *(const f32x4*)(p + 516); }
        }
        const int b = r >> 12;
        if (!OUT_F32 && b != curb) { curb = b;
#pragma unroll
            for (int j = 0; j < 4; ++j) { const int cj = c0 + (j >> 1) * 512 + (j & 1) * 4; scv[j] = *(const f32x4*)(sc + (size_t)b * NMOD + cj) + 1.0f; shv[j] = *(const f32x4*)(sh + (size_t)b * NMOD + cj); } }
#pragma unroll
        for (int q = 0; q < RPI; ++q) {
            f32x4 v[4];
            if (SRC_BF16) {
#pragma unroll
                for (int t = 0; t < 2; ++t) { const u32x4 w = nb[q][t]; v[2 * t].x = bflo(w.x); v[2 * t].y = bfhi(w.x); v[2 * t].z = bflo(w.y); v[2 * t].w = bfhi(w.y); v[2 * t + 1].x = bflo(w.z); v[2 * t + 1].y = bfhi(w.z); v[2 * t + 1].z = bflo(w.w); v[2 * t + 1].w = bfhi(w.w); }
            } else {
#pragma unroll
                for (int j = 0; j < 4; ++j) v[j] = nf[q][j];
            }
            float s = 0.f;
#pragma unroll
            for (int j = 0; j < 4; ++j) s += (v[j].x + v[j].y) + (v[j].z + v[j].w);
            const float mean = wave_sum(s) * (1.f / D); float s2 = 0.f;
#pragma unroll
            for (int j = 0; j < 4; ++j) { v[j] = v[j] - mean; s2 += (v[j].x * v[j].x + v[j].y * v[j].y) + (v[j].z * v[j].z + v[j].w * v[j].w); }
            const float rstd = 1.f / sqrtf(wave_sum(s2) * (1.f / D) + LN_EPS);
#pragma unroll
            for (int j = 0; j < 4; ++j) v[j] = v[j] * rstd * gv[j] + bv[j];
            if (OUT_F32) { float* p = dstF + (size_t)(r + q) * D + c0; *(f32x4*)p = v[0]; *(f32x4*)(p + 4) = v[1]; *(f32x4*)(p + 512) = v[2]; *(f32x4*)(p + 516) = v[3]; }
            else {
#pragma unroll
                for (int j = 0; j < 4; ++j) v[j] = v[j] * scv[j] + shv[j];
                u32x4 w0, w1; w0.x = pk2(v[0].x, v[0].y); w0.y = pk2(v[0].z, v[0].w); w0.z = pk2(v[1].x, v[1].y); w0.w = pk2(v[1].z, v[1].w);
                w1.x = pk2(v[2].x, v[2].y); w1.y = pk2(v[2].z, v[2].w); w1.z = pk2(v[3].x, v[3].y); w1.w = pk2(v[3].z, v[3].w);
                bf16_t* p = dstH + tix(r, c0) + q * 32; *(u32x4*)p = w0; *(u32x4*)(p + 16 * 256 * 32) = w1;
            }
        }
    }
}

__device__ __forceinline__ void add8(float (&s)[8], const u32x4 w) { s[0] += bflo(w.x); s[1] += bfhi(w.x); s[2] += bflo(w.y); s[3] += bfhi(w.y); s[4] += bflo(w.z); s[5] += bfhi(w.z); s[6] += bflo(w.w); s[7] += bfhi(w.w); }
__device__ __forceinline__ void sub8(float (&s)[8], const u32x4 w) { s[0] -= bflo(w.x); s[1] -= bfhi(w.x); s[2] -= bflo(w.y); s[3] -= bfhi(w.y); s[4] -= bflo(w.z); s[5] -= bfhi(w.z); s[6] -= bflo(w.w); s[7] -= bfhi(w.w); }
template <int W>
__device__ __forceinline__ void pool_lane(const bf16_t* Ubc  , bf16_t* catc  , int T0) {
    constexpr int HW = W / 2, NL = 8 + W - 1;
    u32x4 raw[NL];
#pragma unroll
    for (int k = 0; k < NL; ++k) { const int tk = T0 - HW + k; const int tc = tk < 0 ? 0 : (tk > SEQ - 1 ? SEQ - 1 : tk); u32x4 v = *(const u32x4*)(Ubc + (size_t)tc * AW);
        if (tk != tc) v = (u32x4){0u, 0u, 0u, 0u}; raw[k] = v; }
    float sm[8];
#pragma unroll
    for (int e = 0; e < 8; ++e) sm[e] = 0.f;
#pragma unroll
    for (int k = 0; k < W; ++k) add8(sm, raw[k]);
#pragma unroll
    for (int o = 0; o < 8; ++o) {
        int lo = T0 + o - HW, hi = lo + W; lo = lo < 0 ? 0 : lo; hi = hi > SEQ ? SEQ : hi; const float ic = 1.0f / (float)(hi - lo);
        const u32x4 c = raw[o + HW];
        u32x4 w; w.x = pk2(sm[0] * ic - bflo(c.x), sm[1] * ic - bfhi(c.x)); w.y = pk2(sm[2] * ic - bflo(c.y), sm[3] * ic - bfhi(c.y));
        w.z = pk2(sm[4] * ic - bflo(c.z), sm[5] * ic - bfhi(c.z)); w.w = pk2(sm[6] * ic - bflo(c.w), sm[7] * ic - bfhi(c.w));
        *(u32x4*)(catc + o * 32) = w;
        if (o < 7) { add8(sm, raw[o + W]); sub8(sm, raw[o]); }
    }
}
__device__ __forceinline__ void attn_pool_phase(LAS unsigned char* lds, const bf16_t* Qb, const bf16_t* Kb, const bf16_t* Vt, const bf16_t* Ub, bf16_t* cat, const float* rpb_l, int G, int bid, int tid, int mode = 0) {
    asm volatile("" : "+v"(tid));
    LAS float* tab = (LAS float*)lds;
    for (int i = tid; i < NHEAD * RPB_H * 64; i += 512) { const int c = (i & 63) - 16, hr = i >> 6; tab[i] = (c >= 0 && c < RPB_W) ? rpb_l[hr * RPB_W + c] * LOG2E : 0.f; }
    __syncthreads();
    const int lane = tid & 63, h = __builtin_amdgcn_readfirstlane(tid >> 6), q16 = lane & 15, g4 = lane >> 4;
    const LAS float* tabh = tab + h * (RPB_H * 64) + 16;
    const bool xl = (G == 256); const int nun = xl ? 4 : (BATCH * 64 + G - 1) / G;
    for (int k = 0; k < nun; ++k) {
        const int unit = (mode & 4) ? 0 : (xl ? ((bid & 7) * 128 + k * 32 + (bid >> 3)) : (bid + k * G));
        if (unit >= BATCH * 64) break;
        const int b = unit >> 6, r = unit & 63; const int rs = r < 4 ? 0 : (r > 60 ? 56 : r - 4);
        const size_t tok0 = (size_t)b * SEQ + r * 64;
#pragma unroll 1
        for (int j = 0; j < ((mode & 2) ? 0 : 4); ++j) {
            const int cb = (j == 0) ? 0 : (j == 1) ? 8 : (j == 2) ? 24 : 32;
            const int qc = 16 * j + q16; const int cs = qc < 8 ? 0 : (qc > 56 ? 48 : qc - 8);
            const int tb0 = cb + g4 * 8 - qc + 15;
            const int vlo = cs - (cb + g4 * 8);
            f32x4 mb4[2];
#pragma unroll
            for (int hh = 0; hh < 2; ++hh)
#pragma unroll
                for (int jj = 0; jj < 4; ++jj) mb4[hh][jj] = ((unsigned)(hh * 4 + jj - vlo) < 16u) ? 0.f : -1e30f;
            const size_t cbase = ((size_t)(b * 8 + h) * 8 + g4) * SEQ;
            const bf16_t* qp = Qb + (cbase + r * 64 + qc) * 8;
            const bf16x8 q0 = *(const bf16x8*)qp, q1 = *(const bf16x8*)(qp + (size_t)4 * SEQ * 8);
            bf16x8 kf[8][2][2];
            const bf16_t* kbase = Kb + (cbase + rs * 64 + cb + (q16 >> 2) * 8 + (q16 & 3)) * 8;
#pragma unroll
            for (int i = 0; i < 8; ++i)
#pragma unroll
                for (int hh = 0; hh < 2; ++hh) { const bf16_t* kp = kbase + (size_t)(i * 64 + hh * 4) * 8; kf[i][hh][0] = *(const bf16x8*)kp; kf[i][hh][1] = *(const bf16x8*)(kp + (size_t)4 * SEQ * 8); }
            __builtin_amdgcn_sched_barrier(0);
            f32x4 s[8][2];
            float mx = -1e30f;
#pragma unroll
            for (int i = 0; i < 8; ++i)
#pragma unroll
                for (int hh = 0; hh < 2; ++hh) {
                    f32x4 acc = (f32x4){0.f, 0.f, 0.f, 0.f};
                    acc = __builtin_amdgcn_mfma_f32_16x16x32_bf16(kf[i][hh][0], q0, acc, 0, 0, 0);
                    acc = __builtin_amdgcn_mfma_f32_16x16x32_bf16(kf[i][hh][1], q1, acc, 0, 0, 0);
                    const LAS float* trow = tabh + (rs + i - r + 7) * 64 + tb0 + hh * 4;
                    f32x4 bias4; bias4.x = trow[0]; bias4.y = trow[1]; bias4.z = trow[2]; bias4.w = trow[3];
                    acc = (acc + bias4) + mb4[hh];
                    mx = fmaxf(mx, fmaxf(fmaxf(acc.x, acc.y), fmaxf(acc.z, acc.w)));
                    s[i][hh] = acc;
                }
            bf16x8 vf[8][4];
            const bf16_t* vbase = Vt + (((size_t)(b * 8 + h) * (SEQ / 8) + (rs * 64 + cb) / 8 + g4) * 64 + q16) * 8;
#pragma unroll
            for (int i = 0; i < 8; ++i)
#pragma unroll
                for (int db = 0; db < 4; ++db) vf[i][db] = *(const bf16x8*)(vbase + (size_t)i * 8 * 512 + db * 128);
            __builtin_amdgcn_sched_barrier(0);
            mx = fmaxf(mx, __shfl_xor(mx, 16)); mx = fmaxf(mx, __shfl_xor(mx, 32));
            f32x4 sum4 = (f32x4){0.f, 0.f, 0.f, 0.f}; const f32x4 mx4 = (f32x4){mx, mx, mx, mx};
            u32x4 pw[8];
#pragma unroll
            for (int i = 0; i < 8; ++i) {
#pragma unroll
                for (int hh = 0; hh < 2; ++hh) { const f32x4 d = s[i][hh] - mx4;
                    f32x4 p; p.x = __builtin_amdgcn_exp2f(d.x); p.y = __builtin_amdgcn_exp2f(d.y); p.z = __builtin_amdgcn_exp2f(d.z); p.w = __builtin_amdgcn_exp2f(d.w);
                    s[i][hh] = p; sum4 += p; }
                pw[i].x = pg8::cvt_pk_bf16(s[i][0][0], s[i][0][1]); pw[i].y = pg8::cvt_pk_bf16(s[i][0][2], s[i][0][3]); pw[i].z = pg8::cvt_pk_bf16(s[i][1][0], s[i][1][1]); pw[i].w = pg8::cvt_pk_bf16(s[i][1][2], s[i][1][3]);
            }
            float sum = (sum4.x + sum4.y) + (sum4.z + sum4.w);
            sum += __shfl_xor(sum, 16); sum += __shfl_xor(sum, 32);
            f32x4 o[4];
#pragma unroll
            for (int db = 0; db < 4; ++db) o[db] = (f32x4){0.f, 0.f, 0.f, 0.f};
#pragma unroll
            for (int i = 0; i < 8; ++i) {
                const bf16x8 pf = __builtin_bit_cast(bf16x8, pw[i]);
#pragma unroll
                for (int db = 0; db < 4; ++db) o[db] = __builtin_amdgcn_mfma_f32_16x16x32_bf16(vf[i][db], pf, o[db], 0, 0, 0);
            }
            const float inv = 1.0f / sum;
            bf16_t* op = cat + tix((int)(tok0 + qc), h * 64) + g4 * 4;
#pragma unroll
            for (int db = 0; db < 4; ++db) { u32x2 w; w.x = pg8::cvt_pk_bf16(o[db][0] * inv, o[db][1] * inv); w.y = pg8::cvt_pk_bf16(o[db][2] * inv, o[db][3] * inv); *(u32x2*)(op + (db >> 1) * (256 * 32) + (db & 1) * 16) = w; }
        }
        if (!(mode & 1)) {
            const int gidx = h & 3, hfl = h >> 2; const int T0 = r * 64 + hfl * 32 + g4 * 8; const int chan = gidx * 128 + q16 * 8;
            const bf16_t* Ubc = Ub + (size_t)b * SEQ * AW + chan; bf16_t* catc = cat + tix(b * SEQ + T0, 512 + chan);
            if (gidx == 0) pool_lane<2>(Ubc, catc, T0); else if (gidx == 1) pool_lane<4>(Ubc, catc, T0); else if (gidx == 2) pool_lane<8>(Ubc, catc, T0); else pool_lane<16>(Ubc, catc, T0);
        }
    }
}

constexpr int N_PHASES = 2 + 7 * DEPTH;
__global__ void __launch_bounds__(512, 2) fwd_megakernel(Args a) {
    extern __shared__ __attribute__((aligned(16))) unsigned char lds_raw[];
    LAS unsigned char* lds = (LAS unsigned char*)lds_raw;
    cg::grid_group grid = cg::this_grid();
    const int tid = threadIdx.x, bid = blockIdx.x, G = gridDim.x;
    unsigned char* ws = a.ws;
    bf16_t* H = (bf16_t*)(ws + WS_H); bf16_t* F = (bf16_t*)(ws + WS_F);
    bf16_t* Qb = (bf16_t*)(ws + WS_Q); bf16_t* Kb = (bf16_t*)(ws + WS_K); bf16_t* Vt = (bf16_t*)(ws + WS_VT); bf16_t* Ub = (bf16_t*)(ws + WS_U); bf16_t* CAT = (bf16_t*)(ws + WS_CAT);
    const float* mod = (const float*)(ws + WS_MOD);
    const int lo = a.ph_lo, hi = a.ph_hi;
#define IN(k) (lo <= (k) && (k) < hi)
    unsigned* barw = (unsigned*)(ws + WS_CTL);
    volatile LAS unsigned* misc = (volatile LAS unsigned*)(lds + 131072 + 1024);
    if (bid == 0) { for (int i = tid; i < 8192 + 4 * 16384; i += 512) barw[i] = 0u; }
    if (tid < 8) misc[tid] = 0u;
    __syncthreads();
    XcdBarrier xbar; xbar.bar = barw; xbar.x = 0; xbar.st = misc;
    const bool fusedln = (G == 256);
    int vb = bid;
#define SEAM(k) do { if (IN(k) && IN((k) + 1)) { if ((k) == 0) { grid.sync(); xbar = xcd_barrier_post(barw, misc); if (tid == 0) misc[2] = xb_add(&barw[3456 + 64 * xbar.x], 1u); } \
        else { xcd_barrier(xbar); if ((k) == 1) { \
            if (tid == 0) { bool ok = (G % 8 == 0) && xbar.x < 8u; for (int j = 0; j < 8; ++j) ok = ok && (xb_ld(&barw[3456 + 64 * j]) == (unsigned)(G / 8)); misc[3] = ok ? 1u : 0u; } \
            __syncthreads(); if (misc[3]) vb = (int)(misc[2] * 8u + xbar.x); } } } } while (0)

    if (IN(0)) { for (int rep = 0; rep <= PROBE_P0; ++rep) { p0_prologue(a, lds, G, bid, tid); if (rep < PROBE_P0) __syncthreads(); } }
    SEAM(0);
    if (IN(1)) { ln_phase<false, false>(a.x, nullptr, H, a.ln_in_g, a.ln_in_b, mod + 1 * D, mod + 0 * D, G, bid, tid); }
    SEAM(1);
#pragma unroll 1
    for (int l = 0; l < DEPTH; ++l) {
        const int p = 2 + 7 * l;
        unsigned char* ws = a.ws; asm volatile("" : "+s"(ws));
        bf16_t* H = (bf16_t*)(ws + WS_H); bf16_t* F = (bf16_t*)(ws + WS_F);
        bf16_t* Qb = (bf16_t*)(ws + WS_Q); bf16_t* Kb = (bf16_t*)(ws + WS_K); bf16_t* Vt = (bf16_t*)(ws + WS_VT); bf16_t* Ub = (bf16_t*)(ws + WS_U); bf16_t* CAT = (bf16_t*)(ws + WS_CAT);
        const float* mod = (const float*)(ws + WS_MOD); unsigned* barw = (unsigned*)(ws + WS_CTL);
        const float* modl = mod + (size_t)l * BATCH * NMOD;
        if (IN(p + 0)) {
            pg8::Gemm g{H, (const bf16_t*)(ws + WS_WIN) + (size_t)l * PROJ * D, M, PROJ, D}; pg8::StaticOrder S; S.init(M, PROJ, G, vb);
            pg8::EpiProj E{Qb, Kb, Vt, Ub};
            pg8::gemm_phase<pg8::EpiProj, true, pg8::StaticOrder, true, true>(lds, g, S, E);
        }
        SEAM(p + 0);
        if (IN(p + 1)) { for (int rep = 0; rep <= PROBE_ATT; ++rep) { attn_pool_phase(lds, Qb, Kb, Vt, Ub, CAT, a.rpb + (size_t)l * NHEAD * RPB_N, G, vb, tid, rep < PROBE_ATT ? PROBE_MODE : 0); if (rep < PROBE_ATT) xcd_barrier(xbar); } }
        SEAM(p + 1);
        if (IN(p + 2)) {
            pg8::Gemm g{CAT, (const bf16_t*)(ws + WS_WOUT) + (size_t)l * D * D, M, D, D}; pg8::StaticOrder S; S.init(M, D, G, vb);
            if (fusedln) { pg8::PanelStats st{(unsigned long long*)(ws + WS_X) + (size_t)(2 * l) * M * 4, barw + 8192 + (2 * l) * 16384};
                pg8::EpiResLn<false> E{H, nullptr, modl, 0 * D, 1 * D, 2 * D, a.ln1_g + l * D, a.ln1_b + l * D, modl, 3 * D, 4 * D, st};
                pg8::gemm_phase<pg8::EpiResLn<false>, true, pg8::StaticOrder, true, true>(lds, g, S, E); }
            else { pg8::EpiRes E{H, modl, 0 * D, 1 * D, 2 * D};
                pg8::gemm_phase<pg8::EpiRes, true, pg8::StaticOrder, true, true>(lds, g, S, E); }
        }
        SEAM(p + 2);
        if (IN(p + 3) && !fusedln) { ln_phase<true, false>(H, nullptr, H, a.ln1_g + l * D, a.ln1_b + l * D, modl + 4 * D, modl + 3 * D, G, bid, tid); }
        if (!fusedln) SEAM(p + 3);
        if (IN(p + 4)) {
            pg8::Gemm g{H, (const bf16_t*)(ws + WS_W1) + (size_t)l * FF * D, M, FF, D}; pg8::StaticOrder S; S.init(M, FF, G, vb);
#if STAGGER_US
            { const unsigned long long t0 = __builtin_amdgcn_s_memrealtime(); const unsigned long long dl = (unsigned long long)(vb & 3) * (STAGGER_US * 100ull);
              while (__builtin_amdgcn_s_memrealtime() - t0 < dl) __builtin_amdgcn_s_sleep(16); }
#endif
            { pg8::EpiRelu2 E{F, FF, 0}; pg8::gemm_phase<pg8::EpiRelu2, false, pg8::StaticOrder, true, true>(lds, g, S, E); }
#if PROBE_MLP1
            xcd_barrier(xbar);
            { int ns = PROBE_MLP1_NOSTORE; asm volatile("" : "+s"(ns)); pg8::EpiRelu2 E{F, FF, ns};
#if PROBE_MLP1_HOT
              pg8::HotOrder S2; S2.init(M, FF, G, vb); pg8::gemm_phase<pg8::EpiRelu2, true, pg8::HotOrder>(lds, g, S2, E);
#else
              pg8::gemm_phase<pg8::EpiRelu2, true>(lds, g, S, E);
#endif
            }
#endif
        }
        SEAM(p + 4);
        if (IN(p + 5)) {
            pg8::Gemm g{F, (const bf16_t*)(ws + WS_W2) + (size_t)l * D * FF, M, D, FF}; pg8::StaticOrder S; S.init(M, D, G, vb);
            const bool lastl2 = (l == DEPTH - 1); const float* modn2 = mod + (size_t)(lastl2 ? l : l + 1) * BATCH * NMOD;
            if (fusedln) { pg8::PanelStats st{(unsigned long long*)(ws + WS_X) + (size_t)(2 * l + 1) * M * 4, barw + 8192 + (2 * l + 1) * 16384};
                if (lastl2) { pg8::EpiResLn<true> E{H, a.out, modl, 3 * D, 4 * D, 5 * D, a.ln2_g + l * D, a.ln2_b + l * D, modn2, 0, 0, st};
                    pg8::gemm_phase<pg8::EpiResLn<true>, true, pg8::StaticOrder, true, true>(lds, g, S, E); }
                else { pg8::EpiResLn<false> E{H, nullptr, modl, 3 * D, 4 * D, 5 * D, a.ln2_g + l * D, a.ln2_b + l * D, modn2, 0 * D, 1 * D, st};
                    pg8::gemm_phase<pg8::EpiResLn<false>, true, pg8::StaticOrder, true, true>(lds, g, S, E); } }
            else { pg8::EpiRes E{H, modl, 3 * D, 4 * D, 5 * D};
                pg8::gemm_phase<pg8::EpiRes, true, pg8::StaticOrder, true, true>(lds, g, S, E); }
        }
        if (!(fusedln && l == DEPTH - 1)) SEAM(p + 5);
        if (IN(p + 6) && !fusedln) {
            const bool lastl = (l == DEPTH - 1);
            const float* modn = mod + (size_t)(lastl ? l : l + 1) * BATCH * NMOD;
            if (lastl) ln_phase<true, true>(H, a.out, nullptr, a.ln2_g + l * D, a.ln2_b + l * D, modn, modn, G, bid, tid);
            else ln_phase<true, false>(H, nullptr, H, a.ln2_g + l * D, a.ln2_b + l * D, modn + 1 * D, modn + 0 * D, G, bid, tid);
        }
        if (!fusedln) SEAM(p + 6);
    }
    for (int rep = 0; rep < PROBE_SYNC; ++rep) xcd_barrier(xbar);
#undef IN
#undef SEAM
}

extern "C" void kernel_launch(void* const* d_in, const int* in_sizes, int n_in, void* d_out, int out_size, void* d_ws, size_t ws_size, hipStream_t stream) {
    static int grid = 0;
    if (grid == 0) {
        if (n_in != 17 || in_sizes[0] != M * D || out_size != M * D || ws_size < WS_END) { fprintf(stderr, "kernel_launch: unexpected shapes / workspace (n_in %d, in0 %d, out %d, ws %zu)\n", n_in, n_in > 0 ? in_sizes[0] : -1, out_size, ws_size); grid = -1; return; }
        int dev = 0, cus = 0, per_cu = 0;
        hipGetDevice(&dev); hipDeviceGetAttribute(&cus, hipDeviceAttributeMultiprocessorCount, dev);
        if (hipFuncSetAttribute((const void*)fwd_megakernel, hipFuncAttributeMaxDynamicSharedMemorySize, LDS_BYTES) != hipSuccess) { fprintf(stderr, "kernel_launch: hipFuncSetAttribute failed\n"); grid = -1; return; }
        if (hipOccupancyMaxActiveBlocksPerMultiprocessor(&per_cu, (const void*)fwd_megakernel, 512, LDS_BYTES) != hipSuccess || per_cu < 1) { per_cu = 1; (void)hipGetLastError(); }
        grid = (cus > 0 ? cus : 256) * per_cu;
    }
    if (grid < 0) return;
    Args a{};
    a.x = (const float*)d_in[0]; a.c = (const float*)d_in[1]; a.ln_in_g = (const float*)d_in[2]; a.ln_in_b = (const float*)d_in[3]; a.w_ada = (const float*)d_in[4]; a.b_ada = (const float*)d_in[5];
    a.w_in = (const float*)d_in[6]; a.rpb = (const float*)d_in[7]; a.w_pool = (const float*)d_in[8]; a.pool_scale = (const float*)d_in[9]; a.w_out = (const float*)d_in[10];
    a.ln1_g = (const float*)d_in[11]; a.ln1_b = (const float*)d_in[12]; a.w_mlp1 = (const float*)d_in[13]; a.w_mlp2 = (const float*)d_in[14]; a.ln2_g = (const float*)d_in[15]; a.ln2_b = (const float*)d_in[16];
    a.out = (float*)d_out; a.ws = (unsigned char*)d_ws;
#if MK_MULTI
    for (int p = 0; p < N_PHASES; ++p) { a.ph_lo = p; a.ph_hi = p + 1; hipLaunchKernelGGL(fwd_megakernel, dim3(grid), dim3(512), LDS_BYTES, stream, a); }
#else
    a.ph_lo = 0; a.ph_hi = N_PHASES;
    void* args[] = {&a};
    hipError_t e = hipLaunchCooperativeKernel((const void*)fwd_megakernel, dim3(grid), dim3(512), args, LDS_BYTES, stream);
    if (e != hipSuccess) fprintf(stderr, "kernel_launch: cooperative launch failed: %s (grid %d)\n", hipGetErrorString(e), grid);
#endif
}
```
